# Optimizing an MI355X kernel written in HIP

```python
import jax
import jax.numpy as jnp
from jax import lax
import numpy as np

D_MODEL = 1024
BATCH = 8
SEQ = 4096
DEPTH = 2

GRID_W = 64
CTX_LEN = 256
D_MIX = D_MODEL
CONV_WIDTH = D_MIX // 4
CONV_KERNEL = 31
ATTN_WIDTH = D_MIX // 2
ATTN_HEAD_DIM = 64
ATTN_HEADS = ATTN_WIDTH // ATTN_HEAD_DIM
ATTN_KV_HEADS = 2
ATTN_GROUP = ATTN_HEADS // ATTN_KV_HEADS
ATTN_WINDOW = 128
ATTN_BLOCK = 128
ROPE_THETA = 10000.0
GLA_WIDTH = D_MIX - CONV_WIDTH - ATTN_WIDTH
GLA_HEADS = 4
GLA_DV = GLA_WIDTH // GLA_HEADS
GLA_DK = GLA_DV // 2
GLA_LOW_RANK = 16
GLA_TAU = 16.0
GLA_CHUNK = 64
NORM_EPS = 1e-6
NEG_INF = -1e30
F32 = jnp.float32

IN_COLUMNS = (
    ('a_val', CONV_WIDTH), ('a_glu', CONV_WIDTH), ('a_gate', CONV_WIDTH),
    ('b_q', ATTN_WIDTH), ('b_k', ATTN_KV_HEADS * ATTN_HEAD_DIM), ('b_v', ATTN_KV_HEADS * ATTN_HEAD_DIM), ('b_gate', ATTN_WIDTH),
    ('c_q', GLA_HEADS * GLA_DK), ('c_k', GLA_HEADS * GLA_DK), ('c_v', GLA_WIDTH),
    ('c_lr_f', GLA_LOW_RANK), ('c_lr_b', GLA_LOW_RANK), ('c_gate', GLA_WIDTH),
)
N_IN = (3 * CONV_WIDTH + 2 * ATTN_WIDTH + 2 * ATTN_KV_HEADS * ATTN_HEAD_DIM
        + 2 * GLA_HEADS * GLA_DK + 2 * GLA_WIDTH + 2 * GLA_LOW_RANK)
CTX_KV_COLUMNS = ('b_k', 'b_v', 'c_k', 'c_v', 'c_lr_f', 'c_lr_b')

kernel_name = 'hybrid_conv_swa_gla_prefix_dit'


def _rms_norm(x):
    xf = x.astype(F32)
    return (xf * lax.rsqrt(jnp.mean(xf * xf, axis=-1, keepdims=True) + NORM_EPS)).astype(x.dtype)


def _column_slices():
    out, off = {}, 0
    for name, size in IN_COLUMNS:
        out[name] = (off, size)
        off += size
    return out


def _project(h, w_in, names=None):
    sl = _column_slices()
    if names is None:
        z = h @ w_in
        return {n: z[..., o:o + s] for n, (o, s) in sl.items()}
    return {n: h @ w_in[:, sl[n][0]:sl[n][0] + sl[n][1]] for n in names}


def _heads(t, n_heads):
    return t.reshape(t.shape[:2] + (n_heads, t.shape[-1] // n_heads))


def _rope_tables(n_tokens):
    rows = n_tokens // GRID_W
    r = jnp.repeat(jnp.arange(rows, dtype=F32), GRID_W)
    col = jnp.tile(jnp.arange(GRID_W, dtype=F32), rows)
    n_freq = ATTN_HEAD_DIM // 4
    inv = ROPE_THETA ** (-jnp.arange(n_freq, dtype=F32) / n_freq)
    ang = jnp.concatenate([r[:, None] * inv, col[:, None] * inv], axis=-1)
    ang = jnp.concatenate([ang, ang], axis=-1)
    return jnp.cos(ang), jnp.sin(ang)


def _apply_rope(x, cos, sin):
    xf = x.astype(F32)
    half = ATTN_HEAD_DIM // 2
    rot = jnp.concatenate([-xf[..., half:], xf[..., :half]], axis=-1)
    return (xf * cos[None, :, None, :] + rot * sin[None, :, None, :]).astype(x.dtype)


def _conv_branch(p, conv_w, conv_b, ln_w, ln_b):
    u = p['a_val'] * jax.nn.sigmoid(p['a_glu'])
    u = lax.conv_general_dilated(
        u, conv_w[:, None, :].astype(u.dtype), window_strides=(1,),
        padding=((CONV_KERNEL // 2, CONV_KERNEL // 2),),
        dimension_numbers=('NWC', 'WIO', 'NWC'), feature_group_count=CONV_WIDTH) + conv_b
    uf = u.astype(F32)
    mu = jnp.mean(uf, axis=-1, keepdims=True)
    var = jnp.mean(jnp.square(uf - mu), axis=-1, keepdims=True)
    u = ((uf - mu) * lax.rsqrt(var + NORM_EPS) * ln_w + ln_b).astype(p['a_val'].dtype)
    return jax.nn.silu(u) * jax.nn.silu(p['a_gate'])


def _windowed_attention(q, k, v, kc, vc, sink):
    B, S, H, Dh = q.shape
    nb = S // ATTN_BLOCK
    nc = kc.shape[1]
    qb = (q * Dh ** -0.5).reshape(B, nb, ATTN_BLOCK, ATTN_KV_HEADS, ATTN_GROUP, Dh).transpose(1, 0, 2, 3, 4, 5)

    def band(t):
        tb = t.reshape(B, nb, ATTN_BLOCK, ATTN_KV_HEADS, Dh)
        tp = jnp.pad(tb, ((0, 0), (1, 1), (0, 0), (0, 0), (0, 0)))
        return jnp.concatenate([tp[:, :-2], tp[:, 1:-1], tp[:, 2:]], axis=2).transpose(1, 0, 2, 3, 4)

    kw, vw = band(k), band(v)
    qi = jnp.arange(ATTN_BLOCK)
    kj = jnp.arange(3 * ATTN_BLOCK)
    rel = ATTN_BLOCK + qi[:, None] - kj[None, :]
    kpos = (jnp.arange(nb)[:, None] - 1) * ATTN_BLOCK + kj[None, :]
    mask = (jnp.abs(rel)[None] <= ATTN_WINDOW) & ((kpos >= 0) & (kpos < S))[:, None, :]
    sink_l = sink.astype(F32).reshape(ATTN_KV_HEADS, ATTN_GROUP)

    def one_block(args):
        qn, kn, vn, mn = args
        s_loc = jnp.einsum('bqhgd,bkhd->bhgqk', qn, kn).astype(F32)
        s_loc = jnp.where(mn, s_loc, NEG_INF)
        s_ctx = jnp.einsum('bqhgd,bchd->bhgqc', qn, kc).astype(F32)
        s_sink = jnp.broadcast_to(sink_l[None, :, :, None, None], s_ctx.shape[:-1] + (1,))
        p = jax.nn.softmax(jnp.concatenate([s_sink, s_ctx, s_loc], axis=-1), axis=-1)
        p_ctx = p[..., 1:1 + nc].astype(vn.dtype)
        p_loc = p[..., 1 + nc:].astype(vn.dtype)
        return (jnp.einsum('bhgqc,bchd->bqhgd', p_ctx, vc)
                + jnp.einsum('bhgqk,bkhd->bqhgd', p_loc, vn))

    o = lax.map(one_block, (qb, kw, vw, mask))
    return o.transpose(1, 0, 2, 3, 4, 5).reshape(B, S, H * Dh)


def _ctx_attention(qc, kc, vc, sink):
    B, Nc, H, Dh = qc.shape
    qg = (qc * Dh ** -0.5).reshape(B, Nc, ATTN_KV_HEADS, ATTN_GROUP, Dh)
    s = jnp.einsum('bqhgd,bkhd->bhgqk', qg, kc).astype(F32)
    s_sink = jnp.broadcast_to(sink.astype(F32).reshape(ATTN_KV_HEADS, ATTN_GROUP)[None, :, :, None, None],
                              s.shape[:-1] + (1,))
    p = jax.nn.softmax(jnp.concatenate([s_sink, s], axis=-1), axis=-1)[..., 1:].astype(vc.dtype)
    return jnp.einsum('bhgqk,bkhd->bqhgd', p, vc).reshape(B, Nc, H * Dh)


def _gla_decay(lr, w_up, b_up):
    z = lr.astype(F32) @ w_up.astype(F32) + b_up.astype(F32)
    return (jax.nn.log_sigmoid(z) / GLA_TAU).reshape(lr.shape[:2] + (GLA_HEADS, GLA_DK))


def _gla_chunked(q, k, v, log_a, s0):
    B, T, H, _ = q.shape
    dv = v.shape[-1]
    n = T // GLA_CHUNK

    def chunks(t):
        return t.astype(F32).reshape(B, n, GLA_CHUNK, H, t.shape[-1]).transpose(1, 0, 2, 3, 4)

    qc, kc, vc, la = chunks(q), chunks(k), chunks(v), chunks(log_a)
    b = jnp.cumsum(la, axis=2)
    b_last = b[:, :, -1:]
    q_in = qc * jnp.exp(b)
    k_in = kc * jnp.exp(-b)
    causal = jnp.tril(jnp.ones((GLA_CHUNK, GLA_CHUNK), dtype=bool))
    att = jnp.where(causal, jnp.einsum('nbthd,nbshd->nbhts', q_in, k_in), 0.0)
    o_intra = jnp.einsum('nbhts,nbshv->nbthv', att, vc)
    chunk_state = jnp.einsum('nbshd,nbshv->nbhdv', kc * jnp.exp(b_last - b), vc)
    chunk_decay = jnp.exp(b_last[:, :, 0])

    def step(s, xs):
        q_n, dec_n, st_n = xs
        o = jnp.einsum('bthd,bhdv->bthv', q_n, s)
        return dec_n[..., None] * s + st_n, o

    s_final, o_inter = lax.scan(step, s0.astype(F32), (q_in, chunk_decay, chunk_state))
    o = (o_intra + o_inter).transpose(1, 0, 2, 3, 4).reshape(B, T, H, dv)
    return o, s_final


def _gla_final_state(k, v, log_a):
    L = jnp.cumsum(log_a.astype(F32), axis=1)
    w = jnp.exp(L[:, -1:] - L)
    return jnp.einsum('bthd,bthv->bhdv', k.astype(F32) * w, v.astype(F32))


def _gla_output(o, gate, norm_w):
    B, T = o.shape[:2]
    of = o * lax.rsqrt(jnp.mean(o * o, axis=-1, keepdims=True) + NORM_EPS)
    of = of * norm_w.astype(F32).reshape(GLA_HEADS, GLA_DV)
    return of.reshape(B, T, GLA_WIDTH).astype(gate.dtype) * jax.nn.silu(gate)


def _flip(t):
    return jnp.flip(t, axis=1)


def _hybrid_layer(xl, xc, c, c_ctx, w_mod, b_mod, w_in, conv_w, conv_b, conv_ln_w, conv_ln_b,
                  attn_sink, gla_w_up, gla_b_up, gla_norm_w, w_out, rope_cos, rope_sin, update_ctx):
    B, S, _ = xl.shape
    D = D_MODEL
    shift, scale, gate = jnp.split(jax.nn.silu(c) @ w_mod + b_mod, 3, axis=-1)
    n_mod_c = 3 * D if update_ctx else 2 * D
    mod_c = jax.nn.silu(c_ctx) @ w_mod[:, :n_mod_c] + b_mod[:n_mod_c]
    hl = _rms_norm(xl) * (1.0 + scale[:, None]) + shift[:, None]
    hc = _rms_norm(xc) * (1.0 + mod_c[D:2 * D]) + mod_c[:D]
    pl = _project(hl, w_in)
    pc = _project(hc, w_in) if update_ctx else _project(hc, w_in, CTX_KV_COLUMNS)

    a_l = _conv_branch(pl, conv_w, conv_b, conv_ln_w, conv_ln_b)

    q_l = _apply_rope(_heads(pl['b_q'], ATTN_HEADS), rope_cos, rope_sin)
    k_l = _apply_rope(_heads(pl['b_k'], ATTN_KV_HEADS), rope_cos, rope_sin)
    v_l = _heads(pl['b_v'], ATTN_KV_HEADS)
    k_cx = _heads(pc['b_k'], ATTN_KV_HEADS)
    v_cx = _heads(pc['b_v'], ATTN_KV_HEADS)
    b_l = _windowed_attention(q_l, k_l, v_l, k_cx, v_cx, attn_sink) * jax.nn.silu(pl['b_gate'])

    gq_l = _heads(pl['c_q'], GLA_HEADS) * GLA_DK ** -0.5
    gk_l = _heads(pl['c_k'], GLA_HEADS)
    gv_l = _heads(pl['c_v'], GLA_HEADS)
    la_lf = _gla_decay(pl['c_lr_f'], gla_w_up[0], gla_b_up[0])
    la_lb = _gla_decay(pl['c_lr_b'], gla_w_up[1], gla_b_up[1])
    gk_c = _heads(pc['c_k'], GLA_HEADS)
    gv_c = _heads(pc['c_v'], GLA_HEADS)
    la_cf = _gla_decay(pc['c_lr_f'], gla_w_up[0], gla_b_up[0])
    la_cb = _gla_decay(pc['c_lr_b'], gla_w_up[1], gla_b_up[1])
    if update_ctx:
        gq_c = _heads(pc['c_q'], GLA_HEADS) * GLA_DK ** -0.5
        zeros = jnp.zeros((B, GLA_HEADS, GLA_DK, GLA_DV), F32)
        o_cf, s_f = _gla_chunked(gq_c, gk_c, gv_c, la_cf, zeros)
        o_cb, s_b = _gla_chunked(_flip(gq_c), _flip(gk_c), _flip(gv_c), _flip(la_cb), zeros)
    else:
        s_f = _gla_final_state(gk_c, gv_c, la_cf)
        s_b = _gla_final_state(_flip(gk_c), _flip(gv_c), _flip(la_cb))
    o_lf, _ = _gla_chunked(gq_l, gk_l, gv_l, la_lf, s_f)
    o_lb, _ = _gla_chunked(_flip(gq_l), _flip(gk_l), _flip(gv_l), _flip(la_lb), s_b)
    c_l = _gla_output(o_lf + _flip(o_lb), pl['c_gate'], gla_norm_w)

    y_l = jnp.concatenate([a_l, b_l, c_l], axis=-1) @ w_out
    xl = xl + gate[:, None] * y_l

    if update_ctx:
        a_c = _conv_branch(pc, conv_w, conv_b, conv_ln_w, conv_ln_b)
        q_cx = _heads(pc['b_q'], ATTN_HEADS)
        b_c = _ctx_attention(q_cx, k_cx, v_cx, attn_sink) * jax.nn.silu(pc['b_gate'])
        c_c = _gla_output(o_cf + _flip(o_cb), pc['c_gate'], gla_norm_w)
        y_c = jnp.concatenate([a_c, b_c, c_c], axis=-1) @ w_out
        xc = xc + mod_c[2 * D:] * y_c
    return xl, xc


def setup_inputs(seed: int = 0) -> dict:
    key = jax.random.key(seed)
    ks = jax.random.split(key, 17)
    nrm = jax.random.normal
    return {
        'x': nrm(ks[0], (BATCH, SEQ, D_MODEL), F32),
        'c': nrm(ks[1], (BATCH, D_MODEL), F32),
        'ctx': nrm(ks[2], (BATCH, CTX_LEN, D_MODEL), F32),
        'c_ctx': nrm(ks[3], (D_MODEL,), F32),
        'w_mod': nrm(ks[4], (DEPTH, D_MODEL, 3 * D_MODEL), F32) * (0.5 * D_MODEL ** -0.5),
        'b_mod': 0.01 * nrm(ks[5], (DEPTH, 3 * D_MODEL), F32),
        'w_in': nrm(ks[6], (DEPTH, D_MODEL, N_IN), F32) * D_MODEL ** -0.5,
        'conv_w': nrm(ks[7], (DEPTH, CONV_KERNEL, CONV_WIDTH), F32) * CONV_KERNEL ** -0.5,
        'conv_b': 0.01 * nrm(ks[8], (DEPTH, CONV_WIDTH), F32),
        'conv_ln_w': 1.0 + 0.01 * nrm(ks[9], (DEPTH, CONV_WIDTH), F32),
        'conv_ln_b': 0.01 * nrm(ks[10], (DEPTH, CONV_WIDTH), F32),
        'attn_sink': 0.5 * nrm(ks[11], (DEPTH, ATTN_HEADS), F32),
        'gla_w_up': nrm(ks[12], (DEPTH, 2, GLA_LOW_RANK, GLA_HEADS * GLA_DK), F32) * GLA_LOW_RANK ** -0.5,
        'gla_b_up': 0.1 * nrm(ks[13], (DEPTH, 2, GLA_HEADS * GLA_DK), F32),
        'gla_norm_w': 1.0 + 0.01 * nrm(ks[14], (DEPTH, GLA_WIDTH), F32),
        'w_out': nrm(ks[15], (DEPTH, D_MIX, D_MODEL), F32) * D_MIX ** -0.5,
        'final_norm_w': 1.0 + 0.01 * nrm(ks[16], (D_MODEL,), F32),
    }


def reference(x, c, ctx, c_ctx, w_mod, b_mod, w_in, conv_w, conv_b, conv_ln_w, conv_ln_b,
              attn_sink, gla_w_up, gla_b_up, gla_norm_w, w_out, final_norm_w):
    rope_cos, rope_sin = _rope_tables(x.shape[1])
    xl, xc = x, ctx
    for i in range(DEPTH):
        xl, xc = _hybrid_layer(
            xl, xc, c, c_ctx, w_mod[i], b_mod[i], w_in[i], conv_w[i], conv_b[i], conv_ln_w[i], conv_ln_b[i],
            attn_sink[i], gla_w_up[i], gla_b_up[i], gla_norm_w[i], w_out[i], rope_cos, rope_sin,
            update_ctx=(i < DEPTH - 1))
    return _rms_norm(xl) * final_norm_w
```

```cpp
#include <hip/hip_runtime.h>
#include <hip/hip_cooperative_groups.h>
#include <cstdio>
#include <cstdint>
namespace cg = cooperative_groups;
namespace pg8 {
#define PG8_LAS __attribute__((address_space(3)))
typedef unsigned short bf16_t;
typedef short bf16x8 __attribute__((ext_vector_type(8)));
typedef float f32x4 __attribute__((ext_vector_type(4)));
typedef unsigned u32x4 __attribute__((ext_vector_type(4)));
constexpr int BM = 256, BK = 64, HALF = 128, HTB = HALF * BK * 2  , STAGE_BYTES = 8 * HTB, NXCD = 8, WGM = 8;

__host__ __device__ __forceinline__ int lds_byte(int r, int c) { const int st = (r >> 4) * 2 + (c >> 5), rr = r & 15, cc = c & 31, ob = rr * 64 + cc * 2; return st * 1024 + (ob ^ (((ob >> 9) & 1) << 5)); }
__host__ __device__ __forceinline__ void stage_rc(int b, int& R, int& C) { const int st = b / 1024, sb = b % 1024, swz = sb ^ (((sb >> 9) & 1) << 5); R = (st >> 1) * 16 + swz / 64; C = (st & 1) * 32 + (swz % 64) / 2; }
__host__ __device__ __forceinline__ int perm32(int rho) { const int n = rho >> 4, i = rho & 15; return 8 * (i >> 2) + 4 * n + (i & 3); }

struct Unit { int pm, pn; };
struct Gemm { const bf16_t* A; const bf16_t* Bt; int M, N, K; };

struct StaticOrder {
    int nM, nN, nwg, G, c;
    __host__ __device__ void init(int M, int N, int G_, int c_) { nM = M / BM; nN = N / BM; nwg = nM * nN; G = G_; c = c_; }
    __host__ __device__ bool next(int i, Unit& u) const {
        const long L = (long)i * G + c; if (L >= nwg) return false;
        int wgid = (int)L; { const int q = nwg / NXCD, r = nwg % NXCD, xcd = wgid % NXCD, off = wgid / NXCD; wgid = (xcd < r ? xcd * (q + 1) : r * (q + 1) + (xcd - r) * q) + off; }
        const int nig = WGM * nN, gid = wgid / nig, fm = gid * WGM, gsz = (nM - fm) < WGM ? (nM - fm) : WGM;
        u.pm = fm + ((wgid % nig) % gsz); u.pn = (wgid % nig) / gsz; return true;
    }
    __device__ __forceinline__ void a_ready(const Unit&) const {}
    __device__ __forceinline__ void done(const Unit&) const {}
};
__device__ __forceinline__ unsigned cvt_pk_bf16(float lo, float hi) { unsigned r; asm volatile("v_cvt_pk_bf16_f32 %0, %1, %2" : "=v"(r) : "v"(lo), "v"(hi)); return r; }
template <class Epi, class Sched, bool ALIGN_EPI = false, bool SP2 = false>
__device__ __forceinline__ void gemm_phase(PG8_LAS unsigned char* lds, const Gemm g, const Sched& S, const Epi& E) {
    int tid_ = threadIdx.x; asm volatile("" : "+v"(tid_)); const int tid = tid_, wid = __builtin_amdgcn_readfirstlane(tid >> 6), lane = tid & 63, wr = wid >> 2, wc = wid & 3, fr = lane & 15, fq = lane >> 4;
    const int K = g.K, nt = K / BK;
    unsigned voffA[2], voffB[2];
#pragma unroll
    for (int i = 0; i < 2; ++i) { int R, C; stage_rc(tid * 16 + i * 8192, R, C); const int Rb = Epi::PERM ? ((R & ~31) + perm32(R & 31)) : R;
        voffA[i] = (unsigned)(R * K + C) * 2u; voffB[i] = (unsigned)(Rb * K + C) * 2u; }
    const size_t kstep = (size_t)(BK * 2);
    const size_t hstep = (size_t)HALF * K * 2;
    const size_t tstep = 2 * hstep;
    const unsigned ldsw = (unsigned)wid * 1024u;
    const int aoff = lds_byte(wr * 64 + fr, fq * 8), boff = lds_byte(wc * 32 + fr, fq * 8);
#define PG8_SA(b, h) (((b) * 2 + (h)) * HTB)
#define PG8_SB(b, h) ((4 + (b) * 2 + (h)) * HTB)
#define PG8_STAGE(bufoff, gbase, voff) do { _Pragma("unroll") for (int _i = 0; _i < 2; ++_i) \
        __builtin_amdgcn_global_load_lds((const unsigned*)((const char*)(gbase) + (voff)[_i]), (PG8_LAS unsigned*)(lds + (bufoff) + ldsw + _i * 8192), 16, 0, 0); } while (0)
#define PG8_LDA(dst, b, h) do { _Pragma("unroll") for (int m = 0; m < 4; ++m) _Pragma("unroll") for (int k = 0; k < 2; ++k) dst[m][k] = *(const PG8_LAS bf16x8*)(lds + PG8_SA(b, h) + aoff + m * 2048 + k * 1024); } while (0)
#define PG8_LDB(dst, b, h) do { _Pragma("unroll") for (int n = 0; n < 2; ++n) _Pragma("unroll") for (int k = 0; k < 2; ++k) dst[n][k] = *(const PG8_LAS bf16x8*)(lds + PG8_SB(b, h) + boff + n * 2048 + k * 1024); } while (0)
#define PG8_MMA(ai, bj, At, Bt) do { __builtin_amdgcn_s_setprio(1); _Pragma("unroll") for (int m = 0; m < 4; ++m) _Pragma("unroll") for (int n = 0; n < 2; ++n) _Pragma("unroll") for (int k = 0; k < 2; ++k) \
        acc[ai][bj][m][n] = __builtin_amdgcn_mfma_f32_16x16x32_bf16(Bt[n][k], At[m][k], acc[ai][bj][m][n], 0, 0, 0); __builtin_amdgcn_s_setprio(0); } while (0)
#define PG8_WAIT_V(n) asm volatile("s_waitcnt vmcnt(" #n ")" ::: "memory")
#define PG8_WAIT_L(n) asm volatile("s_waitcnt lgkmcnt(" #n ")" ::: "memory")
#define PG8_BAR __builtin_amdgcn_s_barrier()
#define PG8_SCHED __builtin_amdgcn_sched_barrier(0)
    Unit cur, nxt; int ui = 0;
    if (!S.next(0, cur)) return;
    f32x4 acc[2][2][4][2];
#pragma unroll
    for (int a = 0; a < 2; ++a)
#pragma unroll
        for (int b = 0; b < 2; ++b)
#pragma unroll
            for (int m = 0; m < 4; ++m)
#pragma unroll
                for (int n = 0; n < 2; ++n) acc[a][b][m][n] = (f32x4){0.f, 0.f, 0.f, 0.f};
    bf16x8 At[4][2], B0[2][2], B1[2][2];
    const char* cA = (const char*)g.A + (size_t)cur.pm * tstep; const char* cB = (const char*)g.Bt + (size_t)cur.pn * tstep;
    S.a_ready(cur);
    if constexpr (SP2) {
        PG8_STAGE(PG8_SB(0, 0), cB, voffB); PG8_STAGE(PG8_SB(0, 1), cB + hstep, voffB); PG8_STAGE(PG8_SA(0, 0), cA, voffA); PG8_STAGE(PG8_SA(0, 1), cA + hstep, voffA);
        if (wr == 1) PG8_BAR;
        PG8_WAIT_V(2); PG8_BAR;
        PG8_STAGE(PG8_SB(1, 0), cB + kstep, voffB); PG8_STAGE(PG8_SA(1, 0), cA + kstep, voffA); PG8_STAGE(PG8_SB(1, 1), cB + hstep + kstep, voffB);
        PG8_WAIT_V(6); PG8_BAR;
    } else {
        PG8_STAGE(PG8_SB(0, 0), cB, voffB); PG8_STAGE(PG8_SA(0, 0), cA, voffA); PG8_STAGE(PG8_SB(0, 1), cB + hstep, voffB); PG8_STAGE(PG8_SA(0, 1), cA + hstep, voffA);
        if (wr == 1) PG8_BAR;
        PG8_WAIT_V(4); PG8_BAR;
        PG8_STAGE(PG8_SB(1, 0), cB + kstep, voffB); PG8_STAGE(PG8_SA(1, 0), cA + kstep, voffA); PG8_STAGE(PG8_SB(1, 1), cB + hstep + kstep, voffB);
        PG8_WAIT_V(6); PG8_BAR;
    }
    for (;;) {
        const bool has_next = S.next(ui + 1, nxt);
        const char* nA = has_next ? (const char*)g.A + (size_t)nxt.pm * tstep : cA; const char* nB = has_next ? (const char*)g.Bt + (size_t)nxt.pn * tstep : cB;
        for (int t = 0; t < nt; t += 2) {
            const bool last = (t == nt - 2);
            const char* a1 = cA + (size_t)(t + 1) * kstep;
            const char* a2 = last ? nA : cA + (size_t)(t + 2) * kstep; const char* b2 = last ? nB : cB + (size_t)(t + 2) * kstep;
            const char* a3 = a2 + kstep; const char* b3 = b2 + kstep;
            if (last && has_next) S.a_ready(nxt);
            if constexpr (SP2) {
            PG8_LDB(B0, 0, 0); PG8_LDB(B1, 0, 1); PG8_SCHED; PG8_LDA(At, 0, 0); PG8_STAGE(PG8_SA(1, 1), a1 + hstep, voffA);
            PG8_WAIT_V(8); PG8_WAIT_L(0); PG8_BAR; PG8_MMA(0, 0, At, B0); PG8_MMA(0, 1, At, B1); PG8_BAR; PG8_SCHED;
            PG8_LDA(At, 0, 1); PG8_STAGE(PG8_SB(0, 0), b2, voffB); PG8_STAGE(PG8_SB(0, 1), b2 + hstep, voffB); PG8_STAGE(PG8_SA(0, 0), a2, voffA);
            PG8_WAIT_V(8); PG8_WAIT_L(0); PG8_BAR; PG8_MMA(1, 0, At, B0); PG8_MMA(1, 1, At, B1); PG8_BAR; PG8_SCHED;
            PG8_LDB(B0, 1, 0); PG8_LDB(B1, 1, 1); PG8_SCHED; PG8_LDA(At, 1, 0); PG8_STAGE(PG8_SA(0, 1), a2 + hstep, voffA);
            PG8_WAIT_V(8); PG8_WAIT_L(0); PG8_BAR; PG8_MMA(0, 0, At, B0); PG8_MMA(0, 1, At, B1); PG8_BAR; PG8_SCHED;
            PG8_LDA(At, 1, 1); PG8_STAGE(PG8_SB(1, 0), b3, voffB); PG8_STAGE(PG8_SB(1, 1), b3 + hstep, voffB); PG8_STAGE(PG8_SA(1, 0), a3, voffA);
            PG8_WAIT_V(8); PG8_WAIT_L(0); PG8_BAR; PG8_MMA(1, 0, At, B0); PG8_MMA(1, 1, At, B1); PG8_BAR; PG8_SCHED;
            } else {
            PG8_LDB(B0, 0, 0); PG8_SCHED; PG8_LDA(At, 0, 0); PG8_STAGE(PG8_SA(1, 1), a1 + hstep, voffA);
            PG8_WAIT_L(8); PG8_BAR; PG8_WAIT_L(0); PG8_MMA(0, 0, At, B0); PG8_BAR; PG8_SCHED;
            PG8_LDB(B1, 0, 1); PG8_STAGE(PG8_SB(0, 0), b2, voffB);
            PG8_BAR; PG8_WAIT_L(0); PG8_MMA(0, 1, At, B1); PG8_BAR;
            PG8_LDA(At, 0, 1); PG8_STAGE(PG8_SA(0, 0), a2, voffA);
            PG8_BAR; PG8_WAIT_L(0); PG8_MMA(1, 0, At, B0); PG8_BAR; PG8_SCHED;
            PG8_STAGE(PG8_SB(0, 1), b2 + hstep, voffB);
            PG8_WAIT_V(6); PG8_BAR; PG8_MMA(1, 1, At, B1); PG8_BAR;
            PG8_LDB(B0, 1, 0); PG8_SCHED; PG8_LDA(At, 1, 0); PG8_STAGE(PG8_SA(0, 1), a2 + hstep, voffA);
            PG8_WAIT_L(8); PG8_BAR; PG8_WAIT_L(0); PG8_MMA(0, 0, At, B0); PG8_BAR; PG8_SCHED;
            PG8_LDB(B1, 1, 1); PG8_STAGE(PG8_SB(1, 0), b3, voffB);
            PG8_BAR; PG8_WAIT_L(0); PG8_MMA(0, 1, At, B1); PG8_BAR;
            PG8_LDA(At, 1, 1); PG8_STAGE(PG8_SA(1, 0), a3, voffA);
            PG8_BAR; PG8_WAIT_L(0); PG8_MMA(1, 0, At, B0); PG8_BAR; PG8_SCHED;
            PG8_STAGE(PG8_SB(1, 1), b3 + hstep, voffB);
            PG8_WAIT_V(6); PG8_BAR; PG8_MMA(1, 1, At, B1); PG8_BAR;
            }
        }
        if constexpr (ALIGN_EPI) { if (wr == 0) PG8_BAR; }
        if constexpr (!Epi::AFTER_DRAIN) { E(acc, cur, wr, wc, fr, fq); S.done(cur); }
        if (!has_next) break;
#pragma unroll
        for (int a = 0; a < 2; ++a)
#pragma unroll
            for (int b = 0; b < 2; ++b)
#pragma unroll
                for (int m = 0; m < 4; ++m)
#pragma unroll
                    for (int n = 0; n < 2; ++n) acc[a][b][m][n] = (f32x4){0.f, 0.f, 0.f, 0.f};
        cur = nxt; cA = nA; cB = nB; ++ui;
        if constexpr (ALIGN_EPI) { if (wr == 1) PG8_BAR; }
    }
    PG8_WAIT_V(0);
    if constexpr (!ALIGN_EPI) { if (wr == 0) PG8_BAR; }
    PG8_BAR;
    if constexpr (Epi::AFTER_DRAIN) { E.fused(acc, cur, wr, wc, fr, fq, lds, wid, lane); S.done(cur); }
#undef PG8_SA
#undef PG8_SB
#undef PG8_STAGE
#undef PG8_LDA
#undef PG8_LDB
#undef PG8_MMA
#undef PG8_WAIT_V
#undef PG8_WAIT_L
#undef PG8_BAR
#undef PG8_SCHED
}
}

#ifndef DIAG_SUB
#define DIAG_SUB -1
#endif
#define RUNSUB(k) (DIAG_SUB < 0 || DIAG_SUB == (k))
#ifndef MK_MULTI
#define MK_MULTI 1
#endif
constexpr int D = 1024, NB = 8, SEQ = 4096, NCTX = 256;
constexpr int ML = NB * SEQ;
constexpr int MC = NB * NCTX;
constexpr int MT = ML + MC;
constexpr int NPAD = 3072, ZLD = 2816;
constexpr float EPS = 1e-6f;
constexpr float LOG2E = 1.4426950408889634f;
constexpr float QSCALE = 0.125f * LOG2E;
constexpr float GQSCALE = 0.17677669529663687f;
constexpr int NCHAIN = 68;
constexpr int NPHASE = 13;
constexpr int LDS_BYTES = 147456;

constexpr size_t MiB = 1u << 20;
constexpr size_t WS_CTL = 0, WS_WINT = 2 * MiB, WS_WOUTT = 14 * MiB, WS_MODV = 18 * MiB, WS_BIASZ = 18 * MiB + 256 * 1024, WS_ROPE = 18 * MiB + 512 * 1024;
constexpr size_t WS_RSS0 = 19 * MiB, WS_RSS1 = 19 * MiB + 256 * 1024, WS_RSS2 = 19 * MiB + 512 * 1024, WS_DEC = 20 * MiB;
constexpr size_t WS_A = 24 * MiB, WS_Y = 92 * MiB, WS_LA = 160 * MiB, WS_ST = 194 * MiB, WS_Z = 228 * MiB, WS_END = 415 * MiB;

#define LAS __attribute__((address_space(3)))
typedef unsigned short bf16_t;
typedef float f32x4 __attribute__((ext_vector_type(4)));
typedef float f32x2 __attribute__((ext_vector_type(2)));
typedef float f32x16 __attribute__((ext_vector_type(16)));
typedef short bf16x8 __attribute__((ext_vector_type(8)));
typedef short s16x4 __attribute__((ext_vector_type(4)));
typedef unsigned u32x4 __attribute__((ext_vector_type(4)));
typedef unsigned u32x2 __attribute__((ext_vector_type(2)));

struct Params {
    const float *x, *c, *ctx, *c_ctx, *w_mod, *b_mod, *w_in, *conv_w, *conv_b, *conv_ln_w, *conv_ln_b, *attn_sink, *gla_w_up, *gla_b_up, *gla_norm_w, *w_out, *final_norm_w;
    float* out; unsigned char* ws;
    int ph_lo, ph_hi;
};
struct WS {
    bf16_t *WinT, *WoutT, *A, *Y, *Z;
    float *modv, *biasz, *rope, *rss0, *rss1, *rss2, *dec, *LA, *ST;
};
__device__ __forceinline__ WS make_ws(unsigned char* ws) {
    WS W; W.WinT = (bf16_t*)(ws + WS_WINT); W.WoutT = (bf16_t*)(ws + WS_WOUTT); W.A = (bf16_t*)(ws + WS_A); W.Y = (bf16_t*)(ws + WS_Y); W.Z = (bf16_t*)(ws + WS_Z);
    W.modv = (float*)(ws + WS_MODV); W.biasz = (float*)(ws + WS_BIASZ); W.rope = (float*)(ws + WS_ROPE); W.rss0 = (float*)(ws + WS_RSS0); W.rss1 = (float*)(ws + WS_RSS1);
    W.rss2 = (float*)(ws + WS_RSS2); W.dec = (float*)(ws + WS_DEC); W.LA = (float*)(ws + WS_LA); W.ST = (float*)(ws + WS_ST); return W;
}

__device__ __forceinline__ unsigned pk2(float lo, float hi) { typedef __bf16 b2 __attribute__((ext_vector_type(2))); f32x2 v = {lo, hi}; b2 b = __builtin_convertvector(v, b2); return __builtin_bit_cast(unsigned, b); }
__device__ __forceinline__ float bflo(unsigned w) { return __uint_as_float(w << 16); }
__device__ __forceinline__ float bfhi(unsigned w) { return __uint_as_float(w & 0xffff0000u); }
__device__ __forceinline__ float silu_f(float v) { return v / (1.f + __expf(-v)); }
__device__ __forceinline__ float sigmoid_f(float v) { return 1.f / (1.f + __expf(-v)); }
__device__ __forceinline__ float wave_sum(float v) {
#pragma unroll
    for (int o = 1; o < 64; o <<= 1) v += __shfl_xor(v, o);
    return v;
}
typedef short v4i16_t __attribute__((ext_vector_type(4)));
__device__ __forceinline__ s16x4 tr_read(const LAS unsigned char* p) { return __builtin_bit_cast(s16x4, __builtin_amdgcn_ds_read_tr16_b64_v4i16((LAS v4i16_t*)p)); }
__device__ __forceinline__ bf16x8 cat8(s16x4 a, s16x4 b) { return (bf16x8){a[0], a[1], a[2], a[3], b[0], b[1], b[2], b[3]}; }
#define MFMA32(a, b, c) __builtin_amdgcn_mfma_f32_32x32x16_bf16((a), (b), (c), 0, 0, 0)
__device__ __forceinline__ bf16x8 pack_acc8(const f32x16& v, int s) {
    u32x4 w; w.x = pk2(v[8 * s + 0], v[8 * s + 1]); w.y = pk2(v[8 * s + 2], v[8 * s + 3]); w.z = pk2(v[8 * s + 4], v[8 * s + 5]); w.w = pk2(v[8 * s + 6], v[8 * s + 7]);
    return __builtin_bit_cast(bf16x8, w);
}

namespace pg8 {
struct EpiIn {
    static constexpr bool PERM = false, AFTER_DRAIN = false;
    bf16_t* Z; float* LA; const float* rss; const float* biasz; const float* rope;
    __device__ __forceinline__ void operator()(const f32x4 (&acc)[2][2][4][2], const Unit& u, int wr, int wc, int fr, int fq) const {
        const int pn = u.pn; const bool latent = u.pm < 128; const int bsel = latent ? (u.pm >> 4) : 8;
        const float* bz = biasz + bsel * NPAD + pn * 256 + wc * 32 + 4 * fq;
        f32x4 bv[2][2];
#pragma unroll
        for (int bj = 0; bj < 2; ++bj)
#pragma unroll
            for (int n = 0; n < 2; ++n) bv[bj][n] = *(const f32x4*)(bz + bj * 128 + n * 16);
        const bool do_rope = latent && (pn == 3 || pn == 4 || (pn == 5 && wc < 2));
        const float qs = (pn == 3 || pn == 4) ? QSCALE : 1.f;
        const float cqs = (pn == 8) ? GQSCALE : 1.f;
#pragma unroll
        for (int ai = 0; ai < 2; ++ai)
#pragma unroll
            for (int m = 0; m < 4; ++m) {
                const int row = u.pm * 256 + ai * 128 + wr * 64 + m * 16 + fr;
                const float rinv = rsqrtf(rss[row] * (1.f / 1024.f) + EPS);
                f32x4 v[2][2];
#pragma unroll
                for (int bj = 0; bj < 2; ++bj)
#pragma unroll
                    for (int n = 0; n < 2; ++n) v[bj][n] = acc[ai][bj][m][n] * rinv + bv[bj][n];
                if (do_rope) {
                    const int t = row & 4095;
#pragma unroll
                    for (int n = 0; n < 2; ++n) {
                        const int pp = (n == 0) ? (t >> 6) : (t & 63);
                        const f32x4 c4 = *(const f32x4*)(rope + pp * 16 + 4 * fq), s4 = *(const f32x4*)(rope + 1024 + pp * 16 + 4 * fq);
                        const f32x4 x1 = v[0][n], x2 = v[1][n];
                        v[0][n] = x1 * c4 - x2 * s4; v[1][n] = x2 * c4 + x1 * s4;
                    }
                }
                if (pn == 11) {
#pragma unroll
                    for (int bj = 0; bj < 2; ++bj)
#pragma unroll
                        for (int n = 0; n < 2; ++n) { f32x4 o;
#pragma unroll
                            for (int e = 0; e < 4; ++e) { const float zz = v[bj][n][e]; o[e] = (fminf(zz, 0.f) - log1pf(__expf(-fabsf(zz)))) * (1.f / 16.f); }
                            *(f32x4*)(LA + (size_t)row * 256 + bj * 128 + wc * 32 + n * 16 + 4 * fq) = o; }
                } else {
#pragma unroll
                    for (int n = 0; n < 2; ++n) { v[0][n] = v[0][n] * (qs * cqs); v[1][n] = v[1][n] * qs; }
                    bf16_t* zr = Z + (size_t)row * ZLD + pn * 256 + wc * 32 + 4 * fq;
#pragma unroll
                    for (int bj = 0; bj < 2; ++bj)
#pragma unroll
                        for (int n = 0; n < 2; ++n) { u32x2 w; w.x = pk2(v[bj][n][0], v[bj][n][1]); w.y = pk2(v[bj][n][2], v[bj][n][3]); *(u32x2*)(zr + bj * 128 + n * 16) = w; }
                }
            }
    }
};
struct EpiOut {
    static constexpr bool PERM = false, AFTER_DRAIN = false;
    const float* xl; const float* xc; float* xout; const float* modv_l; const float* modv_next; bf16_t* Anext; float* rss_out;
    __device__ __forceinline__ void operator()(const f32x4 (&acc)[2][2][4][2], const Unit& u, int wr, int wc, int fr, int fq) const {
        const int pn = u.pn; const bool latent = u.pm < 128; const int bsel = latent ? (u.pm >> 4) : 8;
        const int colb = pn * 256 + wc * 32 + 4 * fq;
        f32x4 g[2][2], sc[2][2];
#pragma unroll
        for (int bj = 0; bj < 2; ++bj)
#pragma unroll
            for (int n = 0; n < 2; ++n) { g[bj][n] = *(const f32x4*)(modv_l + bsel * 3072 + 2048 + colb + bj * 128 + n * 16);
                sc[bj][n] = modv_next ? (*(const f32x4*)(modv_next + bsel * 3072 + 1024 + colb + bj * 128 + n * 16) + 1.f) : (f32x4){0.f, 0.f, 0.f, 0.f}; }
#pragma unroll
        for (int ai = 0; ai < 2; ++ai)
#pragma unroll
            for (int m = 0; m < 4; ++m) {
                const int row = u.pm * 256 + ai * 128 + wr * 64 + m * 16 + fr;
                const float* xin = latent ? xl + (size_t)row * 1024 : xc + (size_t)(row - ML) * 1024;
                float ss = 0.f;
#pragma unroll
                for (int bj = 0; bj < 2; ++bj)
#pragma unroll
                    for (int n = 0; n < 2; ++n) { const int col = colb + bj * 128 + n * 16;
                        const f32x4 x4 = *(const f32x4*)(xin + col); const f32x4 o = x4 + g[bj][n] * acc[ai][bj][m][n];
                        ss += (o[0] * o[0] + o[1] * o[1]) + (o[2] * o[2] + o[3] * o[3]);
                        if (latent) *(f32x4*)(xout + (size_t)row * 1024 + col) = o;
                        if (Anext) { const f32x4 a = o * sc[bj][n]; u32x2 w; w.x = pk2(a[0], a[1]); w.y = pk2(a[2], a[3]); *(u32x2*)(Anext + (size_t)row * 1024 + col) = w; } }
                ss += __shfl_xor(ss, 16); ss += __shfl_xor(ss, 32);
                if (fq == 0) atomicAdd(rss_out + row, ss);
            }
    }
};
}

__device__ __forceinline__ int win_src_col(int n0) {
    if (n0 < 768) return n0;
    if (n0 < 1280) { const int r = n0 - 768, tq = r >> 8, bj = (r >> 7) & 1, wc = (r >> 5) & 3; return 768 + (4 * tq + wc) * 64 + 32 * bj; }
    if (n0 < 1536) { const int r = n0 - 1280, bj = (r >> 7) & 1, wc = (r >> 5) & 3; return wc < 2 ? 1280 + wc * 64 + 32 * bj : 1408 + (wc - 2) * 64 + 32 * bj; }
    if (n0 < 2560) return n0;
    if (n0 < 2816) return n0 + 32;
    return -1;
}
__device__ __forceinline__ void transpose_item(const float* Wsrc, int N, int srccol, const float* wup  , int lrcol, int j0, bf16_t* WT, int n0dst, int k0, LAS float* scr, int lane) {
#pragma unroll 4
    for (int i = 0; i < 32; ++i) {
        const int kk = 2 * i + (lane >> 5), cc = lane & 31; float v;
        if (wup == nullptr) v = Wsrc[(size_t)(k0 + kk) * N + srccol + cc];
        else { v = 0.f; const float* wr_ = Wsrc + (size_t)(k0 + kk) * N + lrcol;
#pragma unroll
            for (int r = 0; r < 16; ++r) v += wr_[r] * wup[r * 128 + j0 + cc]; }
        scr[kk * 33 + cc] = v;
    }
    asm volatile("s_waitcnt lgkmcnt(0)" ::: "memory");
    const int c = lane & 7;
#pragma unroll
    for (int j = 0; j < 4; ++j) { const int n = (lane >> 3) + 8 * j; const LAS float* s = scr + (8 * c) * 33 + n;
        u32x4 o; o.x = pk2(s[0 * 33], s[1 * 33]); o.y = pk2(s[2 * 33], s[3 * 33]); o.z = pk2(s[4 * 33], s[5 * 33]); o.w = pk2(s[6 * 33], s[7 * 33]);
        *(u32x4*)(WT + (size_t)(n0dst + n) * 1024 + k0 + 8 * c) = o; }
    asm volatile("s_waitcnt lgkmcnt(0)" ::: "memory");
}
__device__ __forceinline__ void phase_prep0(const Params& p, const WS& W, LAS unsigned char* lds) {
    int tid_ = threadIdx.x; asm volatile("" : "+v"(tid_)); const int tid = tid_, lane = tid & 63, wave = tid >> 6;
    {
        LAS float* sc = (LAS float*)lds; LAS float* red = sc + 9 * 1024;
        if ((int)blockIdx.x < 192) {
            for (int idx = tid; idx < 9216; idx += 512) { const int r = idx >> 10, k = idx & 1023; const float v = r < 8 ? p.c[r * 1024 + k] : p.c_ctx[k]; sc[idx] = silu_f(v); }
            __syncthreads();
            for (int it = blockIdx.x; it < 192; it += gridDim.x) {
                const int l = it / 96, cb = it % 96, cc = tid & 31, kg = tid >> 5;
                float a[9];
#pragma unroll
                for (int r = 0; r < 9; ++r) a[r] = 0.f;
                const float* wp = p.w_mod + (size_t)l * 1024 * 3072 + (size_t)(kg * 64) * 3072 + cb * 32 + cc;
#pragma unroll 8
                for (int kk = 0; kk < 64; ++kk) { const float w = wp[(size_t)kk * 3072];
#pragma unroll
                    for (int r = 0; r < 9; ++r) a[r] += sc[r * 1024 + kg * 64 + kk] * w; }
#pragma unroll
                for (int r = 0; r < 9; ++r) red[(kg * 9 + r) * 32 + cc] = a[r];
                __syncthreads();
                if (tid < 288) { const int r = tid >> 5; float s = 0.f;
#pragma unroll
                    for (int g = 0; g < 16; ++g) s += red[(g * 9 + r) * 32 + cc];
                    W.modv[(l * 9 + r) * 3072 + cb * 32 + cc] = s + p.b_mod[l * 3072 + cb * 32 + cc]; }
                __syncthreads();
            }
        }
    }
    if (blockIdx.x == gridDim.x - 1) {
        for (int idx = tid; idx < 1024; idx += 512) { const int pp = idx >> 4, f = idx & 15;
            const float inv = __builtin_amdgcn_exp2f(-(float)f * (13.287712379549449f / 16.f)); const float ang = (float)pp * inv;
            W.rope[idx] = __cosf(ang); W.rope[1024 + idx] = __sinf(ang); }
    }
    for (int i = blockIdx.x * 512 + tid; i < MT; i += gridDim.x * 512) { W.rss1[i] = 0.f; if (i < ML) W.rss2[i] = 0.f; }
    __syncthreads();
    {
        LAS float* scr = (LAS float*)(lds + wave * 16384);
        const int gw = blockIdx.x * 8 + wave, NGW = gridDim.x * 8;
        constexpr int I_IN = 96 * 16, I_OUT = 32 * 16, I_L = I_IN + I_OUT;
        for (int it = gw; it < 2 * I_L; it += NGW) {
            const int l = it / I_L; int r = it % I_L;
            if (r < I_IN) { const int nb = r % 96, kb = r / 96, n0 = nb * 32; const int src = win_src_col(n0);
                if (src >= 0) transpose_item(p.w_in + (size_t)l * 1024 * 2848, 2848, src, nullptr, 0, 0, W.WinT + (size_t)l * NPAD * 1024, n0, kb * 64, scr, lane);
                else { const int dir = (n0 - 2816) >> 7, j0 = (n0 - 2816) & 127;
                    transpose_item(p.w_in + (size_t)l * 1024 * 2848, 2848, 0, p.gla_w_up + (size_t)(l * 2 + dir) * 16 * 128, 2560 + 16 * dir, j0, W.WinT + (size_t)l * NPAD * 1024, n0, kb * 64, scr, lane); } }
            else { r -= I_IN; const int nb = r % 32, kb = r / 32;
                transpose_item(p.w_out + (size_t)l * 1024 * 1024, 1024, nb * 32, nullptr, 0, 0, W.WoutT + (size_t)l * 1024 * 1024, nb * 32, kb * 64, scr, lane); }
        }
    }
}

__device__ __forceinline__ void phase_prep1(const Params& p, const WS& W) {
    int tid_ = threadIdx.x; asm volatile("" : "+v"(tid_)); const int tid = tid_, lane = tid & 63, wave = tid >> 6;
    const int gw = blockIdx.x * 8 + wave, NGW = gridDim.x * 8;
    for (int row = gw; row < MT; row += NGW) {
        const bool latent = row < ML; const int bsel = latent ? (row >> 12) : 8;
        const float* xr = latent ? p.x + (size_t)row * 1024 : p.ctx + (size_t)(row - ML) * 1024;
        const float* sc = W.modv + bsel * 3072 + 1024;
        float ss = 0.f; u32x2* ao = (u32x2*)(W.A + (size_t)row * 1024);
#pragma unroll
        for (int j = 0; j < 4; ++j) { const f32x4 v = *(const f32x4*)(xr + j * 256 + lane * 4); const f32x4 s4 = *(const f32x4*)(sc + j * 256 + lane * 4);
            ss += (v[0] * v[0] + v[1] * v[1]) + (v[2] * v[2] + v[3] * v[3]);
            const f32x4 a = v * (s4 + 1.f); u32x2 w; w.x = pk2(a[0], a[1]); w.y = pk2(a[2], a[3]); ao[j * 64 + lane] = w; }
        ss = wave_sum(ss);
        if (lane == 0) W.rss0[row] = ss;
    }
    for (int it = gw; it < 2 * NPAD; it += NGW) {
        const int l = it / NPAD, n = it % NPAD;
        const bf16_t* wrow = W.WinT + ((size_t)l * NPAD + n) * 1024 + lane * 16;
        const u32x4 w0 = *(const u32x4*)wrow, w1 = *(const u32x4*)(wrow + 8);
        float wf[16];
#pragma unroll
        for (int e = 0; e < 4; ++e) { wf[2 * e] = bflo(w0[e]); wf[2 * e + 1] = bfhi(w0[e]); wf[8 + 2 * e] = bflo(w1[e]); wf[8 + 2 * e + 1] = bfhi(w1[e]); }
        float extra = 0.f;
        if (n >= 2816) extra = p.gla_b_up[(l * 2 + ((n - 2816) >> 7)) * 128 + ((n - 2816) & 127)];
#pragma unroll
        for (int r = 0; r < 9; ++r) {
            const float* sh = W.modv + (l * 9 + r) * 3072 + lane * 16; float s = 0.f;
#pragma unroll
            for (int q = 0; q < 4; ++q) { const f32x4 s4 = *(const f32x4*)(sh + 4 * q); s += s4[0] * wf[4 * q] + s4[1] * wf[4 * q + 1] + s4[2] * wf[4 * q + 2] + s4[3] * wf[4 * q + 3]; }
            s = wave_sum(s);
            if (lane == 0) W.biasz[(l * 9 + r) * NPAD + n] = s + extra;
        }
    }
}

__device__ __forceinline__ void conv_unit(const Params& p, const WS& W, int layer, int sidx, int tile, LAS unsigned char* lds) {
    int tid_ = threadIdx.x; asm volatile("" : "+v"(tid_)); const int tid = tid_, lane = tid & 63, wave = tid >> 6;
    const bool isctx = sidx >= 8; const int b = sidx & 7;
    const int L = isctx ? NCTX : SEQ; const int rowbase = isctx ? ML + b * NCTX : b * SEQ; const int t0 = tile * 64;
    LAS float* U = (LAS float*)lds;
    for (int idx = tid; idx < 94 * 32; idx += 512) {
        const int tt = idx >> 5, ch = idx & 31, t = t0 - 15 + tt;
        f32x4 u0 = {0.f, 0.f, 0.f, 0.f}, u1 = {0.f, 0.f, 0.f, 0.f};
        if (t >= 0 && t < L) { const bf16_t* zr = W.Z + (size_t)(rowbase + t) * ZLD + ch * 8; const u32x4 a = *(const u32x4*)zr, g = *(const u32x4*)(zr + 256);
            u0[0] = bflo(a[0]) * sigmoid_f(bflo(g[0])); u0[1] = bfhi(a[0]) * sigmoid_f(bfhi(g[0])); u0[2] = bflo(a[1]) * sigmoid_f(bflo(g[1])); u0[3] = bfhi(a[1]) * sigmoid_f(bfhi(g[1]));
            u1[0] = bflo(a[2]) * sigmoid_f(bflo(g[2])); u1[1] = bfhi(a[2]) * sigmoid_f(bfhi(g[2])); u1[2] = bflo(a[3]) * sigmoid_f(bflo(g[3])); u1[3] = bfhi(a[3]) * sigmoid_f(bfhi(g[3])); }
        *(LAS f32x4*)(U + tt * 256 + ch * 8) = u0; *(LAS f32x4*)(U + tt * 256 + ch * 8 + 4) = u1;
    }
    __syncthreads();
    {
        const int c = tid & 255, half = tid >> 8;
        float uu[62], wgt[31];
#pragma unroll
        for (int i = 0; i < 62; ++i) uu[i] = U[(half * 32 + i) * 256 + c];
#pragma unroll
        for (int j = 0; j < 31; ++j) wgt[j] = p.conv_w[(layer * 31 + j) * 256 + c];
        const float cb = p.conv_b[layer * 256 + c];
        __syncthreads();
#pragma unroll
        for (int t = 0; t < 32; ++t) { float a = cb;
#pragma unroll
            for (int j = 0; j < 31; ++j) a = fmaf(wgt[j], uu[t + j], a);
            U[(half * 32 + t) * 256 + c] = a; }
    }
    __syncthreads();
    {
        const f32x4 lw = *(const f32x4*)(p.conv_ln_w + layer * 256 + lane * 4), lb = *(const f32x4*)(p.conv_ln_b + layer * 256 + lane * 4);
#pragma unroll 2
        for (int tk = 0; tk < 8; ++tk) {
            const int t = wave * 8 + tk; const int row = rowbase + t0 + t;
            const f32x4 v = *(const LAS f32x4*)(U + t * 256 + lane * 4);
            const float mean = wave_sum((v[0] + v[1]) + (v[2] + v[3])) * (1.f / 256.f);
            const f32x4 dv = v - mean;
            const float var = wave_sum((dv[0] * dv[0] + dv[1] * dv[1]) + (dv[2] * dv[2] + dv[3] * dv[3])) * (1.f / 256.f);
            const float rstd = rsqrtf(var + EPS);
            const u32x2 gz = *(const u32x2*)(W.Z + (size_t)row * ZLD + 512 + lane * 4);
            f32x4 y = dv * rstd * lw + lb;
            const float o0 = silu_f(y[0]) * silu_f(bflo(gz.x)), o1 = silu_f(y[1]) * silu_f(bfhi(gz.x)), o2 = silu_f(y[2]) * silu_f(bflo(gz.y)), o3 = silu_f(y[3]) * silu_f(bfhi(gz.y));
            u32x2 w; w.x = pk2(o0, o1); w.y = pk2(o2, o3);
            *(u32x2*)(W.Y + (size_t)row * 1024 + lane * 4) = w;
        }
    }
    __syncthreads();
}

#define GLA_CUMSUM(bc, tot, larow, dir, lane)                                                               \
    do {                                                                                                    \
        _Pragma("unroll") for (int q_ = 0; q_ < 8; ++q_) { const f32x4 t4_ = *(const f32x4*)((larow) + 4 * q_); bc[4 * q_] = t4_[0]; bc[4 * q_ + 1] = t4_[1]; bc[4 * q_ + 2] = t4_[2]; bc[4 * q_ + 3] = t4_[3]; } \
        _Pragma("unroll") for (int d_ = 0; d_ < 32; ++d_) { float x_ = bc[d_];                                \
            if ((dir) == 0) { _Pragma("unroll") for (int o_ = 1; o_ < 64; o_ <<= 1) { const float y_ = __shfl_up(x_, o_); if ((lane) >= o_) x_ += y_; } tot[d_] = __shfl(x_, 63); } \
            else { _Pragma("unroll") for (int o_ = 1; o_ < 64; o_ <<= 1) { const float y_ = __shfl_down(x_, o_); if ((lane) + o_ < 64) x_ += y_; } tot[d_] = __shfl(x_, 0); } \
            bc[d_] = x_; }                                                                                  \
    } while (0)

__device__ __forceinline__ void gla_state_unit(const WS& W, int b, bool isctx, int n, LAS unsigned char* lds) {
    int tid_ = threadIdx.x; asm volatile("" : "+v"(tid_)); const int tid = tid_, lane = tid & 63, wave = __builtin_amdgcn_readfirstlane(tid >> 6);
    const int dir = wave >> 2, h = wave & 3;
    const int row0 = (isctx ? ML + b * NCTX : b * SEQ) + n * 64;
    LAS unsigned char* Vb = lds;
    LAS unsigned char* KW = lds + 49152 + wave * 5120;
#pragma unroll
    for (int i = 0; i < 4; ++i) { const int idx = tid + 512 * i, t = idx >> 5, hh = (idx >> 3) & 3, ch = idx & 7;
        *(LAS u32x4*)(Vb + hh * 12288 + t * 192 + ch * 16) = *(const u32x4*)(W.Z + (size_t)(row0 + t) * ZLD + 2304 + hh * 64 + ch * 8); }
    float bc[32], tot[32];
    const float* larow = W.LA + (size_t)(row0 + lane) * 256 + dir * 128 + h * 32;
    GLA_CUMSUM(bc, tot, larow, dir, lane);
    const int c = dir == 0 ? (isctx ? n : 4 + n) : (isctx ? 3 - n : 67 - n);
    const size_t cbase = (size_t)(((b * 2 + dir) * NCHAIN + c) * 4 + h);
    {
        const bf16_t* kp = W.Z + (size_t)(row0 + lane) * ZLD + 2176 + h * 32;
#pragma unroll
        for (int q = 0; q < 4; ++q) { const u32x4 kk = *(const u32x4*)(kp + 8 * q); u32x4 o;
#pragma unroll
            for (int e = 0; e < 4; ++e) { const int d = 8 * q + 2 * e; o[e] = pk2(bflo(kk[e]) * __expf(tot[d] - bc[d]), bfhi(kk[e]) * __expf(tot[d + 1] - bc[d + 1])); }
            *(LAS u32x4*)(KW + lane * 80 + q * 16) = o; }
        if (lane == (dir == 0 ? 63 : 0)) { float* dp = W.dec + cbase * 32;
#pragma unroll
            for (int q = 0; q < 8; ++q) { f32x4 o = {__expf(bc[4 * q]), __expf(bc[4 * q + 1]), __expf(bc[4 * q + 2]), __expf(bc[4 * q + 3])}; *(f32x4*)(dp + 4 * q) = o; } }
    }
    __syncthreads();
    {
        const int i16 = lane & 15, gi = (lane >> 4) & 1, hi = lane >> 5, l31 = lane & 31;
        const LAS unsigned char* kwb = KW + (i16 >> 2) * 80 + (16 * gi + 4 * (i16 & 3)) * 2 + (8 * hi) * 80;
        const LAS unsigned char* vb = Vb + h * 12288 + (i16 >> 2) * 192 + (16 * gi + 4 * (i16 & 3)) * 2 + (8 * hi) * 192;
        float* stp = W.ST + cbase * 2048;
#pragma unroll
        for (int vt = 0; vt < 2; ++vt) {
            f32x16 acc = {};
#pragma unroll
            for (int s = 0; s < 4; ++s) {
                const bf16x8 a = cat8(tr_read(kwb + (16 * s) * 80), tr_read(kwb + (16 * s + 4) * 80));
                const bf16x8 bb = cat8(tr_read(vb + (16 * s) * 192 + vt * 64), tr_read(vb + (16 * s + 4) * 192 + vt * 64));
                acc = MFMA32(a, bb, acc);
            }
#pragma unroll
            for (int r = 0; r < 16; ++r) { const int d = (r & 3) + 8 * (r >> 2) + 4 * hi; stp[d * 64 + 32 * vt + l31] = acc[r]; }
        }
    }
    __syncthreads();
}

__device__ __forceinline__ void gla_scan(const WS& W) {
    int tid_ = threadIdx.x; asm volatile("" : "+v"(tid_));
    for (int idx = blockIdx.x * 512 + tid_; idx < 131072; idx += gridDim.x * 512) {
        const int v = idx & 63, d = (idx >> 6) & 31, h = (idx >> 11) & 3, bd = idx >> 13;
        float* sp = W.ST + ((size_t)(bd * NCHAIN) * 4 + h) * 2048 + d * 64 + v;
        const float* dp = W.dec + ((size_t)(bd * NCHAIN) * 4 + h) * 32 + d;
        float S = 0.f;
        for (int c0 = 0; c0 < NCHAIN; c0 += 4) {
            float st[4], dc[4];
#pragma unroll
            for (int j = 0; j < 4; ++j) { st[j] = sp[(size_t)(c0 + j) * 8192]; dc[j] = dp[(size_t)(c0 + j) * 128]; }
#pragma unroll
            for (int j = 0; j < 4; ++j) { sp[(size_t)(c0 + j) * 8192] = S; S = dc[j] * S + st[j]; }
        }
    }
}

__device__ __forceinline__ void gla_out_unit(const Params& p, const WS& W, int layer, int b, bool isctx, int n, int hp, LAS unsigned char* lds) {
    int tid_ = threadIdx.x; asm volatile("" : "+v"(tid_)); const int tid = tid_, lane = tid & 63, wave = __builtin_amdgcn_readfirstlane(tid >> 6);
    const int dh = wave >> 1, dir = dh >> 1, hl = dh & 1, h = hp * 2 + hl, th = wave & 1;
    const int row0 = (isctx ? ML + b * NCTX : b * SEQ) + n * 64;
    LAS unsigned char* Vb = lds;
    LAS unsigned char* QK = lds + 24576;
    LAS unsigned char* SI = lds + 65536;
    LAS float* OB = (LAS float*)(lds + 90112);
#pragma unroll
    for (int i = 0; i < 2; ++i) { const int idx = tid + 512 * i, t = idx >> 4, hh = (idx >> 3) & 1, ch = idx & 7;
        *(LAS u32x4*)(Vb + hh * 12288 + t * 192 + ch * 16) = *(const u32x4*)(W.Z + (size_t)(row0 + t) * ZLD + 2304 + (hp * 2 + hh) * 64 + ch * 8); }
#pragma unroll
    for (int i = 0; i < 2; ++i) { const int idx = tid + 512 * i, q = idx >> 8, d = (idx >> 3) & 31, ch = idx & 7;
        const int qdir = q >> 1, qh = hp * 2 + (q & 1);
        const int c = qdir == 0 ? (isctx ? n : 4 + n) : (isctx ? 3 - n : 67 - n);
        const float* sp = W.ST + ((size_t)(((b * 2 + qdir) * NCHAIN + c) * 4 + qh)) * 2048 + d * 64 + ch * 8;
        const f32x4 s0 = *(const f32x4*)sp, s1 = *(const f32x4*)(sp + 4);
        u32x4 o; o.x = pk2(s0[0], s0[1]); o.y = pk2(s0[2], s0[3]); o.z = pk2(s1[0], s1[1]); o.w = pk2(s1[2], s1[3]);
        *(LAS u32x4*)(SI + q * 6144 + d * 192 + ch * 16) = o; }
    if (th == 0) {
        float bc[32], tot[32];
        const float* larow = W.LA + (size_t)(row0 + lane) * 256 + dir * 128 + h * 32;
        GLA_CUMSUM(bc, tot, larow, dir, lane);
        const bf16_t* qp = W.Z + (size_t)(row0 + lane) * ZLD + 2048 + h * 32;
        LAS unsigned char* qi = QK + dh * 10240 + lane * 80; LAS unsigned char* ki = qi + 5120;
#pragma unroll
        for (int q = 0; q < 4; ++q) { const u32x4 qq = *(const u32x4*)(qp + 8 * q), kk = *(const u32x4*)(qp + 128 + 8 * q); u32x4 oq, ok;
#pragma unroll
            for (int e = 0; e < 4; ++e) { const int d = 8 * q + 2 * e; const float e0 = __expf(bc[d]), e1 = __expf(bc[d + 1]);
                oq[e] = pk2(bflo(qq[e]) * e0, bfhi(qq[e]) * e1); ok[e] = pk2(bflo(kk[e]) / e0, bfhi(kk[e]) / e1); }
            *(LAS u32x4*)(qi + q * 16) = oq; *(LAS u32x4*)(ki + q * 16) = ok; }
    }
    __syncthreads();
    const int i16 = lane & 15, gi = (lane >> 4) & 1, hi = lane >> 5, l31 = lane & 31;
    f32x16 o[2];
    {
        const LAS unsigned char* qib = QK + dh * 10240; const LAS unsigned char* kib = qib + 5120;
        bf16x8 qf[2];
#pragma unroll
        for (int s = 0; s < 2; ++s) qf[s] = *(const LAS bf16x8*)(qib + (32 * th + l31) * 80 + (2 * s + hi) * 16);
        f32x16 at[2];
#pragma unroll
        for (int st = 0; st < 2; ++st) { f32x16 a = {};
#pragma unroll
            for (int s = 0; s < 2; ++s) { const bf16x8 kf = *(const LAS bf16x8*)(kib + (32 * st + l31) * 80 + (2 * s + hi) * 16); a = MFMA32(kf, qf[s], a); }
            const int tq = 32 * th + l31;
#pragma unroll
            for (int r = 0; r < 16; ++r) { const int sk = 32 * st + (r & 3) + 8 * (r >> 2) + 4 * hi; const bool keep = dir == 0 ? (sk <= tq) : (sk >= tq); a[r] = keep ? a[r] : 0.f; }
            at[st] = a; }
        const LAS unsigned char* vb = Vb + hl * 12288 + (i16 >> 2) * 192 + (16 * gi + 4 * (i16 & 3)) * 2;
        const LAS unsigned char* sb = SI + dh * 6144 + (i16 >> 2) * 192 + (16 * gi + 4 * (i16 & 3)) * 2 + (8 * hi) * 192;
#pragma unroll
        for (int vt = 0; vt < 2; ++vt) {
            f32x16 acc = {};
#pragma unroll
            for (int st = 0; st < 2; ++st)
#pragma unroll
                for (int sk = 0; sk < 2; ++sk) { const int r0 = 32 * st + 16 * sk + 4 * hi;
                    const bf16x8 a = cat8(tr_read(vb + r0 * 192 + vt * 64), tr_read(vb + (r0 + 8) * 192 + vt * 64));
                    acc = MFMA32(a, pack_acc8(at[st], sk), acc); }
#pragma unroll
            for (int s = 0; s < 2; ++s) { const bf16x8 a = cat8(tr_read(sb + (16 * s) * 192 + vt * 64), tr_read(sb + (16 * s + 4) * 192 + vt * 64)); acc = MFMA32(a, qf[s], acc); }
            o[vt] = acc;
        }
    }
    if (dir == 1) {
#pragma unroll
        for (int vt = 0; vt < 2; ++vt)
#pragma unroll
            for (int r = 0; r < 16; ++r) { const int v = 32 * vt + (r & 3) + 8 * (r >> 2) + 4 * hi; OB[hl * 4096 + v * 64 + 32 * th + l31] = o[vt][r]; }
    }
    __syncthreads();
    if (dir == 0) {
        float ss = 0.f;
#pragma unroll
        for (int vt = 0; vt < 2; ++vt)
#pragma unroll
            for (int r = 0; r < 16; ++r) { const int v = 32 * vt + (r & 3) + 8 * (r >> 2) + 4 * hi; const float x = o[vt][r] + OB[hl * 4096 + v * 64 + 32 * th + l31]; o[vt][r] = x; ss += x * x; }
        ss += __shfl_xor(ss, 32);
        const float rinv = rsqrtf(ss * (1.f / 64.f) + EPS);
        const int row = row0 + 32 * th + l31;
#pragma unroll
        for (int vt = 0; vt < 2; ++vt)
#pragma unroll
            for (int r4 = 0; r4 < 4; ++r4) { const int v = 32 * vt + 8 * r4 + 4 * hi;
                const u32x2 gz = *(const u32x2*)(W.Z + (size_t)row * ZLD + 2560 + h * 64 + v);
                const f32x4 nw = *(const f32x4*)(p.gla_norm_w + layer * 256 + h * 64 + v);
                const float a0 = o[vt][4 * r4] * rinv * nw[0] * silu_f(bflo(gz.x)), a1 = o[vt][4 * r4 + 1] * rinv * nw[1] * silu_f(bfhi(gz.x));
                const float a2 = o[vt][4 * r4 + 2] * rinv * nw[2] * silu_f(bflo(gz.y)), a3 = o[vt][4 * r4 + 3] * rinv * nw[3] * silu_f(bfhi(gz.y));
                u32x2 w; w.x = pk2(a0, a1); w.y = pk2(a2, a3);
                *(u32x2*)(W.Y + (size_t)row * 1024 + 768 + h * 64 + v) = w; }
    }
    __syncthreads();
}

__device__ __forceinline__ void attn_unit(const Params& p, const WS& W, int layer, int b, int g, int qb, bool isctx, LAS unsigned char* lds) {
    int tid_ = threadIdx.x; asm volatile("" : "+v"(tid_)); const int tid = tid_, lane = tid & 63, wave = __builtin_amdgcn_readfirstlane(tid >> 6);
    const int l31 = lane & 31, hi = lane >> 5, i16 = lane & 15, gi = (lane >> 4) & 1;
    const int head = g * 4 + (wave >> 1);
    const int seqbase = isctx ? ML + b * NCTX : b * SEQ;
    const int q0 = qb * 128, tq0 = q0 + (wave & 1) * 64;
    constexpr int KB = 64 * 144, VB = 64 * 192, STG = KB + VB;
    bf16x8 qf[2][4];
#pragma unroll
    for (int ct = 0; ct < 2; ++ct)
#pragma unroll
        for (int ds = 0; ds < 4; ++ds) qf[ct][ds] = *(const bf16x8*)(W.Z + (size_t)(seqbase + tq0 + 32 * ct + l31) * ZLD + 768 + 256 * (head >> 2) + 128 * (ds >> 1) + 32 * (head & 3) + 16 * (ds & 1) + 8 * hi);
    const int jlo = isctx ? 0 : (qb == 0 ? 2 : 0), jhi = isctx ? -1 : (qb == 31 ? 3 : 5);
    const int NT = 4 + (jhi - jlo + 1);
    const int kvr = tid >> 3, ch = tid & 7;
    const int gcolK = 1280 + 128 * (ch >> 2) + 32 * g + 8 * (ch & 3);
    const int ctxbase = ML + b * NCTX;
    const float sink2 = p.attn_sink[layer * 8 + head] * LOG2E;
    float mrun[2] = {sink2, sink2}, lsum[2] = {hi == 0 ? 1.f : 0.f, hi == 0 ? 1.f : 0.f};
    f32x16 O[2][2];
#pragma unroll
    for (int dt = 0; dt < 2; ++dt)
#pragma unroll
        for (int ct = 0; ct < 2; ++ct) O[dt][ct] = (f32x16){};
    u32x4 kreg, vreg;
#define ATT_KROW(ti) ((ti) < 4 ? ctxbase + 64 * (ti) : b * SEQ + q0 - 128 + 64 * (jlo + (ti) - 4))
#define ATT_LOAD(ti) do { const bf16_t* src_ = W.Z + (size_t)(ATT_KROW(ti) + kvr) * ZLD + gcolK; kreg = *(const u32x4*)src_; vreg = *(const u32x4*)(src_ + 64); } while (0)
#define ATT_STORE(st) do { *(LAS u32x4*)(lds + (st) * STG + kvr * 144 + ch * 16) = kreg; *(LAS u32x4*)(lds + (st) * STG + KB + kvr * 192 + ch * 16) = vreg; } while (0)
    ATT_LOAD(0); ATT_STORE(0);
    __syncthreads();
    for (int ti = 0; ti < NT; ++ti) {
        const int st = ti & 1;
        if (ti + 1 < NT) ATT_LOAD(ti + 1);
        bool active = true, need_mask = false; int k0 = 0;
        if (ti >= 4) { k0 = q0 - 128 + 64 * (jlo + ti - 4); active = (k0 + 63 >= tq0 - 128) && (k0 <= tq0 + 191); need_mask = !((k0 >= tq0 - 65) && (k0 <= tq0 + 65)); }
        if (active) {
            const LAS unsigned char* Kb = lds + st * STG; const LAS unsigned char* Vbp = Kb + KB;
            f32x16 s[2][2];
#pragma unroll
            for (int rt = 0; rt < 2; ++rt) {
                s[rt][0] = (f32x16){}; s[rt][1] = (f32x16){};
#pragma unroll
                for (int ds = 0; ds < 4; ++ds) { const bf16x8 kf = *(const LAS bf16x8*)(Kb + (32 * rt + l31) * 144 + (2 * ds + hi) * 16);
                    s[rt][0] = MFMA32(kf, qf[0][ds], s[rt][0]); s[rt][1] = MFMA32(kf, qf[1][ds], s[rt][1]); }
            }
            if (need_mask) {
#pragma unroll
                for (int rt = 0; rt < 2; ++rt)
#pragma unroll
                    for (int ct = 0; ct < 2; ++ct)
#pragma unroll
                        for (int r = 0; r < 16; ++r) { const int kp = k0 + 32 * rt + (r & 3) + 8 * (r >> 2) + 4 * hi, qp = tq0 + 32 * ct + l31; const int dd = qp - kp;
                            if (dd > 128 || dd < -128) s[rt][ct][r] = -1e30f; }
            }
#pragma unroll
            for (int ct = 0; ct < 2; ++ct) {
                float mx = s[0][ct][0];
#pragma unroll
                for (int r = 1; r < 16; ++r) mx = fmaxf(mx, s[0][ct][r]);
#pragma unroll
                for (int r = 0; r < 16; ++r) mx = fmaxf(mx, s[1][ct][r]);
                mx = fmaxf(mx, __shfl_xor(mx, 32));
                const float mnew = fmaxf(mrun[ct], mx); const float alpha = __builtin_amdgcn_exp2f(mrun[ct] - mnew); mrun[ct] = mnew;
                float ls = 0.f;
#pragma unroll
                for (int rt = 0; rt < 2; ++rt)
#pragma unroll
                    for (int r = 0; r < 16; ++r) { const float pe = __builtin_amdgcn_exp2f(s[rt][ct][r] - mnew); s[rt][ct][r] = pe; ls += pe; }
                lsum[ct] = lsum[ct] * alpha + ls;
#pragma unroll
                for (int dt = 0; dt < 2; ++dt) O[dt][ct] = O[dt][ct] * alpha;
            }
            const LAS unsigned char* vb = Vbp + (i16 >> 2) * 192 + (16 * gi + 4 * (i16 & 3)) * 2;
#pragma unroll
            for (int rt = 0; rt < 2; ++rt)
#pragma unroll
                for (int sk = 0; sk < 2; ++sk) {
                    const bf16x8 p0 = pack_acc8(s[rt][0], sk), p1 = pack_acc8(s[rt][1], sk);
                    const int r0 = 32 * rt + 16 * sk + 4 * hi;
#pragma unroll
                    for (int dt = 0; dt < 2; ++dt) { const bf16x8 vf = cat8(tr_read(vb + r0 * 192 + dt * 64), tr_read(vb + (r0 + 8) * 192 + dt * 64));
                        O[dt][0] = MFMA32(vf, p0, O[dt][0]); O[dt][1] = MFMA32(vf, p1, O[dt][1]); }
                }
        }
        if (ti + 1 < NT) ATT_STORE(st ^ 1);
        __syncthreads();
    }
#undef ATT_KROW
#undef ATT_LOAD
#undef ATT_STORE
#pragma unroll
    for (int ct = 0; ct < 2; ++ct) {
        const float lt = lsum[ct] + __shfl_xor(lsum[ct], 32); const float inv = 1.f / lt;
        const int row = seqbase + tq0 + 32 * ct + l31;
#pragma unroll
        for (int dt = 0; dt < 2; ++dt)
#pragma unroll
            for (int r4 = 0; r4 < 4; ++r4) { const int d = 32 * dt + 8 * r4 + 4 * hi;
                const u32x2 gz = *(const u32x2*)(W.Z + (size_t)row * ZLD + 1536 + head * 64 + d);
                const float a0 = O[dt][ct][4 * r4] * inv * silu_f(bflo(gz.x)), a1 = O[dt][ct][4 * r4 + 1] * inv * silu_f(bfhi(gz.x));
                const float a2 = O[dt][ct][4 * r4 + 2] * inv * silu_f(bflo(gz.y)), a3 = O[dt][ct][4 * r4 + 3] * inv * silu_f(bfhi(gz.y));
                u32x2 w; w.x = pk2(a0, a1); w.y = pk2(a2, a3);
                *(u32x2*)(W.Y + (size_t)row * 1024 + 256 + head * 64 + d) = w; }
    }
}

__device__ __forceinline__ void phase_final(const Params& p, const WS& W) {
    int tid_ = threadIdx.x; asm volatile("" : "+v"(tid_)); const int tid = tid_, lane = tid & 63, wave = tid >> 6;
    const int gw = blockIdx.x * 8 + wave, NGW = gridDim.x * 8;
    f32x4 fw[4];
#pragma unroll
    for (int j = 0; j < 4; ++j) fw[j] = *(const f32x4*)(p.final_norm_w + j * 256 + lane * 4);
    for (int row = gw; row < ML; row += NGW) {
        const float rinv = rsqrtf(W.rss2[row] * (1.f / 1024.f) + EPS);
        float* xr = p.out + (size_t)row * 1024;
#pragma unroll
        for (int j = 0; j < 4; ++j) { const f32x4 v = *(const f32x4*)(xr + j * 256 + lane * 4); *(f32x4*)(xr + j * 256 + lane * 4) = v * rinv * fw[j]; }
    }
}

__global__ void __launch_bounds__(512, 2) fwd_kernel(Params p) {
    extern __shared__ __attribute__((aligned(16))) unsigned char lds_raw[];
    LAS unsigned char* lds = (LAS unsigned char*)lds_raw;
    const int G = gridDim.x;
    for (int ph = p.ph_lo; ph < p.ph_hi; ++ph) {
        if (ph > p.ph_lo) { cg::this_grid().sync(); }
        unsigned char* wsb = p.ws; asm volatile("" : "+s"(wsb));
        int bx = blockIdx.x; asm volatile("" : "+s"(bx));
        const WS W = make_ws(wsb);
        if (RUNSUB(10) && ph == 0) { phase_prep0(p, W, lds); }
        else if (RUNSUB(11) && ph == 1) { phase_prep1(p, W); }
        else if (RUNSUB(12) && ph == 12) { phase_final(p, W); }
        else if (ph >= 2 && ph < 12) {
            const int layer = (ph - 2) / 5, sub = (ph - 2) % 5;
            if (RUNSUB(0) && sub == 0) {
                pg8::Gemm gm{W.A, W.WinT + (size_t)layer * NPAD * 1024, MT, NPAD, 1024}; pg8::StaticOrder S; S.init(MT, NPAD, G, bx);
                pg8::EpiIn E{W.Z, W.LA, layer == 0 ? W.rss0 : W.rss1, W.biasz + layer * 9 * NPAD, W.rope};
                pg8::gemm_phase<pg8::EpiIn, pg8::StaticOrder, true, true>(lds, gm, S, E);
            } else if ((RUNSUB(1) || RUNSUB(5)) && sub == 1) {
                const int nconv = layer == 0 ? 544 : 512;
                if (RUNSUB(1)) for (int u = bx; u < nconv; u += G) { if (u < 512) conv_unit(p, W, layer, u >> 6, u & 63, lds); else conv_unit(p, W, layer, 8 + ((u - 512) >> 2), (u - 512) & 3, lds); }
                if (RUNSUB(5)) for (int u = bx; u < 544; u += G) { if (u < 512) gla_state_unit(W, u >> 6, false, u & 63, lds); else gla_state_unit(W, (u - 512) >> 2, true, (u - 512) & 3, lds); }
            } else if (RUNSUB(2) && sub == 2) {
                gla_scan(W);
                const int natt = layer == 0 ? 544 : 512;
                for (int u = bx; u < natt; u += G) { if (u < 512) attn_unit(p, W, layer, u >> 6, (u >> 5) & 1, u & 31, false, lds); else { const int v = u - 512; attn_unit(p, W, layer, v >> 2, (v >> 1) & 1, v & 1, true, lds); } }
            } else if (RUNSUB(3) && sub == 3) {
                const int nu = layer == 0 ? 1088 : 1024;
                for (int u = bx; u < nu; u += G) { if (u < 1024) gla_out_unit(p, W, layer, u >> 7, false, (u >> 1) & 63, u & 1, lds); else { const int v = u - 1024; gla_out_unit(p, W, layer, v >> 3, true, (v >> 1) & 3, v & 1, lds); } }
            } else if (RUNSUB(4) && sub == 4) {
                const int Mo = layer == 0 ? MT : ML;
                pg8::Gemm gm{W.Y, W.WoutT + (size_t)layer * 1024 * 1024, Mo, 1024, 1024}; pg8::StaticOrder S; S.init(Mo, 1024, G, bx);
                pg8::EpiOut E{layer == 0 ? p.x : p.out, p.ctx, p.out, W.modv + layer * 9 * 3072, layer == 0 ? W.modv + 9 * 3072 : nullptr, layer == 0 ? W.A : nullptr, layer == 0 ? W.rss1 : W.rss2};
                pg8::gemm_phase<pg8::EpiOut, pg8::StaticOrder, true, true>(lds, gm, S, E);
            }
        }
    }
}

extern "C" void kernel_launch(void* const* d_in, const int* in_sizes, int n_in, void* d_out, int out_size, void* d_ws, size_t ws_size, hipStream_t stream) {
    static int grid = 0;
    if (grid == 0) {
        if (n_in != 17 || out_size != ML * D || ws_size < WS_END) { fprintf(stderr, "kernel_launch: unexpected shapes (n_in %d, out %d, ws %zu)\n", n_in, out_size, ws_size); grid = -1; return; }
        int dev = 0, cus = 0, per_cu = 0;
        hipGetDevice(&dev); hipDeviceGetAttribute(&cus, hipDeviceAttributeMultiprocessorCount, dev);
        hipFuncSetAttribute((const void*)fwd_kernel, hipFuncAttributeMaxDynamicSharedMemorySize, LDS_BYTES);
        hipOccupancyMaxActiveBlocksPerMultiprocessor(&per_cu, (const void*)fwd_kernel, 512, LDS_BYTES);
        if (per_cu < 1) { fprintf(stderr, "kernel_launch: occupancy query says %d blocks/CU\n", per_cu); per_cu = 1; }
        (void)hipGetLastError();
        grid = cus;
    }
    if (grid < 0) return;
    Params p{};
    p.x = (const float*)d_in[0]; p.c = (const float*)d_in[1]; p.ctx = (const float*)d_in[2]; p.c_ctx = (const float*)d_in[3]; p.w_mod = (const float*)d_in[4]; p.b_mod = (const float*)d_in[5];
    p.w_in = (const float*)d_in[6]; p.conv_w = (const float*)d_in[7]; p.conv_b = (const float*)d_in[8]; p.conv_ln_w = (const float*)d_in[9]; p.conv_ln_b = (const float*)d_in[10];
    p.attn_sink = (const float*)d_in[11]; p.gla_w_up = (const float*)d_in[12]; p.gla_b_up = (const float*)d_in[13]; p.gla_norm_w = (const float*)d_in[14]; p.w_out = (const float*)d_in[15];
    p.final_norm_w = (const float*)d_in[16]; p.out = (float*)d_out; p.ws = (unsigned char*)d_ws;
#if MK_MULTI
    for (int ph = 0; ph < NPHASE; ++ph) { p.ph_lo = ph; p.ph_hi = ph + 1; hipLaunchKernelGGL(fwd_kernel, dim3(grid), dim3(512), LDS_BYTES, stream, p); }
#else
    p.ph_lo = 0; p.ph_hi = NPHASE;
    void* args[] = {&p};
    hipError_t e = hipLaunchCooperativeKernel((void*)fwd_kernel, dim3(grid), dim3(512), args, LDS_BYTES, stream);
    if (e != hipSuccess) fprintf(stderr, "cooperative launch failed: %s (grid %d)\n", hipGetErrorString(e), grid);
#endif
}
```

```cpp
#include <hip/hip_runtime.h>
#include <hip/hip_cooperative_groups.h>
#include <cstdio>
#include <cstdint>
namespace cg = cooperative_groups;
namespace pg8 {
#define PG8_LAS __attribute__((address_space(3)))
typedef unsigned short bf16_t;
typedef short bf16x8 __attribute__((ext_vector_type(8)));
typedef float f32x4 __attribute__((ext_vector_type(4)));
typedef unsigned u32x4 __attribute__((ext_vector_type(4)));
constexpr int BM = 256, BK = 64, HALF = 128, HTB = HALF * BK * 2  , STAGE_BYTES = 8 * HTB, NXCD = 8, WGM = 8;

__host__ __device__ __forceinline__ int lds_byte(int r, int c) { const int st = (r >> 4) * 2 + (c >> 5), rr = r & 15, cc = c & 31, ob = rr * 64 + cc * 2; return st * 1024 + (ob ^ (((ob >> 9) & 1) << 5)); }
__host__ __device__ __forceinline__ void stage_rc(int b, int& R, int& C) { const int st = b / 1024, sb = b % 1024, swz = sb ^ (((sb >> 9) & 1) << 5); R = (st >> 1) * 16 + swz / 64; C = (st & 1) * 32 + (swz % 64) / 2; }
__host__ __device__ __forceinline__ int perm32(int rho) { const int n = rho >> 4, i = rho & 15; return 8 * (i >> 2) + 4 * n + (i & 3); }

struct Unit { int pm, pn; };
struct Gemm { const bf16_t* A; const bf16_t* Bt; int M, N, K; };

struct StaticOrder {
    int nM, nN, nwg, G, c;
    __host__ __device__ void init(int M, int N, int G_, int c_) { nM = M / BM; nN = N / BM; nwg = nM * nN; G = G_; c = c_; }
    __host__ __device__ bool next(int i, Unit& u) const {
        const long L = (long)i * G + c; if (L >= nwg) return false;
        int wgid = (int)L; { const int q = nwg / NXCD, r = nwg % NXCD, xcd = wgid % NXCD, off = wgid / NXCD; wgid = (xcd < r ? xcd * (q + 1) : r * (q + 1) + (xcd - r) * q) + off; }
        const int nig = WGM * nN, gid = wgid / nig, fm = gid * WGM, gsz = (nM - fm) < WGM ? (nM - fm) : WGM;
        u.pm = fm + ((wgid % nig) % gsz); u.pn = (wgid % nig) / gsz; return true;
    }
    __device__ __forceinline__ void a_ready(const Unit&) const {}
    __device__ __forceinline__ void done(const Unit&) const {}
};
__device__ __forceinline__ unsigned cvt_pk_bf16(float lo, float hi) { unsigned r; asm volatile("v_cvt_pk_bf16_f32 %0, %1, %2" : "=v"(r) : "v"(lo), "v"(hi)); return r; }
template <class Epi, class Sched, bool ALIGN_EPI = false, bool SP2 = false>
__device__ __forceinline__ void gemm_phase(PG8_LAS unsigned char* lds, const Gemm g, const Sched& S, const Epi& E) {
    int tid_ = threadIdx.x; asm volatile("" : "+v"(tid_)); const int tid = tid_, wid = __builtin_amdgcn_readfirstlane(tid >> 6), lane = tid & 63, wr = wid >> 2, wc = wid & 3, fr = lane & 15, fq = lane >> 4;
    const int K = g.K, nt = K / BK;
    unsigned voffA[2], voffB[2];
#pragma unroll
    for (int i = 0; i < 2; ++i) { int R, C; stage_rc(tid * 16 + i * 8192, R, C); const int Rb = Epi::PERM ? ((R & ~31) + perm32(R & 31)) : R;
        voffA[i] = (unsigned)(R * K + C) * 2u; voffB[i] = (unsigned)(Rb * K + C) * 2u; }
    const size_t kstep = (size_t)(BK * 2);
    const size_t hstep = (size_t)HALF * K * 2;
    const size_t tstep = 2 * hstep;
    const unsigned ldsw = (unsigned)wid * 1024u;
    const int aoff = lds_byte(wr * 64 + fr, fq * 8), boff = lds_byte(wc * 32 + fr, fq * 8);
#define PG8_SA(b, h) (((b) * 2 + (h)) * HTB)
#define PG8_SB(b, h) ((4 + (b) * 2 + (h)) * HTB)
#define PG8_STAGE(bufoff, gbase, voff) do { _Pragma("unroll") for (int _i = 0; _i < 2; ++_i) \
        __builtin_amdgcn_global_load_lds((const unsigned*)((const char*)(gbase) + (voff)[_i]), (PG8_LAS unsigned*)(lds + (bufoff) + ldsw + _i * 8192), 16, 0, 0); } while (0)
#define PG8_LDA(dst, b, h) do { _Pragma("unroll") for (int m = 0; m < 4; ++m) _Pragma("unroll") for (int k = 0; k < 2; ++k) dst[m][k] = *(const PG8_LAS bf16x8*)(lds + PG8_SA(b, h) + aoff + m * 2048 + k * 1024); } while (0)
#define PG8_LDB(dst, b, h) do { _Pragma("unroll") for (int n = 0; n < 2; ++n) _Pragma("unroll") for (int k = 0; k < 2; ++k) dst[n][k] = *(const PG8_LAS bf16x8*)(lds + PG8_SB(b, h) + boff + n * 2048 + k * 1024); } while (0)
#define PG8_MMA(ai, bj, At, Bt) do { __builtin_amdgcn_s_setprio(1); _Pragma("unroll") for (int m = 0; m < 4; ++m) _Pragma("unroll") for (int n = 0; n < 2; ++n) _Pragma("unroll") for (int k = 0; k < 2; ++k) \
        acc[ai][bj][m][n] = __builtin_amdgcn_mfma_f32_16x16x32_bf16(Bt[n][k], At[m][k], acc[ai][bj][m][n], 0, 0, 0); __builtin_amdgcn_s_setprio(0); } while (0)
#define PG8_WAIT_V(n) asm volatile("s_waitcnt vmcnt(" #n ")" ::: "memory")
#define PG8_WAIT_L(n) asm volatile("s_waitcnt lgkmcnt(" #n ")" ::: "memory")
#define PG8_BAR __builtin_amdgcn_s_barrier()
#define PG8_SCHED __builtin_amdgcn_sched_barrier(0)
    Unit cur, nxt; int ui = 0;
    if (!S.next(0, cur)) return;
    f32x4 acc[2][2][4][2];
#pragma unroll
    for (int a = 0; a < 2; ++a)
#pragma unroll
        for (int b = 0; b < 2; ++b)
#pragma unroll
            for (int m = 0; m < 4; ++m)
#pragma unroll
                for (int n = 0; n < 2; ++n) acc[a][b][m][n] = (f32x4){0.f, 0.f, 0.f, 0.f};
    bf16x8 At[4][2], B0[2][2], B1[2][2];
    const char* cA = (const char*)g.A + (size_t)cur.pm * tstep; const char* cB = (const char*)g.Bt + (size_t)cur.pn * tstep;
    S.a_ready(cur);
    if constexpr (SP2) {
        PG8_STAGE(PG8_SB(0, 0), cB, voffB); PG8_STAGE(PG8_SB(0, 1), cB + hstep, voffB); PG8_STAGE(PG8_SA(0, 0), cA, voffA); PG8_STAGE(PG8_SA(0, 1), cA + hstep, voffA);
        if (wr == 1) PG8_BAR;
        PG8_WAIT_V(2); PG8_BAR;
        PG8_STAGE(PG8_SB(1, 0), cB + kstep, voffB); PG8_STAGE(PG8_SA(1, 0), cA + kstep, voffA); PG8_STAGE(PG8_SB(1, 1), cB + hstep + kstep, voffB);
        PG8_WAIT_V(6); PG8_BAR;
    } else {
        PG8_STAGE(PG8_SB(0, 0), cB, voffB); PG8_STAGE(PG8_SA(0, 0), cA, voffA); PG8_STAGE(PG8_SB(0, 1), cB + hstep, voffB); PG8_STAGE(PG8_SA(0, 1), cA + hstep, voffA);
        if (wr == 1) PG8_BAR;
        PG8_WAIT_V(4); PG8_BAR;
        PG8_STAGE(PG8_SB(1, 0), cB + kstep, voffB); PG8_STAGE(PG8_SA(1, 0), cA + kstep, voffA); PG8_STAGE(PG8_SB(1, 1), cB + hstep + kstep, voffB);
        PG8_WAIT_V(6); PG8_BAR;
    }
    for (;;) {
        const bool has_next = S.next(ui + 1, nxt);
        const char* nA = has_next ? (const char*)g.A + (size_t)nxt.pm * tstep : cA; const char* nB = has_next ? (const char*)g.Bt + (size_t)nxt.pn * tstep : cB;
        for (int t = 0; t < nt; t += 2) {
            const bool last = (t == nt - 2);
            const char* a1 = cA + (size_t)(t + 1) * kstep;
            const char* a2 = last ? nA : cA + (size_t)(t + 2) * kstep; const char* b2 = last ? nB : cB + (size_t)(t + 2) * kstep;
            const char* a3 = a2 + kstep; const char* b3 = b2 + kstep;
            if (last && has_next) S.a_ready(nxt);
            if constexpr (SP2) {
            PG8_LDB(B0, 0, 0); PG8_LDB(B1, 0, 1); PG8_SCHED; PG8_LDA(At, 0, 0); PG8_STAGE(PG8_SA(1, 1), a1 + hstep, voffA);
            PG8_WAIT_V(8); PG8_WAIT_L(0); PG8_BAR; PG8_MMA(0, 0, At, B0); PG8_MMA(0, 1, At, B1); PG8_BAR; PG8_SCHED;
            PG8_LDA(At, 0, 1); PG8_STAGE(PG8_SB(0, 0), b2, voffB); PG8_STAGE(PG8_SB(0, 1), b2 + hstep, voffB); PG8_STAGE(PG8_SA(0, 0), a2, voffA);
            PG8_WAIT_V(8); PG8_WAIT_L(0); PG8_BAR; PG8_MMA(1, 0, At, B0); PG8_MMA(1, 1, At, B1); PG8_BAR; PG8_SCHED;
            PG8_LDB(B0, 1, 0); PG8_LDB(B1, 1, 1); PG8_SCHED; PG8_LDA(At, 1, 0); PG8_STAGE(PG8_SA(0, 1), a2 + hstep, voffA);
            PG8_WAIT_V(8); PG8_WAIT_L(0); PG8_BAR; PG8_MMA(0, 0, At, B0); PG8_MMA(0, 1, At, B1); PG8_BAR; PG8_SCHED;
            PG8_LDA(At, 1, 1); PG8_STAGE(PG8_SB(1, 0), b3, voffB); PG8_STAGE(PG8_SB(1, 1), b3 + hstep, voffB); PG8_STAGE(PG8_SA(1, 0), a3, voffA);
            PG8_WAIT_V(8); PG8_WAIT_L(0); PG8_BAR; PG8_MMA(1, 0, At, B0); PG8_MMA(1, 1, At, B1); PG8_BAR; PG8_SCHED;
            } else {
            PG8_LDB(B0, 0, 0); PG8_SCHED; PG8_LDA(At, 0, 0); PG8_STAGE(PG8_SA(1, 1), a1 + hstep, voffA);
            PG8_WAIT_L(8); PG8_BAR; PG8_WAIT_L(0); PG8_MMA(0, 0, At, B0); PG8_BAR; PG8_SCHED;
            PG8_LDB(B1, 0, 1); PG8_STAGE(PG8_SB(0, 0), b2, voffB);
            PG8_BAR; PG8_WAIT_L(0); PG8_MMA(0, 1, At, B1); PG8_BAR;
            PG8_LDA(At, 0, 1); PG8_STAGE(PG8_SA(0, 0), a2, voffA);
            PG8_BAR; PG8_WAIT_L(0); PG8_MMA(1, 0, At, B0); PG8_BAR; PG8_SCHED;
            PG8_STAGE(PG8_SB(0, 1), b2 + hstep, voffB);
            PG8_WAIT_V(6); PG8_BAR; PG8_MMA(1, 1, At, B1); PG8_BAR;
            PG8_LDB(B0, 1, 0); PG8_SCHED; PG8_LDA(At, 1, 0); PG8_STAGE(PG8_SA(0, 1), a2 + hstep, voffA);
            PG8_WAIT_L(8); PG8_BAR; PG8_WAIT_L(0); PG8_MMA(0, 0, At, B0); PG8_BAR; PG8_SCHED;
            PG8_LDB(B1, 1, 1); PG8_STAGE(PG8_SB(1, 0), b3, voffB);
            PG8_BAR; PG8_WAIT_L(0); PG8_MMA(0, 1, At, B1); PG8_BAR;
            PG8_LDA(At, 1, 1); PG8_STAGE(PG8_SA(1, 0), a3, voffA);
            PG8_BAR; PG8_WAIT_L(0); PG8_MMA(1, 0, At, B0); PG8_BAR; PG8_SCHED;
            PG8_STAGE(PG8_SB(1, 1), b3 + hstep, voffB);
            PG8_WAIT_V(6); PG8_BAR; PG8_MMA(1, 1, At, B1); PG8_BAR;
            }
        }
        if constexpr (ALIGN_EPI) { if (wr == 0) PG8_BAR; }
        if constexpr (!Epi::AFTER_DRAIN) { E(acc, cur, wr, wc, fr, fq); S.done(cur); }
        if (!has_next) break;
#pragma unroll
        for (int a = 0; a < 2; ++a)
#pragma unroll
            for (int b = 0; b < 2; ++b)
#pragma unroll
                for (int m = 0; m < 4; ++m)
#pragma unroll
                    for (int n = 0; n < 2; ++n) acc[a][b][m][n] = (f32x4){0.f, 0.f, 0.f, 0.f};
        cur = nxt; cA = nA; cB = nB; ++ui;
        if constexpr (ALIGN_EPI) { if (wr == 1) PG8_BAR; }
    }
    PG8_WAIT_V(0);
    if constexpr (!ALIGN_EPI) { if (wr == 0) PG8_BAR; }
    PG8_BAR;
    if constexpr (Epi::AFTER_DRAIN) { E.fused(acc, cur, wr, wc, fr, fq, lds, wid, lane); S.done(cur); }
#undef PG8_SA
#undef PG8_SB
#undef PG8_STAGE
#undef PG8_LDA
#undef PG8_LDB
#undef PG8_MMA
#undef PG8_WAIT_V
#undef PG8_WAIT_L
#undef PG8_BAR
#undef PG8_SCHED
}
}

#ifndef DIAG_SUB
#define DIAG_SUB -1
#endif
#define RUNSUB(k) (DIAG_SUB < 0 || DIAG_SUB == (k))
#ifndef MK_MULTI
#define MK_MULTI 0
#endif
constexpr int D = 1024, NB = 8, SEQ = 4096, NCTX = 256;
constexpr int ML = NB * SEQ;
constexpr int MC = NB * NCTX;
constexpr int MT = ML + MC;
constexpr int NPAD = 3072, ZLD = 2816;
constexpr float EPS = 1e-6f;
constexpr float LOG2E = 1.4426950408889634f;
constexpr float QSCALE = 0.125f * LOG2E;
constexpr float GQSCALE = 0.17677669529663687f;
constexpr int NCHAIN = 68;
constexpr int NPHASE = 13;
constexpr int LDS_BYTES = 147456;

constexpr size_t MiB = 1u << 20;
constexpr size_t WS_CTL = 0, WS_WINT = 2 * MiB, WS_WOUTT = 14 * MiB, WS_MODV = 18 * MiB, WS_BIASZ = 18 * MiB + 256 * 1024, WS_ROPE = 18 * MiB + 512 * 1024;
constexpr size_t WS_RSS0 = 19 * MiB, WS_RSS1 = 19 * MiB + 256 * 1024, WS_RSS2 = 19 * MiB + 512 * 1024, WS_DEC = 20 * MiB;
constexpr size_t WS_A = 24 * MiB, WS_Y = 92 * MiB, WS_LA = 160 * MiB, WS_ST = 194 * MiB, WS_Z = 228 * MiB, WS_END = 415 * MiB;

#define LAS __attribute__((address_space(3)))
typedef unsigned short bf16_t;
typedef float f32x4 __attribute__((ext_vector_type(4)));
typedef float f32x2 __attribute__((ext_vector_type(2)));
typedef float f32x16 __attribute__((ext_vector_type(16)));
typedef short bf16x8 __attribute__((ext_vector_type(8)));
typedef short s16x4 __attribute__((ext_vector_type(4)));
typedef unsigned u32x4 __attribute__((ext_vector_type(4)));
typedef unsigned u32x2 __attribute__((ext_vector_type(2)));

struct Params {
    const float *x, *c, *ctx, *c_ctx, *w_mod, *b_mod, *w_in, *conv_w, *conv_b, *conv_ln_w, *conv_ln_b, *attn_sink, *gla_w_up, *gla_b_up, *gla_norm_w, *w_out, *final_norm_w;
    float* out; unsigned char* ws;
    int ph_lo, ph_hi;
};
struct WS {
    bf16_t *WinT, *WoutT, *A, *Y, *Z;
    float *modv, *biasz, *rope, *rss0, *rss1, *rss2, *dec, *LA, *ST;
};
__device__ __forceinline__ WS make_ws(unsigned char* ws) {
    WS W; W.WinT = (bf16_t*)(ws + WS_WINT); W.WoutT = (bf16_t*)(ws + WS_WOUTT); W.A = (bf16_t*)(ws + WS_A); W.Y = (bf16_t*)(ws + WS_Y); W.Z = (bf16_t*)(ws + WS_Z);
    W.modv = (float*)(ws + WS_MODV); W.biasz = (float*)(ws + WS_BIASZ); W.rope = (float*)(ws + WS_ROPE); W.rss0 = (float*)(ws + WS_RSS0); W.rss1 = (float*)(ws + WS_RSS1);
    W.rss2 = (float*)(ws + WS_RSS2); W.dec = (float*)(ws + WS_DEC); W.LA = (float*)(ws + WS_LA); W.ST = (float*)(ws + WS_ST); return W;
}

__device__ __forceinline__ unsigned pk2(float lo, float hi) { typedef __bf16 b2 __attribute__((ext_vector_type(2))); f32x2 v = {lo, hi}; b2 b = __builtin_convertvector(v, b2); return __builtin_bit_cast(unsigned, b); }
__device__ __forceinline__ float bflo(unsigned w) { return __uint_as_float(w << 16); }
__device__ __forceinline__ float bfhi(unsigned w) { return __uint_as_float(w & 0xffff0000u); }
__device__ __forceinline__ float silu_f(float v) { return v / (1.f + __expf(-v)); }
__device__ __forceinline__ float sigmoid_f(float v) { return 1.f / (1.f + __expf(-v)); }
__device__ __forceinline__ float wave_sum(float v) {
#pragma unroll
    for (int o = 1; o < 64; o <<= 1) v += __shfl_xor(v, o);
    return v;
}
typedef short v4i16_t __attribute__((ext_vector_type(4)));
__device__ __forceinline__ s16x4 tr_read(const LAS unsigned char* p) { return __builtin_bit_cast(s16x4, __builtin_amdgcn_ds_read_tr16_b64_v4i16((LAS v4i16_t*)p)); }
__device__ __forceinline__ bf16x8 cat8(s16x4 a, s16x4 b) { return (bf16x8){a[0], a[1], a[2], a[3], b[0], b[1], b[2], b[3]}; }
#define MFMA32(a, b, c) __builtin_amdgcn_mfma_f32_32x32x16_bf16((a), (b), (c), 0, 0, 0)
__device__ __forceinline__ bf16x8 pack_acc8(const f32x16& v, int s) {
    u32x4 w; w.x = pk2(v[8 * s + 0], v[8 * s + 1]); w.y = pk2(v[8 * s + 2], v[8 * s + 3]); w.z = pk2(v[8 * s + 4], v[8 * s + 5]); w.w = pk2(v[8 * s + 6], v[8 * s + 7]);
    return __builtin_bit_cast(bf16x8, w);
}

namespace pg8 {
struct EpiIn {
    static constexpr bool PERM = false, AFTER_DRAIN = false;
    bf16_t* Z; float* LA; const float* rss; const float* biasz; const float* rope;
    __device__ __forceinline__ void operator()(const f32x4 (&acc)[2][2][4][2], const Unit& u, int wr, int wc, int fr, int fq) const {
        const int pn = u.pn; const bool latent = u.pm < 128; const int bsel = latent ? (u.pm >> 4) : 8;
        const float* bz = biasz + bsel * NPAD + pn * 256 + wc * 32 + 4 * fq;
        f32x4 bv[2][2];
#pragma unroll
        for (int bj = 0; bj < 2; ++bj)
#pragma unroll
            for (int n = 0; n < 2; ++n) bv[bj][n] = *(const f32x4*)(bz + bj * 128 + n * 16);
        const bool do_rope = latent && (pn == 3 || pn == 4 || (pn == 5 && wc < 2));
        const float qs = (pn == 3 || pn == 4) ? QSCALE : 1.f;
        const float cqs = (pn == 8) ? GQSCALE : 1.f;
#pragma unroll
        for (int ai = 0; ai < 2; ++ai)
#pragma unroll
            for (int m = 0; m < 4; ++m) {
                const int row = u.pm * 256 + ai * 128 + wr * 64 + m * 16 + fr;
                const float rinv = rsqrtf(rss[row] * (1.f / 1024.f) + EPS);
                f32x4 v[2][2];
#pragma unroll
                for (int bj = 0; bj < 2; ++bj)
#pragma unroll
                    for (int n = 0; n < 2; ++n) v[bj][n] = acc[ai][bj][m][n] * rinv + bv[bj][n];
                if (do_rope) {
                    const int t = row & 4095;
#pragma unroll
                    for (int n = 0; n < 2; ++n) {
                        const int pp = (n == 0) ? (t >> 6) : (t & 63);
                        const f32x4 c4 = *(const f32x4*)(rope + pp * 16 + 4 * fq), s4 = *(const f32x4*)(rope + 1024 + pp * 16 + 4 * fq);
                        const f32x4 x1 = v[0][n], x2 = v[1][n];
                        v[0][n] = x1 * c4 - x2 * s4; v[1][n] = x2 * c4 + x1 * s4;
                    }
                }
                if (pn == 11) {
#pragma unroll
                    for (int bj = 0; bj < 2; ++bj)
#pragma unroll
                        for (int n = 0; n < 2; ++n) { f32x4 o;
#pragma unroll
                            for (int e = 0; e < 4; ++e) { const float zz = v[bj][n][e]; o[e] = (fminf(zz, 0.f) - log1pf(__expf(-fabsf(zz)))) * (1.f / 16.f); }
                            *(f32x4*)(LA + (size_t)row * 256 + bj * 128 + wc * 32 + n * 16 + 4 * fq) = o; }
                } else {
#pragma unroll
                    for (int n = 0; n < 2; ++n) { v[0][n] = v[0][n] * (qs * cqs); v[1][n] = v[1][n] * qs; }
                    bf16_t* zr = Z + (size_t)row * ZLD + pn * 256 + wc * 32 + 4 * fq;
#pragma unroll
                    for (int bj = 0; bj < 2; ++bj)
#pragma unroll
                        for (int n = 0; n < 2; ++n) { u32x2 w; w.x = pk2(v[bj][n][0], v[bj][n][1]); w.y = pk2(v[bj][n][2], v[bj][n][3]); *(u32x2*)(zr + bj * 128 + n * 16) = w; }
                }
            }
    }
};
struct EpiOut {
    static constexpr bool PERM = false, AFTER_DRAIN = false;
    const float* xl; const float* xc; float* xout; const float* modv_l; const float* modv_next; bf16_t* Anext; float* rss_out;
    __device__ __forceinline__ void operator()(const f32x4 (&acc)[2][2][4][2], const Unit& u, int wr, int wc, int fr, int fq) const {
        const int pn = u.pn; const bool latent = u.pm < 128; const int bsel = latent ? (u.pm >> 4) : 8;
        const int colb = pn * 256 + wc * 32 + 4 * fq;
        f32x4 g[2][2], sc[2][2];
#pragma unroll
        for (int bj = 0; bj < 2; ++bj)
#pragma unroll
            for (int n = 0; n < 2; ++n) { g[bj][n] = *(const f32x4*)(modv_l + bsel * 3072 + 2048 + colb + bj * 128 + n * 16);
                sc[bj][n] = modv_next ? (*(const f32x4*)(modv_next + bsel * 3072 + 1024 + colb + bj * 128 + n * 16) + 1.f) : (f32x4){0.f, 0.f, 0.f, 0.f}; }
#pragma unroll
        for (int ai = 0; ai < 2; ++ai)
#pragma unroll
            for (int m = 0; m < 4; ++m) {
                const int row = u.pm * 256 + ai * 128 + wr * 64 + m * 16 + fr;
                const float* xin = latent ? xl + (size_t)row * 1024 : xc + (size_t)(row - ML) * 1024;
                float ss = 0.f;
#pragma unroll
                for (int bj = 0; bj < 2; ++bj)
#pragma unroll
                    for (int n = 0; n < 2; ++n) { const int col = colb + bj * 128 + n * 16;
                        const f32x4 x4 = *(const f32x4*)(xin + col); const f32x4 o = x4 + g[bj][n] * acc[ai][bj][m][n];
                        ss += (o[0] * o[0] + o[1] * o[1]) + (o[2] * o[2] + o[3] * o[3]);
                        if (latent) *(f32x4*)(xout + (size_t)row * 1024 + col) = o;
                        if (Anext) { const f32x4 a = o * sc[bj][n]; u32x2 w; w.x = pk2(a[0], a[1]); w.y = pk2(a[2], a[3]); *(u32x2*)(Anext + (size_t)row * 1024 + col) = w; } }
                ss += __shfl_xor(ss, 16); ss += __shfl_xor(ss, 32);
                if (fq == 0) atomicAdd(rss_out + row, ss);
            }
    }
};
}

__device__ __forceinline__ int win_src_col(int n0) {
    if (n0 < 768) return n0;
    if (n0 < 1280) { const int r = n0 - 768, tq = r >> 8, bj = (r >> 7) & 1, wc = (r >> 5) & 3; return 768 + (4 * tq + wc) * 64 + 32 * bj; }
    if (n0 < 1536) { const int r = n0 - 1280, bj = (r >> 7) & 1, wc = (r >> 5) & 3; return wc < 2 ? 1280 + wc * 64 + 32 * bj : 1408 + (wc - 2) * 64 + 32 * bj; }
    if (n0 < 2560) return n0;
    if (n0 < 2816) return n0 + 32;
    return -1;
}
__device__ __forceinline__ void transpose_item(const float* Wsrc, int N, int srccol, const float* wup  , int lrcol, int j0, bf16_t* WT, int n0dst, int k0, LAS float* scr, int lane) {
#pragma unroll 4
    for (int i = 0; i < 32; ++i) {
        const int kk = 2 * i + (lane >> 5), cc = lane & 31; float v;
        if (wup == nullptr) v = Wsrc[(size_t)(k0 + kk) * N + srccol + cc];
        else { v = 0.f; const float* wr_ = Wsrc + (size_t)(k0 + kk) * N + lrcol;
#pragma unroll
            for (int r = 0; r < 16; ++r) v += wr_[r] * wup[r * 128 + j0 + cc]; }
        scr[kk * 33 + cc] = v;
    }
    asm volatile("s_waitcnt lgkmcnt(0)" ::: "memory");
    const int c = lane & 7;
#pragma unroll
    for (int j = 0; j < 4; ++j) { const int n = (lane >> 3) + 8 * j; const LAS float* s = scr + (8 * c) * 33 + n;
        u32x4 o; o.x = pk2(s[0 * 33], s[1 * 33]); o.y = pk2(s[2 * 33], s[3 * 33]); o.z = pk2(s[4 * 33], s[5 * 33]); o.w = pk2(s[6 * 33], s[7 * 33]);
        *(u32x4*)(WT + (size_t)(n0dst + n) * 1024 + k0 + 8 * c) = o; }
    asm volatile("s_waitcnt lgkmcnt(0)" ::: "memory");
}
__device__ __forceinline__ void phase_prep0(const Params& p, const WS& W, LAS unsigned char* lds) {
    int tid_ = threadIdx.x; asm volatile("" : "+v"(tid_)); const int tid = tid_, lane = tid & 63, wave = tid >> 6;
    {
        LAS float* sc = (LAS float*)lds; LAS float* red = sc + 9 * 1024;
        if ((int)blockIdx.x < 192) {
            for (int idx = tid; idx < 9216; idx += 512) { const int r = idx >> 10, k = idx & 1023; const float v = r < 8 ? p.c[r * 1024 + k] : p.c_ctx[k]; sc[idx] = silu_f(v); }
            __syncthreads();
            for (int it = blockIdx.x; it < 192; it += gridDim.x) {
                const int l = it / 96, cb = it % 96, cc = tid & 31, kg = tid >> 5;
                float a[9];
#pragma unroll
                for (int r = 0; r < 9; ++r) a[r] = 0.f;
                const float* wp = p.w_mod + (size_t)l * 1024 * 3072 + (size_t)(kg * 64) * 3072 + cb * 32 + cc;
#pragma unroll 8
                for (int kk = 0; kk < 64; ++kk) { const float w = wp[(size_t)kk * 3072];
#pragma unroll
                    for (int r = 0; r < 9; ++r) a[r] += sc[r * 1024 + kg * 64 + kk] * w; }
#pragma unroll
                for (int r = 0; r < 9; ++r) red[(kg * 9 + r) * 32 + cc] = a[r];
                __syncthreads();
                if (tid < 288) { const int r = tid >> 5; float s = 0.f;
#pragma unroll
                    for (int g = 0; g < 16; ++g) s += red[(g * 9 + r) * 32 + cc];
                    W.modv[(l * 9 + r) * 3072 + cb * 32 + cc] = s + p.b_mod[l * 3072 + cb * 32 + cc]; }
                __syncthreads();
            }
        }
    }
    if (blockIdx.x == gridDim.x - 1) {
        for (int idx = tid; idx < 1024; idx += 512) { const int pp = idx >> 4, f = idx & 15;
            const float inv = __builtin_amdgcn_exp2f(-(float)f * (13.287712379549449f / 16.f)); const float ang = (float)pp * inv;
            W.rope[idx] = __cosf(ang); W.rope[1024 + idx] = __sinf(ang); }
    }
    for (int i = blockIdx.x * 512 + tid; i < MT; i += gridDim.x * 512) { W.rss1[i] = 0.f; if (i < ML) W.rss2[i] = 0.f; }
    __syncthreads();
    {
        LAS float* scr = (LAS float*)(lds + wave * 16384);
        const int gw = blockIdx.x * 8 + wave, NGW = gridDim.x * 8;
        constexpr int I_IN = 96 * 16, I_OUT = 32 * 16, I_L = I_IN + I_OUT;
        for (int it = gw; it < 2 * I_L; it += NGW) {
            const int l = it / I_L; int r = it % I_L;
            if (r < I_IN) { const int nb = r % 96, kb = r / 96, n0 = nb * 32; const int src = win_src_col(n0);
                if (src >= 0) transpose_item(p.w_in + (size_t)l * 1024 * 2848, 2848, src, nullptr, 0, 0, W.WinT + (size_t)l * NPAD * 1024, n0, kb * 64, scr, lane);
                else { const int dir = (n0 - 2816) >> 7, j0 = (n0 - 2816) & 127;
                    transpose_item(p.w_in + (size_t)l * 1024 * 2848, 2848, 0, p.gla_w_up + (size_t)(l * 2 + dir) * 16 * 128, 2560 + 16 * dir, j0, W.WinT + (size_t)l * NPAD * 1024, n0, kb * 64, scr, lane); } }
            else { r -= I_IN; const int nb = r % 32, kb = r / 32;
                transpose_item(p.w_out + (size_t)l * 1024 * 1024, 1024, nb * 32, nullptr, 0, 0, W.WoutT + (size_t)l * 1024 * 1024, nb * 32, kb * 64, scr, lane); }
        }
    }
}

__device__ __forceinline__ void phase_prep1(const Params& p, const WS& W) {
    int tid_ = threadIdx.x; asm volatile("" : "+v"(tid_)); const int tid = tid_, lane = tid & 63, wave = tid >> 6;
    const int gw = blockIdx.x * 8 + wave, NGW = gridDim.x * 8;
    for (int row = gw; row < MT; row += NGW) {
        const bool latent = row < ML; const int bsel = latent ? (row >> 12) : 8;
        const float* xr = latent ? p.x + (size_t)row * 1024 : p.ctx + (size_t)(row - ML) * 1024;
        const float* sc = W.modv + bsel * 3072 + 1024;
        float ss = 0.f; u32x2* ao = (u32x2*)(W.A + (size_t)row * 1024);
#pragma unroll
        for (int j = 0; j < 4; ++j) { const f32x4 v = *(const f32x4*)(xr + j * 256 + lane * 4); const f32x4 s4 = *(const f32x4*)(sc + j * 256 + lane * 4);
            ss += (v[0] * v[0] + v[1] * v[1]) + (v[2] * v[2] + v[3] * v[3]);
            const f32x4 a = v * (s4 + 1.f); u32x2 w; w.x = pk2(a[0], a[1]); w.y = pk2(a[2], a[3]); ao[j * 64 + lane] = w; }
        ss = wave_sum(ss);
        if (lane == 0) W.rss0[row] = ss;
    }
    for (int it = gw; it < 2 * NPAD; it += NGW) {
        const int l = it / NPAD, n = it % NPAD;
        const bf16_t* wrow = W.WinT + ((size_t)l * NPAD + n) * 1024 + lane * 16;
        const u32x4 w0 = *(const u32x4*)wrow, w1 = *(const u32x4*)(wrow + 8);
        float wf[16];
#pragma unroll
        for (int e = 0; e < 4; ++e) { wf[2 * e] = bflo(w0[e]); wf[2 * e + 1] = bfhi(w0[e]); wf[8 + 2 * e] = bflo(w1[e]); wf[8 + 2 * e + 1] = bfhi(w1[e]); }
        float extra = 0.f;
        if (n >= 2816) extra = p.gla_b_up[(l * 2 + ((n - 2816) >> 7)) * 128 + ((n - 2816) & 127)];
#pragma unroll
        for (int r = 0; r < 9; ++r) {
            const float* sh = W.modv + (l * 9 + r) * 3072 + lane * 16; float s = 0.f;
#pragma unroll
            for (int q = 0; q < 4; ++q) { const f32x4 s4 = *(const f32x4*)(sh + 4 * q); s += s4[0] * wf[4 * q] + s4[1] * wf[4 * q + 1] + s4[2] * wf[4 * q + 2] + s4[3] * wf[4 * q + 3]; }
            s = wave_sum(s);
            if (lane == 0) W.biasz[(l * 9 + r) * NPAD + n] = s + extra;
        }
    }
}

__device__ __forceinline__ void conv_unit(const Params& p, const WS& W, int layer, int sidx, int tile, LAS unsigned char* lds) {
    int tid_ = threadIdx.x; asm volatile("" : "+v"(tid_)); const int tid = tid_, lane = tid & 63, wave = tid >> 6;
    const bool isctx = sidx >= 8; const int b = sidx & 7;
    const int L = isctx ? NCTX : SEQ; const int rowbase = isctx ? ML + b * NCTX : b * SEQ; const int t0 = tile * 64;
    LAS float* U = (LAS float*)lds;
    for (int idx = tid; idx < 94 * 32; idx += 512) {
        const int tt = idx >> 5, ch = idx & 31, t = t0 - 15 + tt;
        f32x4 u0 = {0.f, 0.f, 0.f, 0.f}, u1 = {0.f, 0.f, 0.f, 0.f};
        if (t >= 0 && t < L) { const bf16_t* zr = W.Z + (size_t)(rowbase + t) * ZLD + ch * 8; const u32x4 a = *(const u32x4*)zr, g = *(const u32x4*)(zr + 256);
            u0[0] = bflo(a[0]) * sigmoid_f(bflo(g[0])); u0[1] = bfhi(a[0]) * sigmoid_f(bfhi(g[0])); u0[2] = bflo(a[1]) * sigmoid_f(bflo(g[1])); u0[3] = bfhi(a[1]) * sigmoid_f(bfhi(g[1]));
            u1[0] = bflo(a[2]) * sigmoid_f(bflo(g[2])); u1[1] = bfhi(a[2]) * sigmoid_f(bfhi(g[2])); u1[2] = bflo(a[3]) * sigmoid_f(bflo(g[3])); u1[3] = bfhi(a[3]) * sigmoid_f(bfhi(g[3])); }
        *(LAS f32x4*)(U + tt * 256 + ch * 8) = u0; *(LAS f32x4*)(U + tt * 256 + ch * 8 + 4) = u1;
    }
    __syncthreads();
    {
        const int c = tid & 255, half = tid >> 8;
        float uu[62], wgt[31];
#pragma unroll
        for (int i = 0; i < 62; ++i) uu[i] = U[(half * 32 + i) * 256 + c];
#pragma unroll
        for (int j = 0; j < 31; ++j) wgt[j] = p.conv_w[(layer * 31 + j) * 256 + c];
        const float cb = p.conv_b[layer * 256 + c];
        __syncthreads();
#pragma unroll
        for (int t = 0; t < 32; ++t) { float a = cb;
#pragma unroll
            for (int j = 0; j < 31; ++j) a = fmaf(wgt[j], uu[t + j], a);
            U[(half * 32 + t) * 256 + c] = a; }
    }
    __syncthreads();
    {
        const f32x4 lw = *(const f32x4*)(p.conv_ln_w + layer * 256 + lane * 4), lb = *(const f32x4*)(p.conv_ln_b + layer * 256 + lane * 4);
#pragma unroll 2
        for (int tk = 0; tk < 8; ++tk) {
            const int t = wave * 8 + tk; const int row = rowbase + t0 + t;
            const f32x4 v = *(const LAS f32x4*)(U + t * 256 + lane * 4);
            const float mean = wave_sum((v[0] + v[1]) + (v[2] + v[3])) * (1.f / 256.f);
            const f32x4 dv = v - mean;
            const float var = wave_sum((dv[0] * dv[0] + dv[1] * dv[1]) + (dv[2] * dv[2] + dv[3] * dv[3])) * (1.f / 256.f);
            const float rstd = rsqrtf(var + EPS);
            const u32x2 gz = *(const u32x2*)(W.Z + (size_t)row * ZLD + 512 + lane * 4);
            f32x4 y = dv * rstd * lw + lb;
            const float o0 = silu_f(y[0]) * silu_f(bflo(gz.x)), o1 = silu_f(y[1]) * silu_f(bfhi(gz.x)), o2 = silu_f(y[2]) * silu_f(bflo(gz.y)), o3 = silu_f(y[3]) * silu_f(bfhi(gz.y));
            u32x2 w; w.x = pk2(o0, o1); w.y = pk2(o2, o3);
            *(u32x2*)(W.Y + (size_t)row * 1024 + lane * 4) = w;
        }
    }
    __syncthreads();
}

#define GLA_CUMSUM(bc, tot, larow, dir, lane)                                                               \
    do {                                                                                                    \
        _Pragma("unroll") for (int q_ = 0; q_ < 8; ++q_) { const f32x4 t4_ = *(const f32x4*)((larow) + 4 * q_); bc[4 * q_] = t4_[0]; bc[4 * q_ + 1] = t4_[1]; bc[4 * q_ + 2] = t4_[2]; bc[4 * q_ + 3] = t4_[3]; } \
        _Pragma("unroll") for (int d_ = 0; d_ < 32; ++d_) { float x_ = bc[d_];                                \
            if ((dir) == 0) { _Pragma("unroll") for (int o_ = 1; o_ < 64; o_ <<= 1) { const float y_ = __shfl_up(x_, o_); if ((lane) >= o_) x_ += y_; } tot[d_] = __shfl(x_, 63); } \
            else { _Pragma("unroll") for (int o_ = 1; o_ < 64; o_ <<= 1) { const float y_ = __shfl_down(x_, o_); if ((lane) + o_ < 64) x_ += y_; } tot[d_] = __shfl(x_, 0); } \
            bc[d_] = x_; }                                                                                  \
    } while (0)

__device__ __forceinline__ void gla_state_unit(const WS& W, int b, bool isctx, int n, LAS unsigned char* lds) {
    int tid_ = threadIdx.x; asm volatile("" : "+v"(tid_)); const int tid = tid_, lane = tid & 63, wave = __builtin_amdgcn_readfirstlane(tid >> 6);
    const int dir = wave >> 2, h = wave & 3;
    const int row0 = (isctx ? ML + b * NCTX : b * SEQ) + n * 64;
    LAS unsigned char* Vb = lds;
    LAS unsigned char* KW = lds + 49152 + wave * 5120;
#pragma unroll
    for (int i = 0; i < 4; ++i) { const int idx = tid + 512 * i, t = idx >> 5, hh = (idx >> 3) & 3, ch = idx & 7;
        *(LAS u32x4*)(Vb + hh * 12288 + t * 192 + ch * 16) = *(const u32x4*)(W.Z + (size_t)(row0 + t) * ZLD + 2304 + hh * 64 + ch * 8); }
    float bc[32], tot[32];
    const float* larow = W.LA + (size_t)(row0 + lane) * 256 + dir * 128 + h * 32;
    GLA_CUMSUM(bc, tot, larow, dir, lane);
    const int c = dir == 0 ? (isctx ? n : 4 + n) : (isctx ? 3 - n : 67 - n);
    const size_t cbase = (size_t)(((b * 2 + dir) * NCHAIN + c) * 4 + h);
    {
        const bf16_t* kp = W.Z + (size_t)(row0 + lane) * ZLD + 2176 + h * 32;
#pragma unroll
        for (int q = 0; q < 4; ++q) { const u32x4 kk = *(const u32x4*)(kp + 8 * q); u32x4 o;
#pragma unroll
            for (int e = 0; e < 4; ++e) { const int d = 8 * q + 2 * e; o[e] = pk2(bflo(kk[e]) * __expf(tot[d] - bc[d]), bfhi(kk[e]) * __expf(tot[d + 1] - bc[d + 1])); }
            *(LAS u32x4*)(KW + lane * 80 + q * 16) = o; }
        if (lane == (dir == 0 ? 63 : 0)) { float* dp = W.dec + cbase * 32;
#pragma unroll
            for (int q = 0; q < 8; ++q) { f32x4 o = {__expf(bc[4 * q]), __expf(bc[4 * q + 1]), __expf(bc[4 * q + 2]), __expf(bc[4 * q + 3])}; *(f32x4*)(dp + 4 * q) = o; } }
    }
    __syncthreads();
    {
        const int i16 = lane & 15, gi = (lane >> 4) & 1, hi = lane >> 5, l31 = lane & 31;
        const LAS unsigned char* kwb = KW + (i16 >> 2) * 80 + (16 * gi + 4 * (i16 & 3)) * 2 + (8 * hi) * 80;
        const LAS unsigned char* vb = Vb + h * 12288 + (i16 >> 2) * 192 + (16 * gi + 4 * (i16 & 3)) * 2 + (8 * hi) * 192;
        float* stp = W.ST + cbase * 2048;
#pragma unroll
        for (int vt = 0; vt < 2; ++vt) {
            f32x16 acc = {};
#pragma unroll
            for (int s = 0; s < 4; ++s) {
                const bf16x8 a = cat8(tr_read(kwb + (16 * s) * 80), tr_read(kwb + (16 * s + 4) * 80));
                const bf16x8 bb = cat8(tr_read(vb + (16 * s) * 192 + vt * 64), tr_read(vb + (16 * s + 4) * 192 + vt * 64));
                acc = MFMA32(a, bb, acc);
            }
#pragma unroll
            for (int r = 0; r < 16; ++r) { const int d = (r & 3) + 8 * (r >> 2) + 4 * hi; stp[d * 64 + 32 * vt + l31] = acc[r]; }
        }
    }
    __syncthreads();
}

__device__ __forceinline__ void gla_scan(const WS& W) {
    int tid_ = threadIdx.x; asm volatile("" : "+v"(tid_));
    for (int idx = blockIdx.x * 512 + tid_; idx < 131072; idx += gridDim.x * 512) {
        const int v = idx & 63, d = (idx >> 6) & 31, h = (idx >> 11) & 3, bd = idx >> 13;
        float* sp = W.ST + ((size_t)(bd * NCHAIN) * 4 + h) * 2048 + d * 64 + v;
        const float* dp = W.dec + ((size_t)(bd * NCHAIN) * 4 + h) * 32 + d;
        float S = 0.f;
        for (int c0 = 0; c0 < NCHAIN; c0 += 4) {
            float st[4], dc[4];
#pragma unroll
            for (int j = 0; j < 4; ++j) { st[j] = sp[(size_t)(c0 + j) * 8192]; dc[j] = dp[(size_t)(c0 + j) * 128]; }
#pragma unroll
            for (int j = 0; j < 4; ++j) { sp[(size_t)(c0 + j) * 8192] = S; S = dc[j] * S + st[j]; }
        }
    }
}

__device__ __forceinline__ void gla_out_unit(const Params& p, const WS& W, int layer, int b, bool isctx, int n, int hp, LAS unsigned char* lds) {
    int tid_ = threadIdx.x; asm volatile("" : "+v"(tid_)); const int tid = tid_, lane = tid & 63, wave = __builtin_amdgcn_readfirstlane(tid >> 6);
    const int dh = wave >> 1, dir = dh >> 1, hl = dh & 1, h = hp * 2 + hl, th = wave & 1;
    const int row0 = (isctx ? ML + b * NCTX : b * SEQ) + n * 64;
    LAS unsigned char* Vb = lds;
    LAS unsigned char* QK = lds + 24576;
    LAS unsigned char* SI = lds + 65536;
    LAS float* OB = (LAS float*)(lds + 90112);
#pragma unroll
    for (int i = 0; i < 2; ++i) { const int idx = tid + 512 * i, t = idx >> 4, hh = (idx >> 3) & 1, ch = idx & 7;
        *(LAS u32x4*)(Vb + hh * 12288 + t * 192 + ch * 16) = *(const u32x4*)(W.Z + (size_t)(row0 + t) * ZLD + 2304 + (hp * 2 + hh) * 64 + ch * 8); }
#pragma unroll
    for (int i = 0; i < 2; ++i) { const int idx = tid + 512 * i, q = idx >> 8, d = (idx >> 3) & 31, ch = idx & 7;
        const int qdir = q >> 1, qh = hp * 2 + (q & 1);
        const int c = qdir == 0 ? (isctx ? n : 4 + n) : (isctx ? 3 - n : 67 - n);
        const float* sp = W.ST + ((size_t)(((b * 2 + qdir) * NCHAIN + c) * 4 + qh)) * 2048 + d * 64 + ch * 8;
        const f32x4 s0 = *(const f32x4*)sp, s1 = *(const f32x4*)(sp + 4);
        u32x4 o; o.x = pk2(s0[0], s0[1]); o.y = pk2(s0[2], s0[3]); o.z = pk2(s1[0], s1[1]); o.w = pk2(s1[2], s1[3]);
        *(LAS u32x4*)(SI + q * 6144 + d * 192 + ch * 16) = o; }
    if (th == 0) {
        float bc[32], tot[32];
        const float* larow = W.LA + (size_t)(row0 + lane) * 256 + dir * 128 + h * 32;
        GLA_CUMSUM(bc, tot, larow, dir, lane);
        const bf16_t* qp = W.Z + (size_t)(row0 + lane) * ZLD + 2048 + h * 32;
        LAS unsigned char* qi = QK + dh * 10240 + lane * 80; LAS unsigned char* ki = qi + 5120;
#pragma unroll
        for (int q = 0; q < 4; ++q) { const u32x4 qq = *(const u32x4*)(qp + 8 * q), kk = *(const u32x4*)(qp + 128 + 8 * q); u32x4 oq, ok;
#pragma unroll
            for (int e = 0; e < 4; ++e) { const int d = 8 * q + 2 * e; const float e0 = __expf(bc[d]), e1 = __expf(bc[d + 1]);
                oq[e] = pk2(bflo(qq[e]) * e0, bfhi(qq[e]) * e1); ok[e] = pk2(bflo(kk[e]) / e0, bfhi(kk[e]) / e1); }
            *(LAS u32x4*)(qi + q * 16) = oq; *(LAS u32x4*)(ki + q * 16) = ok; }
    }
    __syncthreads();
    const int i16 = lane & 15, gi = (lane >> 4) & 1, hi = lane >> 5, l31 = lane & 31;
    f32x16 o[2];
    {
        const LAS unsigned char* qib = QK + dh * 10240; const LAS unsigned char* kib = qib + 5120;
        bf16x8 qf[2];
#pragma unroll
        for (int s = 0; s < 2; ++s) qf[s] = *(const LAS bf16x8*)(qib + (32 * th + l31) * 80 + (2 * s + hi) * 16);
        f32x16 at[2];
#pragma unroll
        for (int st = 0; st < 2; ++st) { f32x16 a = {};
#pragma unroll
            for (int s = 0; s < 2; ++s) { const bf16x8 kf = *(const LAS bf16x8*)(kib + (32 * st + l31) * 80 + (2 * s + hi) * 16); a = MFMA32(kf, qf[s], a); }
            const int tq = 32 * th + l31;
#pragma unroll
            for (int r = 0; r < 16; ++r) { const int sk = 32 * st + (r & 3) + 8 * (r >> 2) + 4 * hi; const bool keep = dir == 0 ? (sk <= tq) : (sk >= tq); a[r] = keep ? a[r] : 0.f; }
            at[st] = a; }
        const LAS unsigned char* vb = Vb + hl * 12288 + (i16 >> 2) * 192 + (16 * gi + 4 * (i16 & 3)) * 2;
        const LAS unsigned char* sb = SI + dh * 6144 + (i16 >> 2) * 192 + (16 * gi + 4 * (i16 & 3)) * 2 + (8 * hi) * 192;
#pragma unroll
        for (int vt = 0; vt < 2; ++vt) {
            f32x16 acc = {};
#pragma unroll
            for (int st = 0; st < 2; ++st)
#pragma unroll
                for (int sk = 0; sk < 2; ++sk) { const int r0 = 32 * st + 16 * sk + 4 * hi;
                    const bf16x8 a = cat8(tr_read(vb + r0 * 192 + vt * 64), tr_read(vb + (r0 + 8) * 192 + vt * 64));
                    acc = MFMA32(a, pack_acc8(at[st], sk), acc); }
#pragma unroll
            for (int s = 0; s < 2; ++s) { const bf16x8 a = cat8(tr_read(sb + (16 * s) * 192 + vt * 64), tr_read(sb + (16 * s + 4) * 192 + vt * 64)); acc = MFMA32(a, qf[s], acc); }
            o[vt] = acc;
        }
    }
    if (dir == 1) {
#pragma unroll
        for (int vt = 0; vt < 2; ++vt)
#pragma unroll
            for (int r = 0; r < 16; ++r) { const int v = 32 * vt + (r & 3) + 8 * (r >> 2) + 4 * hi; OB[hl * 4096 + v * 64 + 32 * th + l31] = o[vt][r]; }
    }
    __syncthreads();
    if (dir == 0) {
        float ss = 0.f;
#pragma unroll
        for (int vt = 0; vt < 2; ++vt)
#pragma unroll
            for (int r = 0; r < 16; ++r) { const int v = 32 * vt + (r & 3) + 8 * (r >> 2) + 4 * hi; const float x = o[vt][r] + OB[hl * 4096 + v * 64 + 32 * th + l31]; o[vt][r] = x; ss += x * x; }
        ss += __shfl_xor(ss, 32);
        const float rinv = rsqrtf(ss * (1.f / 64.f) + EPS);
        const int row = row0 + 32 * th + l31;
#pragma unroll
        for (int vt = 0; vt < 2; ++vt)
#pragma unroll
            for (int r4 = 0; r4 < 4; ++r4) { const int v = 32 * vt + 8 * r4 + 4 * hi;
                const u32x2 gz = *(const u32x2*)(W.Z + (size_t)row * ZLD + 2560 + h * 64 + v);
                const f32x4 nw = *(const f32x4*)(p.gla_norm_w + layer * 256 + h * 64 + v);
                const float a0 = o[vt][4 * r4] * rinv * nw[0] * silu_f(bflo(gz.x)), a1 = o[vt][4 * r4 + 1] * rinv * nw[1] * silu_f(bfhi(gz.x));
                const float a2 = o[vt][4 * r4 + 2] * rinv * nw[2] * silu_f(bflo(gz.y)), a3 = o[vt][4 * r4 + 3] * rinv * nw[3] * silu_f(bfhi(gz.y));
                u32x2 w; w.x = pk2(a0, a1); w.y = pk2(a2, a3);
                *(u32x2*)(W.Y + (size_t)row * 1024 + 768 + h * 64 + v) = w; }
    }
    __syncthreads();
}

__device__ __forceinline__ void attn_unit(const Params& p, const WS& W, int layer, int b, int g, int qb, bool isctx, LAS unsigned char* lds) {
    int tid_ = threadIdx.x; asm volatile("" : "+v"(tid_)); const int tid = tid_, lane = tid & 63, wave = __builtin_amdgcn_readfirstlane(tid >> 6);
    const int l31 = lane & 31, hi = lane >> 5, i16 = lane & 15, gi = (lane >> 4) & 1;
    const int head = g * 4 + (wave >> 1);
    const int seqbase = isctx ? ML + b * NCTX : b * SEQ;
    const int q0 = qb * 128, tq0 = q0 + (wave & 1) * 64;
    constexpr int KB = 64 * 144, VB = 64 * 192, STG = KB + VB;
    bf16x8 qf[2][4];
#pragma unroll
    for (int ct = 0; ct < 2; ++ct)
#pragma unroll
        for (int ds = 0; ds < 4; ++ds) qf[ct][ds] = *(const bf16x8*)(W.Z + (size_t)(seqbase + tq0 + 32 * ct + l31) * ZLD + 768 + 256 * (head >> 2) + 128 * (ds >> 1) + 32 * (head & 3) + 16 * (ds & 1) + 8 * hi);
    const int jlo = isctx ? 0 : (qb == 0 ? 2 : 0), jhi = isctx ? -1 : (qb == 31 ? 3 : 5);
    const int NT = 4 + (jhi - jlo + 1);
    const int kvr = tid >> 3, ch = tid & 7;
    const int gcolK = 1280 + 128 * (ch >> 2) + 32 * g + 8 * (ch & 3);
    const int ctxbase = ML + b * NCTX;
    const float sink2 = p.attn_sink[layer * 8 + head] * LOG2E;
    float mrun[2] = {sink2, sink2}, lsum[2] = {hi == 0 ? 1.f : 0.f, hi == 0 ? 1.f : 0.f};
    f32x16 O[2][2];
#pragma unroll
    for (int dt = 0; dt < 2; ++dt)
#pragma unroll
        for (int ct = 0; ct < 2; ++ct) O[dt][ct] = (f32x16){};
    u32x4 kreg, vreg;
#define ATT_KROW(ti) ((ti) < 4 ? ctxbase + 64 * (ti) : b * SEQ + q0 - 128 + 64 * (jlo + (ti) - 4))
#define ATT_LOAD(ti) do { const bf16_t* src_ = W.Z + (size_t)(ATT_KROW(ti) + kvr) * ZLD + gcolK; kreg = *(const u32x4*)src_; vreg = *(const u32x4*)(src_ + 64); } while (0)
#define ATT_STORE(st) do { *(LAS u32x4*)(lds + (st) * STG + kvr * 144 + ch * 16) = kreg; *(LAS u32x4*)(lds + (st) * STG + KB + kvr * 192 + ch * 16) = vreg; } while (0)
    ATT_LOAD(0); ATT_STORE(0);
    __syncthreads();
    for (int ti = 0; ti < NT; ++ti) {
        const int st = ti & 1;
        if (ti + 1 < NT) ATT_LOAD(ti + 1);
        bool active = true, need_mask = false; int k0 = 0;
        if (ti >= 4) { k0 = q0 - 128 + 64 * (jlo + ti - 4); active = (k0 + 63 >= tq0 - 128) && (k0 <= tq0 + 191); need_mask = !((k0 >= tq0 - 65) && (k0 <= tq0 + 65)); }
        if (active) {
            const LAS unsigned char* Kb = lds + st * STG; const LAS unsigned char* Vbp = Kb + KB;
            f32x16 s[2][2];
#pragma unroll
            for (int rt = 0; rt < 2; ++rt) {
                s[rt][0] = (f32x16){}; s[rt][1] = (f32x16){};
#pragma unroll
                for (int ds = 0; ds < 4; ++ds) { const bf16x8 kf = *(const LAS bf16x8*)(Kb + (32 * rt + l31) * 144 + (2 * ds + hi) * 16);
                    s[rt][0] = MFMA32(kf, qf[0][ds], s[rt][0]); s[rt][1] = MFMA32(kf, qf[1][ds], s[rt][1]); }
            }
            if (need_mask) {
#pragma unroll
                for (int rt = 0; rt < 2; ++rt)
#pragma unroll
                    for (int ct = 0; ct < 2; ++ct)
#pragma unroll
                        for (int r = 0; r < 16; ++r) { const int kp = k0 + 32 * rt + (r & 3) + 8 * (r >> 2) + 4 * hi, qp = tq0 + 32 * ct + l31; const int dd = qp - kp;
                            if (dd > 128 || dd < -128) s[rt][ct][r] = -1e30f; }
            }
#pragma unroll
            for (int ct = 0; ct < 2; ++ct) {
                float mx = s[0][ct][0];
#pragma unroll
                for (int r = 1; r < 16; ++r) mx = fmaxf(mx, s[0][ct][r]);
#pragma unroll
                for (int r = 0; r < 16; ++r) mx = fmaxf(mx, s[1][ct][r]);
                mx = fmaxf(mx, __shfl_xor(mx, 32));
                const float mnew = fmaxf(mrun[ct], mx); const float alpha = __builtin_amdgcn_exp2f(mrun[ct] - mnew); mrun[ct] = mnew;
                float ls = 0.f;
#pragma unroll
                for (int rt = 0; rt < 2; ++rt)
#pragma unroll
                    for (int r = 0; r < 16; ++r) { const float pe = __builtin_amdgcn_exp2f(s[rt][ct][r] - mnew); s[rt][ct][r] = pe; ls += pe; }
                lsum[ct] = lsum[ct] * alpha + ls;
#pragma unroll
                for (int dt = 0; dt < 2; ++dt) O[dt][ct] = O[dt][ct] * alpha;
            }
            const LAS unsigned char* vb = Vbp + (i16 >> 2) * 192 + (16 * gi + 4 * (i16 & 3)) * 2;
#pragma unroll
            for (int rt = 0; rt < 2; ++rt)
#pragma unroll
                for (int sk = 0; sk < 2; ++sk) {
                    const bf16x8 p0 = pack_acc8(s[rt][0], sk), p1 = pack_acc8(s[rt][1], sk);
                    const int r0 = 32 * rt + 16 * sk + 4 * hi;
#pragma unroll
                    for (int dt = 0; dt < 2; ++dt) { const bf16x8 vf = cat8(tr_read(vb + r0 * 192 + dt * 64), tr_read(vb + (r0 + 8) * 192 + dt * 64));
                        O[dt][0] = MFMA32(vf, p0, O[dt][0]); O[dt][1] = MFMA32(vf, p1, O[dt][1]); }
                }
        }
        if (ti + 1 < NT) ATT_STORE(st ^ 1);
        __syncthreads();
    }
#undef ATT_KROW
#undef ATT_LOAD
#undef ATT_STORE
#pragma unroll
    for (int ct = 0; ct < 2; ++ct) {
        const float lt = lsum[ct] + __shfl_xor(lsum[ct], 32); const float inv = 1.f / lt;
        const int row = seqbase + tq0 + 32 * ct + l31;
#pragma unroll
        for (int dt = 0; dt < 2; ++dt)
#pragma unroll
            for (int r4 = 0; r4 < 4; ++r4) { const int d = 32 * dt + 8 * r4 + 4 * hi;
                const u32x2 gz = *(const u32x2*)(W.Z + (size_t)row * ZLD + 1536 + head * 64 + d);
                const float a0 = O[dt][ct][4 * r4] * inv * silu_f(bflo(gz.x)), a1 = O[dt][ct][4 * r4 + 1] * inv * silu_f(bfhi(gz.x));
                const float a2 = O[dt][ct][4 * r4 + 2] * inv * silu_f(bflo(gz.y)), a3 = O[dt][ct][4 * r4 + 3] * inv * silu_f(bfhi(gz.y));
                u32x2 w; w.x = pk2(a0, a1); w.y = pk2(a2, a3);
                *(u32x2*)(W.Y + (size_t)row * 1024 + 256 + head * 64 + d) = w; }
    }
}

__device__ __forceinline__ void phase_final(const Params& p, const WS& W) {
    int tid_ = threadIdx.x; asm volatile("" : "+v"(tid_)); const int tid = tid_, lane = tid & 63, wave = tid >> 6;
    const int gw = blockIdx.x * 8 + wave, NGW = gridDim.x * 8;
    f32x4 fw[4];
#pragma unroll
    for (int j = 0; j < 4; ++j) fw[j] = *(const f32x4*)(p.final_norm_w + j * 256 + lane * 4);
    for (int row = gw; row < ML; row += NGW) {
        const float rinv = rsqrtf(W.rss2[row] * (1.f / 1024.f) + EPS);
        float* xr = p.out + (size_t)row * 1024;
#pragma unroll
        for (int j = 0; j < 4; ++j) { const f32x4 v = *(const f32x4*)(xr + j * 256 + lane * 4); *(f32x4*)(xr + j * 256 + lane * 4) = v * rinv * fw[j]; }
    }
}

__global__ void __launch_bounds__(512, 2) fwd_kernel(Params p) {
    extern __shared__ __attribute__((aligned(16))) unsigned char lds_raw[];
    LAS unsigned char* lds = (LAS unsigned char*)lds_raw;
    const int G = gridDim.x;
    for (int ph = p.ph_lo; ph < p.ph_hi; ++ph) {
        if (ph > p.ph_lo) { cg::this_grid().sync(); }
        unsigned char* wsb = p.ws; asm volatile("" : "+s"(wsb));
        int bx = blockIdx.x; asm volatile("" : "+s"(bx));
        const WS W = make_ws(wsb);
        if (RUNSUB(10) && ph == 0) { phase_prep0(p, W, lds); }
        else if (RUNSUB(11) && ph == 1) { phase_prep1(p, W); }
        else if (RUNSUB(12) && ph == 12) { phase_final(p, W); }
        else if (ph >= 2 && ph < 12) {
            const int layer = (ph - 2) / 5, sub = (ph - 2) % 5;
            if (RUNSUB(0) && sub == 0) {
                pg8::Gemm gm{W.A, W.WinT + (size_t)layer * NPAD * 1024, MT, NPAD, 1024}; pg8::StaticOrder S; S.init(MT, NPAD, G, bx);
                pg8::EpiIn E{W.Z, W.LA, layer == 0 ? W.rss0 : W.rss1, W.biasz + layer * 9 * NPAD, W.rope};
                pg8::gemm_phase<pg8::EpiIn, pg8::StaticOrder, true, true>(lds, gm, S, E);
            } else if ((RUNSUB(1) || RUNSUB(5)) && sub == 1) {
                const int nconv = layer == 0 ? 544 : 512;
                if (RUNSUB(1)) for (int u = bx; u < nconv; u += G) { if (u < 512) conv_unit(p, W, layer, u >> 6, u & 63, lds); else conv_unit(p, W, layer, 8 + ((u - 512) >> 2), (u - 512) & 3, lds); }
                if (RUNSUB(5)) for (int u = bx; u < 544; u += G) { if (u < 512) gla_state_unit(W, u >> 6, false, u & 63, lds); else gla_state_unit(W, (u - 512) >> 2, true, (u - 512) & 3, lds); }
            } else if (RUNSUB(2) && sub == 2) {
                gla_scan(W);
                const int natt = layer == 0 ? 544 : 512;
                for (int u = bx; u < natt; u += G) { if (u < 512) attn_unit(p, W, layer, u >> 6, (u >> 5) & 1, u & 31, false, lds); else { const int v = u - 512; attn_unit(p, W, layer, v >> 2, (v >> 1) & 1, v & 1, true, lds); } }
            } else if (RUNSUB(3) && sub == 3) {
                const int nu = layer == 0 ? 1088 : 1024;
                for (int u = bx; u < nu; u += G) { if (u < 1024) gla_out_unit(p, W, layer, u >> 7, false, (u >> 1) & 63, u & 1, lds); else { const int v = u - 1024; gla_out_unit(p, W, layer, v >> 3, true, (v >> 1) & 3, v & 1, lds); } }
            } else if (RUNSUB(4) && sub == 4) {
                const int Mo = layer == 0 ? MT : ML;
                pg8::Gemm gm{W.Y, W.WoutT + (size_t)layer * 1024 * 1024, Mo, 1024, 1024}; pg8::StaticOrder S; S.init(Mo, 1024, G, bx);
                pg8::EpiOut E{layer == 0 ? p.x : p.out, p.ctx, p.out, W.modv + layer * 9 * 3072, layer == 0 ? W.modv + 9 * 3072 : nullptr, layer == 0 ? W.A : nullptr, layer == 0 ? W.rss1 : W.rss2};
                pg8::gemm_phase<pg8::EpiOut, pg8::StaticOrder, true, true>(lds, gm, S, E);
            }
        }
    }
}

extern "C" void kernel_launch(void* const* d_in, const int* in_sizes, int n_in, void* d_out, int out_size, void* d_ws, size_t ws_size, hipStream_t stream) {
    static int grid = 0;
    if (grid == 0) {
        if (n_in != 17 || out_size != ML * D || ws_size < WS_END) { fprintf(stderr, "kernel_launch: unexpected shapes (n_in %d, out %d, ws %zu)\n", n_in, out_size, ws_size); grid = -1; return; }
        int dev = 0, cus = 0, per_cu = 0;
        hipGetDevice(&dev); hipDeviceGetAttribute(&cus, hipDeviceAttributeMultiprocessorCount, dev);
        hipFuncSetAttribute((const void*)fwd_kernel, hipFuncAttributeMaxDynamicSharedMemorySize, LDS_BYTES);
        hipOccupancyMaxActiveBlocksPerMultiprocessor(&per_cu, (const void*)fwd_kernel, 512, LDS_BYTES);
        if (per_cu < 1) { fprintf(stderr, "kernel_launch: occupancy query says %d blocks/CU\n", per_cu); per_cu = 1; }
        (void)hipGetLastError();
        grid = cus;
    }
    if (grid < 0) return;
    Params p{};
    p.x = (const float*)d_in[0]; p.c = (const float*)d_in[1]; p.ctx = (const float*)d_in[2]; p.c_ctx = (const float*)d_in[3]; p.w_mod = (const float*)d_in[4]; p.b_mod = (const float*)d_in[5];
    p.w_in = (const float*)d_in[6]; p.conv_w = (const float*)d_in[7]; p.conv_b = (const float*)d_in[8]; p.conv_ln_w = (const float*)d_in[9]; p.conv_ln_b = (const float*)d_in[10];
    p.attn_sink = (const float*)d_in[11]; p.gla_w_up = (const float*)d_in[12]; p.gla_b_up = (const float*)d_in[13]; p.gla_norm_w = (const float*)d_in[14]; p.w_out = (const float*)d_in[15];
    p.final_norm_w = (const float*)d_in[16]; p.out = (float*)d_out; p.ws = (unsigned char*)d_ws;
#if MK_MULTI
    for (int ph = 0; ph < NPHASE; ++ph) { p.ph_lo = ph; p.ph_hi = ph + 1; hipLaunchKernelGGL(fwd_kernel, dim3(grid), dim3(512), LDS_BYTES, stream, p); }
#else
    p.ph_lo = 0; p.ph_hi = NPHASE;
    void* args[] = {&p};
    hipError_t e = hipLaunchCooperativeKernel((void*)fwd_kernel, dim3(grid), dim3(512), args, LDS_BYTES, stream);
    if (e != hipSuccess) fprintf(stderr, "cooperative launch failed: %s (grid %d)\n", hipGetErrorString(e), grid);
#endif
}
```

```cpp
#include <hip/hip_runtime.h>
#include <hip/hip_cooperative_groups.h>
#include <cstdio>
#include <cstdint>
namespace cg = cooperative_groups;
namespace pg8 {
#define PG8_LAS __attribute__((address_space(3)))
typedef unsigned short bf16_t;
typedef short bf16x8 __attribute__((ext_vector_type(8)));
typedef float f32x4 __attribute__((ext_vector_type(4)));
typedef unsigned u32x4 __attribute__((ext_vector_type(4)));
constexpr int BM = 256, BK = 64, HALF = 128, HTB = HALF * BK * 2  , STAGE_BYTES = 8 * HTB, NXCD = 8, WGM = 8;

__host__ __device__ __forceinline__ int lds_byte(int r, int c) { const int st = (r >> 4) * 2 + (c >> 5), rr = r & 15, cc = c & 31, ob = rr * 64 + cc * 2; return st * 1024 + (ob ^ (((ob >> 9) & 1) << 5)); }
__host__ __device__ __forceinline__ void stage_rc(int b, int& R, int& C) { const int st = b / 1024, sb = b % 1024, swz = sb ^ (((sb >> 9) & 1) << 5); R = (st >> 1) * 16 + swz / 64; C = (st & 1) * 32 + (swz % 64) / 2; }
__host__ __device__ __forceinline__ int perm32(int rho) { const int n = rho >> 4, i = rho & 15; return 8 * (i >> 2) + 4 * n + (i & 3); }

struct Unit { int pm, pn; };
struct Gemm { const bf16_t* A; const bf16_t* Bt; int M, N, K; };

struct StaticOrder {
    int nM, nN, nwg, G, c;
    __host__ __device__ void init(int M, int N, int G_, int c_) { nM = M / BM; nN = N / BM; nwg = nM * nN; G = G_; c = c_; }
    __host__ __device__ bool next(int i, Unit& u) const {
        const long L = (long)i * G + c; if (L >= nwg) return false;
        int wgid = (int)L; { const int q = nwg / NXCD, r = nwg % NXCD, xcd = wgid % NXCD, off = wgid / NXCD; wgid = (xcd < r ? xcd * (q + 1) : r * (q + 1) + (xcd - r) * q) + off; }
        const int nig = WGM * nN, gid = wgid / nig, fm = gid * WGM, gsz = (nM - fm) < WGM ? (nM - fm) : WGM;
        u.pm = fm + ((wgid % nig) % gsz); u.pn = (wgid % nig) / gsz; return true;
    }
    __device__ __forceinline__ void a_ready(const Unit&) const {}
    __device__ __forceinline__ void done(const Unit&) const {}
};
__device__ __forceinline__ unsigned cvt_pk_bf16(float lo, float hi) { unsigned r; asm volatile("v_cvt_pk_bf16_f32 %0, %1, %2" : "=v"(r) : "v"(lo), "v"(hi)); return r; }
template <class Epi, class Sched, bool ALIGN_EPI = false, bool SP2 = false>
__device__ __forceinline__ void gemm_phase(PG8_LAS unsigned char* lds, const Gemm g, const Sched& S, const Epi& E) {
    int tid_ = threadIdx.x; asm volatile("" : "+v"(tid_)); const int tid = tid_, wid = __builtin_amdgcn_readfirstlane(tid >> 6), lane = tid & 63, wr = wid >> 2, wc = wid & 3, fr = lane & 15, fq = lane >> 4;
    const int K = g.K, nt = K / BK;
    unsigned voffA[2], voffB[2];
#pragma unroll
    for (int i = 0; i < 2; ++i) { int R, C; stage_rc(tid * 16 + i * 8192, R, C); const int Rb = Epi::PERM ? ((R & ~31) + perm32(R & 31)) : R;
        voffA[i] = (unsigned)(R * K + C) * 2u; voffB[i] = (unsigned)(Rb * K + C) * 2u; }
    const size_t kstep = (size_t)(BK * 2);
    const size_t hstep = (size_t)HALF * K * 2;
    const size_t tstep = 2 * hstep;
    const unsigned ldsw = (unsigned)wid * 1024u;
    const int aoff = lds_byte(wr * 64 + fr, fq * 8), boff = lds_byte(wc * 32 + fr, fq * 8);
#define PG8_SA(b, h) (((b) * 2 + (h)) * HTB)
#define PG8_SB(b, h) ((4 + (b) * 2 + (h)) * HTB)
#define PG8_STAGE(bufoff, gbase, voff) do { _Pragma("unroll") for (int _i = 0; _i < 2; ++_i) \
        __builtin_amdgcn_global_load_lds((const unsigned*)((const char*)(gbase) + (voff)[_i]), (PG8_LAS unsigned*)(lds + (bufoff) + ldsw + _i * 8192), 16, 0, 0); } while (0)
#define PG8_LDA(dst, b, h) do { _Pragma("unroll") for (int m = 0; m < 4; ++m) _Pragma("unroll") for (int k = 0; k < 2; ++k) dst[m][k] = *(const PG8_LAS bf16x8*)(lds + PG8_SA(b, h) + aoff + m * 2048 + k * 1024); } while (0)
#define PG8_LDB(dst, b, h) do { _Pragma("unroll") for (int n = 0; n < 2; ++n) _Pragma("unroll") for (int k = 0; k < 2; ++k) dst[n][k] = *(const PG8_LAS bf16x8*)(lds + PG8_SB(b, h) + boff + n * 2048 + k * 1024); } while (0)
#define PG8_MMA(ai, bj, At, Bt) do { __builtin_amdgcn_s_setprio(1); _Pragma("unroll") for (int m = 0; m < 4; ++m) _Pragma("unroll") for (int n = 0; n < 2; ++n) _Pragma("unroll") for (int k = 0; k < 2; ++k) \
        acc[ai][bj][m][n] = __builtin_amdgcn_mfma_f32_16x16x32_bf16(Bt[n][k], At[m][k], acc[ai][bj][m][n], 0, 0, 0); __builtin_amdgcn_s_setprio(0); } while (0)
#define PG8_WAIT_V(n) asm volatile("s_waitcnt vmcnt(" #n ")" ::: "memory")
#define PG8_WAIT_L(n) asm volatile("s_waitcnt lgkmcnt(" #n ")" ::: "memory")
#define PG8_BAR __builtin_amdgcn_s_barrier()
#define PG8_SCHED __builtin_amdgcn_sched_barrier(0)
    Unit cur, nxt; int ui = 0;
    if (!S.next(0, cur)) return;
    f32x4 acc[2][2][4][2];
#pragma unroll
    for (int a = 0; a < 2; ++a)
#pragma unroll
        for (int b = 0; b < 2; ++b)
#pragma unroll
            for (int m = 0; m < 4; ++m)
#pragma unroll
                for (int n = 0; n < 2; ++n) acc[a][b][m][n] = (f32x4){0.f, 0.f, 0.f, 0.f};
    bf16x8 At[4][2], B0[2][2], B1[2][2];
    const char* cA = (const char*)g.A + (size_t)cur.pm * tstep; const char* cB = (const char*)g.Bt + (size_t)cur.pn * tstep;
    S.a_ready(cur);
    if constexpr (SP2) {
        PG8_STAGE(PG8_SB(0, 0), cB, voffB); PG8_STAGE(PG8_SB(0, 1), cB + hstep, voffB); PG8_STAGE(PG8_SA(0, 0), cA, voffA); PG8_STAGE(PG8_SA(0, 1), cA + hstep, voffA);
        if (wr == 1) PG8_BAR;
        PG8_WAIT_V(2); PG8_BAR;
        PG8_STAGE(PG8_SB(1, 0), cB + kstep, voffB); PG8_STAGE(PG8_SA(1, 0), cA + kstep, voffA); PG8_STAGE(PG8_SB(1, 1), cB + hstep + kstep, voffB);
        PG8_WAIT_V(6); PG8_BAR;
    } else {
        PG8_STAGE(PG8_SB(0, 0), cB, voffB); PG8_STAGE(PG8_SA(0, 0), cA, voffA); PG8_STAGE(PG8_SB(0, 1), cB + hstep, voffB); PG8_STAGE(PG8_SA(0, 1), cA + hstep, voffA);
        if (wr == 1) PG8_BAR;
        PG8_WAIT_V(4); PG8_BAR;
        PG8_STAGE(PG8_SB(1, 0), cB + kstep, voffB); PG8_STAGE(PG8_SA(1, 0), cA + kstep, voffA); PG8_STAGE(PG8_SB(1, 1), cB + hstep + kstep, voffB);
        PG8_WAIT_V(6); PG8_BAR;
    }
    for (;;) {
        const bool has_next = S.next(ui + 1, nxt);
        const char* nA = has_next ? (const char*)g.A + (size_t)nxt.pm * tstep : cA; const char* nB = has_next ? (const char*)g.Bt + (size_t)nxt.pn * tstep : cB;
        for (int t = 0; t < nt; t += 2) {
            const bool last = (t == nt - 2);
            const char* a1 = cA + (size_t)(t + 1) * kstep;
            const char* a2 = last ? nA : cA + (size_t)(t + 2) * kstep; const char* b2 = last ? nB : cB + (size_t)(t + 2) * kstep;
            const char* a3 = a2 + kstep; const char* b3 = b2 + kstep;
            if (last && has_next) S.a_ready(nxt);
            if constexpr (SP2) {
            PG8_LDB(B0, 0, 0); PG8_LDB(B1, 0, 1); PG8_SCHED; PG8_LDA(At, 0, 0); PG8_STAGE(PG8_SA(1, 1), a1 + hstep, voffA);
            PG8_WAIT_V(8); PG8_WAIT_L(0); PG8_BAR; PG8_MMA(0, 0, At, B0); PG8_MMA(0, 1, At, B1); PG8_BAR; PG8_SCHED;
            PG8_LDA(At, 0, 1); PG8_STAGE(PG8_SB(0, 0), b2, voffB); PG8_STAGE(PG8_SB(0, 1), b2 + hstep, voffB); PG8_STAGE(PG8_SA(0, 0), a2, voffA);
            PG8_WAIT_V(8); PG8_WAIT_L(0); PG8_BAR; PG8_MMA(1, 0, At, B0); PG8_MMA(1, 1, At, B1); PG8_BAR; PG8_SCHED;
            PG8_LDB(B0, 1, 0); PG8_LDB(B1, 1, 1); PG8_SCHED; PG8_LDA(At, 1, 0); PG8_STAGE(PG8_SA(0, 1), a2 + hstep, voffA);
            PG8_WAIT_V(8); PG8_WAIT_L(0); PG8_BAR; PG8_MMA(0, 0, At, B0); PG8_MMA(0, 1, At, B1); PG8_BAR; PG8_SCHED;
            PG8_LDA(At, 1, 1); PG8_STAGE(PG8_SB(1, 0), b3, voffB); PG8_STAGE(PG8_SB(1, 1), b3 + hstep, voffB); PG8_STAGE(PG8_SA(1, 0), a3, voffA);
            PG8_WAIT_V(8); PG8_WAIT_L(0); PG8_BAR; PG8_MMA(1, 0, At, B0); PG8_MMA(1, 1, At, B1); PG8_BAR; PG8_SCHED;
            } else {
            PG8_LDB(B0, 0, 0); PG8_SCHED; PG8_LDA(At, 0, 0); PG8_STAGE(PG8_SA(1, 1), a1 + hstep, voffA);
            PG8_WAIT_L(8); PG8_BAR; PG8_WAIT_L(0); PG8_MMA(0, 0, At, B0); PG8_BAR; PG8_SCHED;
            PG8_LDB(B1, 0, 1); PG8_STAGE(PG8_SB(0, 0), b2, voffB);
            PG8_BAR; PG8_WAIT_L(0); PG8_MMA(0, 1, At, B1); PG8_BAR;
            PG8_LDA(At, 0, 1); PG8_STAGE(PG8_SA(0, 0), a2, voffA);
            PG8_BAR; PG8_WAIT_L(0); PG8_MMA(1, 0, At, B0); PG8_BAR; PG8_SCHED;
            PG8_STAGE(PG8_SB(0, 1), b2 + hstep, voffB);
            PG8_WAIT_V(6); PG8_BAR; PG8_MMA(1, 1, At, B1); PG8_BAR;
            PG8_LDB(B0, 1, 0); PG8_SCHED; PG8_LDA(At, 1, 0); PG8_STAGE(PG8_SA(0, 1), a2 + hstep, voffA);
            PG8_WAIT_L(8); PG8_BAR; PG8_WAIT_L(0); PG8_MMA(0, 0, At, B0); PG8_BAR; PG8_SCHED;
            PG8_LDB(B1, 1, 1); PG8_STAGE(PG8_SB(1, 0), b3, voffB);
            PG8_BAR; PG8_WAIT_L(0); PG8_MMA(0, 1, At, B1); PG8_BAR;
            PG8_LDA(At, 1, 1); PG8_STAGE(PG8_SA(1, 0), a3, voffA);
            PG8_BAR; PG8_WAIT_L(0); PG8_MMA(1, 0, At, B0); PG8_BAR; PG8_SCHED;
            PG8_STAGE(PG8_SB(1, 1), b3 + hstep, voffB);
            PG8_WAIT_V(6); PG8_BAR; PG8_MMA(1, 1, At, B1); PG8_BAR;
            }
        }
        if constexpr (ALIGN_EPI) { if (wr == 0) PG8_BAR; }
        if constexpr (!Epi::AFTER_DRAIN) { E(acc, cur, wr, wc, fr, fq); S.done(cur); }
        if (!has_next) break;
#pragma unroll
        for (int a = 0; a < 2; ++a)
#pragma unroll
            for (int b = 0; b < 2; ++b)
#pragma unroll
                for (int m = 0; m < 4; ++m)
#pragma unroll
                    for (int n = 0; n < 2; ++n) acc[a][b][m][n] = (f32x4){0.f, 0.f, 0.f, 0.f};
        cur = nxt; cA = nA; cB = nB; ++ui;
        if constexpr (ALIGN_EPI) { if (wr == 1) PG8_BAR; }
    }
    PG8_WAIT_V(0);
    if constexpr (!ALIGN_EPI) { if (wr == 0) PG8_BAR; }
    PG8_BAR;
    if constexpr (Epi::AFTER_DRAIN) { E.fused(acc, cur, wr, wc, fr, fq, lds, wid, lane); S.done(cur); }
#undef PG8_SA
#undef PG8_SB
#undef PG8_STAGE
#undef PG8_LDA
#undef PG8_LDB
#undef PG8_MMA
#undef PG8_WAIT_V
#undef PG8_WAIT_L
#undef PG8_BAR
#undef PG8_SCHED
}
}

#ifndef DIAG_SUB
#define DIAG_SUB -1
#endif
#define RUNSUB(k) (DIAG_SUB < 0 || DIAG_SUB == (k))
#ifndef DUP_SUB
#define DUP_SUB -1
#endif
#define NREP(k) ((DUP_SUB == (k)) ? 2 : 1)
#ifndef USE_CG_SYNC
#define USE_CG_SYNC 0
#endif
#ifndef MK_MULTI
#define MK_MULTI 0
#endif
constexpr int D = 1024, NB = 8, SEQ = 4096, NCTX = 256;
constexpr int ML = NB * SEQ;
constexpr int MC = NB * NCTX;
constexpr int MT = ML + MC;
constexpr int NPAD = 3072, ZLD = 2816;
constexpr float EPS = 1e-6f;
constexpr float LOG2E = 1.4426950408889634f;
constexpr float QSCALE = 0.125f * LOG2E;
constexpr float GQSCALE = 0.17677669529663687f;
constexpr int NCHAIN = 68;
constexpr int NPHASE = 13;
constexpr int LDS_BYTES = 147456;

constexpr size_t MiB = 1u << 20;
constexpr size_t WS_CTL = 0, WS_WINT = 2 * MiB, WS_WOUTT = 14 * MiB, WS_MODV = 18 * MiB, WS_BIASZ = 18 * MiB + 256 * 1024, WS_ROPE = 18 * MiB + 512 * 1024;
constexpr size_t WS_RSS0 = 19 * MiB, WS_RSS1 = 19 * MiB + 256 * 1024, WS_RSS2 = 19 * MiB + 512 * 1024, WS_DEC = 20 * MiB;
constexpr size_t WS_A = 24 * MiB, WS_Y = 92 * MiB, WS_LA = 160 * MiB, WS_ST = 194 * MiB, WS_Z = 228 * MiB, WS_END = 415 * MiB;

#define LAS __attribute__((address_space(3)))
typedef unsigned short bf16_t;
typedef float f32x4 __attribute__((ext_vector_type(4)));
typedef float f32x2 __attribute__((ext_vector_type(2)));
typedef float f32x16 __attribute__((ext_vector_type(16)));
typedef short bf16x8 __attribute__((ext_vector_type(8)));
typedef short s16x4 __attribute__((ext_vector_type(4)));
typedef unsigned u32x4 __attribute__((ext_vector_type(4)));
typedef unsigned u32x2 __attribute__((ext_vector_type(2)));

struct Params {
    const float *x, *c, *ctx, *c_ctx, *w_mod, *b_mod, *w_in, *conv_w, *conv_b, *conv_ln_w, *conv_ln_b, *attn_sink, *gla_w_up, *gla_b_up, *gla_norm_w, *w_out, *final_norm_w;
    float* out; unsigned char* ws;
    int ph_lo, ph_hi;
};
struct WS {
    bf16_t *WinT, *WoutT, *A, *Y, *Z;
    float *modv, *biasz, *rope, *rss0, *rss1, *rss2, *dec, *LA, *ST;
};
__device__ __forceinline__ WS make_ws(unsigned char* ws) {
    WS W; W.WinT = (bf16_t*)(ws + WS_WINT); W.WoutT = (bf16_t*)(ws + WS_WOUTT); W.A = (bf16_t*)(ws + WS_A); W.Y = (bf16_t*)(ws + WS_Y); W.Z = (bf16_t*)(ws + WS_Z);
    W.modv = (float*)(ws + WS_MODV); W.biasz = (float*)(ws + WS_BIASZ); W.rope = (float*)(ws + WS_ROPE); W.rss0 = (float*)(ws + WS_RSS0); W.rss1 = (float*)(ws + WS_RSS1);
    W.rss2 = (float*)(ws + WS_RSS2); W.dec = (float*)(ws + WS_DEC); W.LA = (float*)(ws + WS_LA); W.ST = (float*)(ws + WS_ST); return W;
}

__device__ __forceinline__ unsigned pk2(float lo, float hi) { typedef __bf16 b2 __attribute__((ext_vector_type(2))); f32x2 v = {lo, hi}; b2 b = __builtin_convertvector(v, b2); return __builtin_bit_cast(unsigned, b); }
__device__ __forceinline__ float bflo(unsigned w) { return __uint_as_float(w << 16); }
__device__ __forceinline__ float bfhi(unsigned w) { return __uint_as_float(w & 0xffff0000u); }
__device__ __forceinline__ float silu_f(float v) { return v / (1.f + __expf(-v)); }
__device__ __forceinline__ float sigmoid_f(float v) { return 1.f / (1.f + __expf(-v)); }
__device__ __forceinline__ float wave_sum(float v) {
#pragma unroll
    for (int o = 1; o < 64; o <<= 1) v += __shfl_xor(v, o);
    return v;
}
typedef short v4i16_t __attribute__((ext_vector_type(4)));
__device__ __forceinline__ s16x4 tr_read(const LAS unsigned char* p) { return __builtin_bit_cast(s16x4, __builtin_amdgcn_ds_read_tr16_b64_v4i16((LAS v4i16_t*)p)); }
__device__ __forceinline__ bf16x8 cat8(s16x4 a, s16x4 b) { return (bf16x8){a[0], a[1], a[2], a[3], b[0], b[1], b[2], b[3]}; }
#define MFMA32(a, b, c) __builtin_amdgcn_mfma_f32_32x32x16_bf16((a), (b), (c), 0, 0, 0)
__device__ __forceinline__ bf16x8 pack_acc8(const f32x16& v, int s) {
    u32x4 w; w.x = pk2(v[8 * s + 0], v[8 * s + 1]); w.y = pk2(v[8 * s + 2], v[8 * s + 3]); w.z = pk2(v[8 * s + 4], v[8 * s + 5]); w.w = pk2(v[8 * s + 6], v[8 * s + 7]);
    return __builtin_bit_cast(bf16x8, w);
}

#define XB_TMO      128
#define XB_XCNT(j)  (256  + 64 * (j))
#define XB_XSUB(j)  (1280 + 64 * (j))
#define XB_XGEN(j)  (2304 + 64 * (j))
#define XB_TOP      3328
#define XB_TOPGEN   3392
#define XCD_BAR_WORDS 3456
#define XB_SPIN_CAP (1u << 18)

__device__ __forceinline__ unsigned xb_ld(unsigned* p)              { return __hip_atomic_load(p, __ATOMIC_RELAXED, __HIP_MEMORY_SCOPE_AGENT); }
__device__ __forceinline__ unsigned xb_add(unsigned* p, unsigned v) { return __hip_atomic_fetch_add(p, v, __ATOMIC_RELAXED, __HIP_MEMORY_SCOPE_AGENT); }
__device__ __forceinline__ unsigned xb_xcc_id() { return (unsigned)__builtin_amdgcn_s_getreg((3 << 11) | 20) & 0xFu; }
#define XB_SPIN(cond, bar) do { unsigned _sp = 0; while (cond) { __builtin_amdgcn_s_sleep(1); \
    if ((++_sp & 255u) == 0u) { if (xb_ld(&(bar)[XB_TMO])) break; if (_sp > XB_SPIN_CAP) { atomicAdd(&(bar)[XB_TMO], 1u); break; } } } } while (0)

struct XcdBarrier {
    unsigned* bar; unsigned x;
    volatile LAS unsigned* st;
};

__device__ __forceinline__ XcdBarrier xcd_barrier_post(unsigned* bar, volatile LAS unsigned* st) {
    XcdBarrier b; b.bar = bar; b.x = xb_xcc_id(); b.st = st;
    if (threadIdx.x == 0) (void)xb_add(&bar[XB_XCNT(b.x)], 1u);
    return b;
}
__device__ __forceinline__ void xcd_barrier_complete(unsigned* bar, unsigned x, unsigned& nloc, unsigned& nx) {
    const unsigned G = gridDim.x * gridDim.y * gridDim.z;
    unsigned sum, cnt, mine, sp = 0u;
    for (;;) {
        sum = 0u; cnt = 0u; mine = 0u;
#pragma unroll
        for (unsigned j = 0; j < 16; ++j) { const unsigned c = xb_ld(&bar[XB_XCNT(j)]); sum += c; cnt += (c > 0u) ? 1u : 0u; mine = (j == x) ? c : mine; }
        if (sum == G) break;
        __builtin_amdgcn_s_sleep(1);
        if ((++sp & 255u) == 0u) { if (xb_ld(&bar[XB_TMO])) break; if (sp > XB_SPIN_CAP) { atomicAdd(&bar[XB_TMO], 1u); break; } }
    }
    nloc = mine > 0u ? mine : 1u; nx = cnt > 0u ? cnt : 1u;
}

__device__ __forceinline__ void xcd_barrier(const XcdBarrier& b) {
    asm volatile("s_waitcnt vmcnt(0)" ::: "memory");
    __syncthreads();
    if (threadIdx.x == 0) {
        unsigned* bar = b.bar;
        __builtin_amdgcn_s_waitcnt(0);
        unsigned nloc = b.st[0], nx = b.st[1];
        if (nloc == 0u) { xcd_barrier_complete(bar, b.x, nloc, nx); b.st[0] = nloc; b.st[1] = nx; }
        const unsigned old = xb_add(&bar[XB_XSUB(b.x)], 1u);
        const unsigned gen = old / nloc;
        if (old + 1u == (gen + 1u) * nloc) {
            __builtin_amdgcn_fence(__ATOMIC_RELEASE, "agent");
            asm volatile("s_waitcnt vmcnt(0)" ::: "memory");
            const unsigned og = xb_add(&bar[XB_TOP], 1u);
            const unsigned tg = og / nx;
            if (og + 1u == (tg + 1u) * nx) xb_add(&bar[XB_TOPGEN], 1u);
            else XB_SPIN(xb_ld(&bar[XB_TOPGEN]) == tg, bar);
            __builtin_amdgcn_fence(__ATOMIC_ACQUIRE, "agent");
            xb_add(&bar[XB_XGEN(b.x)], 1u);
            asm volatile("s_waitcnt vmcnt(0)" ::: "memory");
        } else {
            XB_SPIN(xb_ld(&bar[XB_XGEN(b.x)]) == gen, bar);
            __builtin_amdgcn_fence(__ATOMIC_ACQUIRE, "agent");
            asm volatile("s_waitcnt vmcnt(0)" ::: "memory");
        }
    }
    __syncthreads();
}

namespace pg8 {

template <bool DRY> struct EpiInT {
    static constexpr bool PERM = true, AFTER_DRAIN = false;
    bf16_t* Z; float* LA; const float* rss; const float* biasz; const float* rope;
    __device__ __forceinline__ void operator()(const f32x4 (&acc)[2][2][4][2], const Unit& u, int wr, int wc, int fr_, int fq_) const {
        int fr = fr_, fq = fq_; asm volatile("" : "+v"(fr), "+v"(fq));
        const int pn = u.pn; const bool latent = u.pm < 128; const int bsel = latent ? (u.pm >> 4) : 8;
        const float* bz = biasz + bsel * NPAD + pn * 256 + wc * 32 + 8 * fq;
        const bool do_rope = latent && (pn == 3 || pn == 4 || (pn == 5 && wc < 2));
        const float s0 = (pn == 3 || pn == 4) ? QSCALE : (pn == 8 ? GQSCALE : 1.f), s1 = (pn == 3 || pn == 4) ? QSCALE : 1.f;
        const int ropeoff = 8 * (fq & 1);
#pragma unroll
        for (int ai = 0; ai < 2; ++ai)
#pragma unroll
            for (int m = 0; m < 4; ++m) {
                const int row = u.pm * 256 + ai * 128 + wr * 64 + m * 16 + fr;
                const float rinv = rsqrtf(rss[row] * (1.f / 1024.f) + EPS);
                f32x4 v[2][2];
#pragma unroll
                for (int bj = 0; bj < 2; ++bj)
#pragma unroll
                    for (int n = 0; n < 2; ++n) v[bj][n] = acc[ai][bj][m][n] * rinv + *(const f32x4*)(bz + bj * 128 + n * 4);
                if (do_rope) {
                    const int t = row & 4095; const int pp = (fq < 2) ? (t >> 6) : (t & 63);
#pragma unroll
                    for (int n = 0; n < 2; ++n) {
                        const f32x4 c4 = *(const f32x4*)(rope + pp * 16 + ropeoff + 4 * n), s4 = *(const f32x4*)(rope + 1024 + pp * 16 + ropeoff + 4 * n);
                        const f32x4 x1 = v[0][n], x2 = v[1][n];
                        v[0][n] = x1 * c4 - x2 * s4; v[1][n] = x2 * c4 + x1 * s4;
                    }
                }
                if (pn == 11) {
#pragma unroll
                    for (int bj = 0; bj < 2; ++bj)
#pragma unroll
                        for (int n = 0; n < 2; ++n) { f32x4 o;
#pragma unroll
                            for (int e = 0; e < 4; ++e) { const float zz = v[bj][n][e]; o[e] = (fminf(zz, 0.f) - __logf(1.f + __expf(-fabsf(zz)))) * (1.f / 16.f); }
                            if (!DRY || o[0] == 12345.f) *(f32x4*)(LA + (size_t)row * 256 + bj * 128 + wc * 32 + 8 * fq + 4 * n) = o; }
                } else {
                    bf16_t* zr = Z + (size_t)row * ZLD + pn * 256 + wc * 32 + 8 * fq;
#pragma unroll
                    for (int bj = 0; bj < 2; ++bj) { const float sc = bj == 0 ? s0 : s1; const f32x4 a = v[bj][0] * sc, b = v[bj][1] * sc;
                        u32x4 w; w.x = pk2(a[0], a[1]); w.y = pk2(a[2], a[3]); w.z = pk2(b[0], b[1]); w.w = pk2(b[2], b[3]);
                        if (!DRY || w.x == 0x12345678u) *(u32x4*)(zr + bj * 128) = w; }
                }
            }
    }
};
typedef EpiInT<false> EpiIn;
struct EpiOut {
    static constexpr bool PERM = true, AFTER_DRAIN = false;
    const float* xl; const float* xc; float* xout; const float* modv_l; const float* modv_next; bf16_t* Anext; float* rss_out;
    __device__ __forceinline__ void operator()(const f32x4 (&acc)[2][2][4][2], const Unit& u, int wr, int wc, int fr_, int fq_) const {
        int fr = fr_, fq = fq_; asm volatile("" : "+v"(fr), "+v"(fq));
        const int pn = u.pn; const bool latent = u.pm < 128; const int bsel = latent ? (u.pm >> 4) : 8;
        const int colb = pn * 256 + wc * 32 + 8 * fq;
        const float* gp = modv_l + bsel * 3072 + 2048 + colb;
        const float* sp = modv_next ? modv_next + bsel * 3072 + 1024 + colb : nullptr;
#pragma unroll
        for (int ai = 0; ai < 2; ++ai)
#pragma unroll
            for (int m = 0; m < 4; ++m) {
                const int row = u.pm * 256 + ai * 128 + wr * 64 + m * 16 + fr;
                const float* xin = (latent ? xl + (size_t)row * 1024 : xc + (size_t)(row - ML) * 1024) + colb;
                float ss = 0.f;
#pragma unroll
                for (int bj = 0; bj < 2; ++bj) {
                    f32x4 o[2];
#pragma unroll
                    for (int n = 0; n < 2; ++n) { const f32x4 x4 = *(const f32x4*)(xin + bj * 128 + 4 * n); const f32x4 g4 = *(const f32x4*)(gp + bj * 128 + 4 * n);
                        o[n] = x4 + g4 * acc[ai][bj][m][n]; ss += (o[n][0] * o[n][0] + o[n][1] * o[n][1]) + (o[n][2] * o[n][2] + o[n][3] * o[n][3]); }
                    if (latent) { float* xo = xout + (size_t)row * 1024 + colb + bj * 128; *(f32x4*)xo = o[0]; *(f32x4*)(xo + 4) = o[1]; }
                    if (sp) { const f32x4 a = o[0] * (*(const f32x4*)(sp + bj * 128) + 1.f), b = o[1] * (*(const f32x4*)(sp + bj * 128 + 4) + 1.f);
                        u32x4 w; w.x = pk2(a[0], a[1]); w.y = pk2(a[2], a[3]); w.z = pk2(b[0], b[1]); w.w = pk2(b[2], b[3]);
                        *(u32x4*)(Anext + (size_t)row * 1024 + colb + bj * 128) = w; }
                }
                ss += __shfl_xor(ss, 16); ss += __shfl_xor(ss, 32);
                if (fq == 0) atomicAdd(rss_out + row, ss);
            }
    }
};
}

__device__ __forceinline__ int win_src_col(int n0) {
    if (n0 < 768) return n0;
    if (n0 < 1280) { const int r = n0 - 768, tq = r >> 8, bj = (r >> 7) & 1, wc = (r >> 5) & 3; return 768 + (4 * tq + wc) * 64 + 32 * bj; }
    if (n0 < 1536) { const int r = n0 - 1280, bj = (r >> 7) & 1, wc = (r >> 5) & 3; return wc < 2 ? 1280 + wc * 64 + 32 * bj : 1408 + (wc - 2) * 64 + 32 * bj; }
    if (n0 < 2560) return n0;
    if (n0 < 2816) return n0 + 32;
    return -1;
}
__device__ __forceinline__ void transpose_item(const float* Wsrc, int N, int srccol, const float* wup  , int lrcol, int j0, bf16_t* WT, int n0dst, int k0, LAS float* scr, int lane) {
#pragma unroll 4
    for (int i = 0; i < 32; ++i) {
        const int kk = 2 * i + (lane >> 5), cc = lane & 31; float v;
        if (wup == nullptr) v = Wsrc[(size_t)(k0 + kk) * N + srccol + cc];
        else { v = 0.f; const float* wr_ = Wsrc + (size_t)(k0 + kk) * N + lrcol;
#pragma unroll
            for (int r = 0; r < 16; ++r) v += wr_[r] * wup[r * 128 + j0 + cc]; }
        scr[kk * 33 + cc] = v;
    }
    asm volatile("s_waitcnt lgkmcnt(0)" ::: "memory");
    const int c = lane & 7;
#pragma unroll
    for (int j = 0; j < 4; ++j) { const int n = (lane >> 3) + 8 * j; const LAS float* s = scr + (8 * c) * 33 + n;
        u32x4 o; o.x = pk2(s[0 * 33], s[1 * 33]); o.y = pk2(s[2 * 33], s[3 * 33]); o.z = pk2(s[4 * 33], s[5 * 33]); o.w = pk2(s[6 * 33], s[7 * 33]);
        *(u32x4*)(WT + (size_t)(n0dst + n) * 1024 + k0 + 8 * c) = o; }
    asm volatile("s_waitcnt lgkmcnt(0)" ::: "memory");
}
__device__ __forceinline__ void phase_prep0(const Params& p, const WS& W, LAS unsigned char* lds) {
    int tid_ = threadIdx.x; asm volatile("" : "+v"(tid_)); const int tid = tid_, lane = tid & 63, wave = tid >> 6;
    {
        LAS float* sc = (LAS float*)lds; LAS float* red = sc + 9 * 1024;
        if ((int)blockIdx.x < 192) {
            for (int idx = tid; idx < 9216; idx += 512) { const int r = idx >> 10, k = idx & 1023; const float v = r < 8 ? p.c[r * 1024 + k] : p.c_ctx[k]; sc[idx] = silu_f(v); }
            __syncthreads();
            for (int it = blockIdx.x; it < 192; it += gridDim.x) {
                const int l = it / 96, cb = it % 96, cc = tid & 31, kg = tid >> 5;
                float a[9];
#pragma unroll
                for (int r = 0; r < 9; ++r) a[r] = 0.f;
                const float* wp = p.w_mod + (size_t)l * 1024 * 3072 + (size_t)(kg * 64) * 3072 + cb * 32 + cc;
#pragma unroll 8
                for (int kk = 0; kk < 64; ++kk) { const float w = wp[(size_t)kk * 3072];
#pragma unroll
                    for (int r = 0; r < 9; ++r) a[r] += sc[r * 1024 + kg * 64 + kk] * w; }
#pragma unroll
                for (int r = 0; r < 9; ++r) red[(kg * 9 + r) * 32 + cc] = a[r];
                __syncthreads();
                if (tid < 288) { const int r = tid >> 5; float s = 0.f;
#pragma unroll
                    for (int g = 0; g < 16; ++g) s += red[(g * 9 + r) * 32 + cc];
                    W.modv[(l * 9 + r) * 3072 + cb * 32 + cc] = s + p.b_mod[l * 3072 + cb * 32 + cc]; }
                __syncthreads();
            }
        }
    }
    if (blockIdx.x == gridDim.x - 1) {
        for (int idx = tid; idx < 1024; idx += 512) { const int pp = idx >> 4, f = idx & 15;
            const float inv = __builtin_amdgcn_exp2f(-(float)f * (13.287712379549449f / 16.f)); const float ang = (float)pp * inv;
            W.rope[idx] = __cosf(ang); W.rope[1024 + idx] = __sinf(ang); }
    }
    for (int i = blockIdx.x * 512 + tid; i < MT; i += gridDim.x * 512) { W.rss1[i] = 0.f; if (i < ML) W.rss2[i] = 0.f; }
    __syncthreads();
    {
        LAS float* scr = (LAS float*)(lds + wave * 16384);
        const int gw = blockIdx.x * 8 + wave, NGW = gridDim.x * 8;
        constexpr int I_IN = 96 * 16, I_OUT = 32 * 16, I_L = I_IN + I_OUT;
        for (int it = gw; it < 2 * I_L; it += NGW) {
            const int l = it / I_L; int r = it % I_L;
            if (r < I_IN) { const int nb = r % 96, kb = r / 96, n0 = nb * 32; const int src = win_src_col(n0);
                if (src >= 0) transpose_item(p.w_in + (size_t)l * 1024 * 2848, 2848, src, nullptr, 0, 0, W.WinT + (size_t)l * NPAD * 1024, n0, kb * 64, scr, lane);
                else { const int dir = (n0 - 2816) >> 7, j0 = (n0 - 2816) & 127;
                    transpose_item(p.w_in + (size_t)l * 1024 * 2848, 2848, 0, p.gla_w_up + (size_t)(l * 2 + dir) * 16 * 128, 2560 + 16 * dir, j0, W.WinT + (size_t)l * NPAD * 1024, n0, kb * 64, scr, lane); } }
            else { r -= I_IN; const int nb = r % 32, kb = r / 32;
                transpose_item(p.w_out + (size_t)l * 1024 * 1024, 1024, nb * 32, nullptr, 0, 0, W.WoutT + (size_t)l * 1024 * 1024, nb * 32, kb * 64, scr, lane); }
        }
    }
}

__device__ __forceinline__ void phase_prep1(const Params& p, const WS& W) {
    int tid_ = threadIdx.x; asm volatile("" : "+v"(tid_)); const int tid = tid_, lane = tid & 63, wave = tid >> 6;
    const int gw = blockIdx.x * 8 + wave, NGW = gridDim.x * 8;
    for (int row = gw; row < MT; row += NGW) {
        const bool latent = row < ML; const int bsel = latent ? (row >> 12) : 8;
        const float* xr = latent ? p.x + (size_t)row * 1024 : p.ctx + (size_t)(row - ML) * 1024;
        const float* sc = W.modv + bsel * 3072 + 1024;
        float ss = 0.f; u32x2* ao = (u32x2*)(W.A + (size_t)row * 1024);
#pragma unroll
        for (int j = 0; j < 4; ++j) { const f32x4 v = *(const f32x4*)(xr + j * 256 + lane * 4); const f32x4 s4 = *(const f32x4*)(sc + j * 256 + lane * 4);
            ss += (v[0] * v[0] + v[1] * v[1]) + (v[2] * v[2] + v[3] * v[3]);
            const f32x4 a = v * (s4 + 1.f); u32x2 w; w.x = pk2(a[0], a[1]); w.y = pk2(a[2], a[3]); ao[j * 64 + lane] = w; }
        ss = wave_sum(ss);
        if (lane == 0) W.rss0[row] = ss;
    }
    for (int it = gw; it < 2 * NPAD; it += NGW) {
        const int l = it / NPAD, n = it % NPAD;
        const bf16_t* wrow = W.WinT + ((size_t)l * NPAD + n) * 1024 + lane * 16;
        const u32x4 w0 = *(const u32x4*)wrow, w1 = *(const u32x4*)(wrow + 8);
        float wf[16];
#pragma unroll
        for (int e = 0; e < 4; ++e) { wf[2 * e] = bflo(w0[e]); wf[2 * e + 1] = bfhi(w0[e]); wf[8 + 2 * e] = bflo(w1[e]); wf[8 + 2 * e + 1] = bfhi(w1[e]); }
        float extra = 0.f;
        if (n >= 2816) extra = p.gla_b_up[(l * 2 + ((n - 2816) >> 7)) * 128 + ((n - 2816) & 127)];
#pragma unroll
        for (int r = 0; r < 9; ++r) {
            const float* sh = W.modv + (l * 9 + r) * 3072 + lane * 16; float s = 0.f;
#pragma unroll
            for (int q = 0; q < 4; ++q) { const f32x4 s4 = *(const f32x4*)(sh + 4 * q); s += s4[0] * wf[4 * q] + s4[1] * wf[4 * q + 1] + s4[2] * wf[4 * q + 2] + s4[3] * wf[4 * q + 3]; }
            s = wave_sum(s);
            if (lane == 0) W.biasz[(l * 9 + r) * NPAD + n] = s + extra;
        }
    }
}

__device__ __forceinline__ void conv_unit(const Params& p, const WS& W, int layer, int sidx, int tile, LAS unsigned char* lds) {
    int tid_ = threadIdx.x; asm volatile("" : "+v"(tid_)); const int tid = tid_, lane = tid & 63, wave = tid >> 6;
    const bool isctx = sidx >= 8; const int b = sidx & 7;
    const int L = isctx ? NCTX : SEQ; const int rowbase = isctx ? ML + b * NCTX : b * SEQ; const int t0 = tile * 64;
    LAS float* U = (LAS float*)lds;
    for (int idx = tid; idx < 94 * 32; idx += 512) {
        const int tt = idx >> 5, ch = idx & 31, t = t0 - 15 + tt;
        f32x4 u0 = {0.f, 0.f, 0.f, 0.f}, u1 = {0.f, 0.f, 0.f, 0.f};
        if (t >= 0 && t < L) { const bf16_t* zr = W.Z + (size_t)(rowbase + t) * ZLD + ch * 8; const u32x4 a = *(const u32x4*)zr, g = *(const u32x4*)(zr + 256);
            u0[0] = bflo(a[0]) * sigmoid_f(bflo(g[0])); u0[1] = bfhi(a[0]) * sigmoid_f(bfhi(g[0])); u0[2] = bflo(a[1]) * sigmoid_f(bflo(g[1])); u0[3] = bfhi(a[1]) * sigmoid_f(bfhi(g[1]));
            u1[0] = bflo(a[2]) * sigmoid_f(bflo(g[2])); u1[1] = bfhi(a[2]) * sigmoid_f(bfhi(g[2])); u1[2] = bflo(a[3]) * sigmoid_f(bflo(g[3])); u1[3] = bfhi(a[3]) * sigmoid_f(bfhi(g[3])); }
        *(LAS f32x4*)(U + tt * 256 + ch * 8) = u0; *(LAS f32x4*)(U + tt * 256 + ch * 8 + 4) = u1;
    }
    __syncthreads();
    {
        const int c = tid & 255, half = tid >> 8;
        float uu[62], wgt[31];
#pragma unroll
        for (int i = 0; i < 62; ++i) uu[i] = U[(half * 32 + i) * 256 + c];
#pragma unroll
        for (int j = 0; j < 31; ++j) wgt[j] = p.conv_w[(layer * 31 + j) * 256 + c];
        const float cb = p.conv_b[layer * 256 + c];
        __syncthreads();
#pragma unroll
        for (int t = 0; t < 32; ++t) { float a = cb;
#pragma unroll
            for (int j = 0; j < 31; ++j) a = fmaf(wgt[j], uu[t + j], a);
            U[(half * 32 + t) * 256 + c] = a; }
    }
    __syncthreads();
    {
        const f32x4 lw = *(const f32x4*)(p.conv_ln_w + layer * 256 + lane * 4), lb = *(const f32x4*)(p.conv_ln_b + layer * 256 + lane * 4);
#pragma unroll 2
        for (int tk = 0; tk < 8; ++tk) {
            const int t = wave * 8 + tk; const int row = rowbase + t0 + t;
            const f32x4 v = *(const LAS f32x4*)(U + t * 256 + lane * 4);
            const float mean = wave_sum((v[0] + v[1]) + (v[2] + v[3])) * (1.f / 256.f);
            const f32x4 dv = v - mean;
            const float var = wave_sum((dv[0] * dv[0] + dv[1] * dv[1]) + (dv[2] * dv[2] + dv[3] * dv[3])) * (1.f / 256.f);
            const float rstd = rsqrtf(var + EPS);
            const u32x2 gz = *(const u32x2*)(W.Z + (size_t)row * ZLD + 512 + lane * 4);
            f32x4 y = dv * rstd * lw + lb;
            const float o0 = silu_f(y[0]) * silu_f(bflo(gz.x)), o1 = silu_f(y[1]) * silu_f(bfhi(gz.x)), o2 = silu_f(y[2]) * silu_f(bflo(gz.y)), o3 = silu_f(y[3]) * silu_f(bfhi(gz.y));
            u32x2 w; w.x = pk2(o0, o1); w.y = pk2(o2, o3);
            *(u32x2*)(W.Y + (size_t)row * 1024 + lane * 4) = w;
        }
    }
    __syncthreads();
}

#define GLA_CUMSUM(bc, tot, larow, dir, lane)                                                               \
    do {                                                                                                    \
        _Pragma("unroll") for (int q_ = 0; q_ < 8; ++q_) { const f32x4 t4_ = *(const f32x4*)((larow) + 4 * q_); bc[4 * q_] = t4_[0]; bc[4 * q_ + 1] = t4_[1]; bc[4 * q_ + 2] = t4_[2]; bc[4 * q_ + 3] = t4_[3]; } \
        _Pragma("unroll") for (int d_ = 0; d_ < 32; ++d_) { float x_ = bc[d_];                                \
            if ((dir) == 0) { _Pragma("unroll") for (int o_ = 1; o_ < 64; o_ <<= 1) { const float y_ = __shfl_up(x_, o_); if ((lane) >= o_) x_ += y_; } tot[d_] = __shfl(x_, 63); } \
            else { _Pragma("unroll") for (int o_ = 1; o_ < 64; o_ <<= 1) { const float y_ = __shfl_down(x_, o_); if ((lane) + o_ < 64) x_ += y_; } tot[d_] = __shfl(x_, 0); } \
            bc[d_] = x_; }                                                                                  \
    } while (0)

__device__ __forceinline__ void gla_state_unit(const WS& W, int b, bool isctx, int n, LAS unsigned char* lds) {
    int tid_ = threadIdx.x; asm volatile("" : "+v"(tid_)); const int tid = tid_, lane = tid & 63, wave = __builtin_amdgcn_readfirstlane(tid >> 6);
    const int dir = wave >> 2, h = wave & 3;
    const int row0 = (isctx ? ML + b * NCTX : b * SEQ) + n * 64;
    LAS unsigned char* Vb = lds;
    LAS unsigned char* KW = lds + 49152 + wave * 5120;
#pragma unroll
    for (int i = 0; i < 4; ++i) { const int idx = tid + 512 * i, t = idx >> 5, hh = (idx >> 3) & 3, ch = idx & 7;
        *(LAS u32x4*)(Vb + hh * 12288 + t * 192 + ch * 16) = *(const u32x4*)(W.Z + (size_t)(row0 + t) * ZLD + 2304 + hh * 64 + ch * 8); }
    float bc[32], tot[32];
    const float* larow = W.LA + (size_t)(row0 + lane) * 256 + dir * 128 + h * 32;
    GLA_CUMSUM(bc, tot, larow, dir, lane);
    const int c = dir == 0 ? (isctx ? n : 4 + n) : (isctx ? 3 - n : 67 - n);
    const size_t cbase = (size_t)(((b * 2 + dir) * NCHAIN + c) * 4 + h);
    {
        const bf16_t* kp = W.Z + (size_t)(row0 + lane) * ZLD + 2176 + h * 32;
#pragma unroll
        for (int q = 0; q < 4; ++q) { const u32x4 kk = *(const u32x4*)(kp + 8 * q); u32x4 o;
#pragma unroll
            for (int e = 0; e < 4; ++e) { const int d = 8 * q + 2 * e; o[e] = pk2(bflo(kk[e]) * __expf(tot[d] - bc[d]), bfhi(kk[e]) * __expf(tot[d + 1] - bc[d + 1])); }
            *(LAS u32x4*)(KW + lane * 80 + q * 16) = o; }
        if (lane == (dir == 0 ? 63 : 0)) { float* dp = W.dec + cbase * 32;
#pragma unroll
            for (int q = 0; q < 8; ++q) { f32x4 o = {__expf(bc[4 * q]), __expf(bc[4 * q + 1]), __expf(bc[4 * q + 2]), __expf(bc[4 * q + 3])}; *(f32x4*)(dp + 4 * q) = o; } }
    }
    __syncthreads();
    {
        const int i16 = lane & 15, gi = (lane >> 4) & 1, hi = lane >> 5, l31 = lane & 31;
        const LAS unsigned char* kwb = KW + (i16 >> 2) * 80 + (16 * gi + 4 * (i16 & 3)) * 2 + (8 * hi) * 80;
        const LAS unsigned char* vb = Vb + h * 12288 + (i16 >> 2) * 192 + (16 * gi + 4 * (i16 & 3)) * 2 + (8 * hi) * 192;
        float* stp = W.ST + cbase * 2048;
#pragma unroll
        for (int vt = 0; vt < 2; ++vt) {
            f32x16 acc = {};
#pragma unroll
            for (int s = 0; s < 4; ++s) {
                const bf16x8 a = cat8(tr_read(kwb + (16 * s) * 80), tr_read(kwb + (16 * s + 4) * 80));
                const bf16x8 bb = cat8(tr_read(vb + (16 * s) * 192 + vt * 64), tr_read(vb + (16 * s + 4) * 192 + vt * 64));
                acc = MFMA32(a, bb, acc);
            }
#pragma unroll
            for (int r = 0; r < 16; ++r) { const int d = (r & 3) + 8 * (r >> 2) + 4 * hi; stp[d * 64 + 32 * vt + l31] = acc[r]; }
        }
    }
    __syncthreads();
}

__device__ __forceinline__ void gla_scan(const WS& W) {
    int tid_ = threadIdx.x; asm volatile("" : "+v"(tid_));
    for (int idx = blockIdx.x * 512 + tid_; idx < 131072; idx += gridDim.x * 512) {
        const int v = idx & 63, d = (idx >> 6) & 31, h = (idx >> 11) & 3, bd = idx >> 13;
        float* sp = W.ST + ((size_t)(bd * NCHAIN) * 4 + h) * 2048 + d * 64 + v;
        const float* dp = W.dec + ((size_t)(bd * NCHAIN) * 4 + h) * 32 + d;
        float S = 0.f;
        for (int c0 = 0; c0 < NCHAIN; c0 += 4) {
            float st[4], dc[4];
#pragma unroll
            for (int j = 0; j < 4; ++j) { st[j] = sp[(size_t)(c0 + j) * 8192]; dc[j] = dp[(size_t)(c0 + j) * 128]; }
#pragma unroll
            for (int j = 0; j < 4; ++j) { sp[(size_t)(c0 + j) * 8192] = S; S = dc[j] * S + st[j]; }
        }
    }
}

__device__ __forceinline__ void gla_out_unit(const Params& p, const WS& W, int layer, int b, bool isctx, int n, int hp, LAS unsigned char* lds) {
    int tid_ = threadIdx.x; asm volatile("" : "+v"(tid_)); const int tid = tid_, lane = tid & 63, wave = __builtin_amdgcn_readfirstlane(tid >> 6);
    const int dh = wave >> 1, dir = dh >> 1, hl = dh & 1, h = hp * 2 + hl, th = wave & 1;
    const int row0 = (isctx ? ML + b * NCTX : b * SEQ) + n * 64;
    LAS unsigned char* Vb = lds;
    LAS unsigned char* QK = lds + 24576;
    LAS unsigned char* SI = lds + 65536;
    LAS float* OB = (LAS float*)(lds + 90112);
#pragma unroll
    for (int i = 0; i < 2; ++i) { const int idx = tid + 512 * i, t = idx >> 4, hh = (idx >> 3) & 1, ch = idx & 7;
        *(LAS u32x4*)(Vb + hh * 12288 + t * 192 + ch * 16) = *(const u32x4*)(W.Z + (size_t)(row0 + t) * ZLD + 2304 + (hp * 2 + hh) * 64 + ch * 8); }
#pragma unroll
    for (int i = 0; i < 2; ++i) { const int idx = tid + 512 * i, q = idx >> 8, d = (idx >> 3) & 31, ch = idx & 7;
        const int qdir = q >> 1, qh = hp * 2 + (q & 1);
        const int c = qdir == 0 ? (isctx ? n : 4 + n) : (isctx ? 3 - n : 67 - n);
        const float* sp = W.ST + ((size_t)(((b * 2 + qdir) * NCHAIN + c) * 4 + qh)) * 2048 + d * 64 + ch * 8;
        const f32x4 s0 = *(const f32x4*)sp, s1 = *(const f32x4*)(sp + 4);
        u32x4 o; o.x = pk2(s0[0], s0[1]); o.y = pk2(s0[2], s0[3]); o.z = pk2(s1[0], s1[1]); o.w = pk2(s1[2], s1[3]);
        *(LAS u32x4*)(SI + q * 6144 + d * 192 + ch * 16) = o; }
    if (th == 0) {
        float bc[32], tot[32];
        const float* larow = W.LA + (size_t)(row0 + lane) * 256 + dir * 128 + h * 32;
        GLA_CUMSUM(bc, tot, larow, dir, lane);
        const bf16_t* qp = W.Z + (size_t)(row0 + lane) * ZLD + 2048 + h * 32;
        LAS unsigned char* qi = QK + dh * 10240 + lane * 80; LAS unsigned char* ki = qi + 5120;
#pragma unroll
        for (int q = 0; q < 4; ++q) { const u32x4 qq = *(const u32x4*)(qp + 8 * q), kk = *(const u32x4*)(qp + 128 + 8 * q); u32x4 oq, ok;
#pragma unroll
            for (int e = 0; e < 4; ++e) { const int d = 8 * q + 2 * e; const float e0 = __expf(bc[d]), e1 = __expf(bc[d + 1]);
                oq[e] = pk2(bflo(qq[e]) * e0, bfhi(qq[e]) * e1); ok[e] = pk2(bflo(kk[e]) / e0, bfhi(kk[e]) / e1); }
            *(LAS u32x4*)(qi + q * 16) = oq; *(LAS u32x4*)(ki + q * 16) = ok; }
    }
    __syncthreads();
    const int i16 = lane & 15, gi = (lane >> 4) & 1, hi = lane >> 5, l31 = lane & 31;
    f32x16 o[2];
    {
        const LAS unsigned char* qib = QK + dh * 10240; const LAS unsigned char* kib = qib + 5120;
        bf16x8 qf[2];
#pragma unroll
        for (int s = 0; s < 2; ++s) qf[s] = *(const LAS bf16x8*)(qib + (32 * th + l31) * 80 + (2 * s + hi) * 16);
        f32x16 at[2];
#pragma unroll
        for (int st = 0; st < 2; ++st) { f32x16 a = {};
#pragma unroll
            for (int s = 0; s < 2; ++s) { const bf16x8 kf = *(const LAS bf16x8*)(kib + (32 * st + l31) * 80 + (2 * s + hi) * 16); a = MFMA32(kf, qf[s], a); }
            const int tq = 32 * th + l31;
#pragma unroll
            for (int r = 0; r < 16; ++r) { const int sk = 32 * st + (r & 3) + 8 * (r >> 2) + 4 * hi; const bool keep = dir == 0 ? (sk <= tq) : (sk >= tq); a[r] = keep ? a[r] : 0.f; }
            at[st] = a; }
        const LAS unsigned char* vb = Vb + hl * 12288 + (i16 >> 2) * 192 + (16 * gi + 4 * (i16 & 3)) * 2;
        const LAS unsigned char* sb = SI + dh * 6144 + (i16 >> 2) * 192 + (16 * gi + 4 * (i16 & 3)) * 2 + (8 * hi) * 192;
#pragma unroll
        for (int vt = 0; vt < 2; ++vt) {
            f32x16 acc = {};
#pragma unroll
            for (int st = 0; st < 2; ++st)
#pragma unroll
                for (int sk = 0; sk < 2; ++sk) { const int r0 = 32 * st + 16 * sk + 4 * hi;
                    const bf16x8 a = cat8(tr_read(vb + r0 * 192 + vt * 64), tr_read(vb + (r0 + 8) * 192 + vt * 64));
                    acc = MFMA32(a, pack_acc8(at[st], sk), acc); }
#pragma unroll
            for (int s = 0; s < 2; ++s) { const bf16x8 a = cat8(tr_read(sb + (16 * s) * 192 + vt * 64), tr_read(sb + (16 * s + 4) * 192 + vt * 64)); acc = MFMA32(a, qf[s], acc); }
            o[vt] = acc;
        }
    }
    if (dir == 1) {
#pragma unroll
        for (int vt = 0; vt < 2; ++vt)
#pragma unroll
            for (int r = 0; r < 16; ++r) { const int v = 32 * vt + (r & 3) + 8 * (r >> 2) + 4 * hi; OB[hl * 4096 + v * 64 + 32 * th + l31] = o[vt][r]; }
    }
    __syncthreads();
    if (dir == 0) {
        float ss = 0.f;
#pragma unroll
        for (int vt = 0; vt < 2; ++vt)
#pragma unroll
            for (int r = 0; r < 16; ++r) { const int v = 32 * vt + (r & 3) + 8 * (r >> 2) + 4 * hi; const float x = o[vt][r] + OB[hl * 4096 + v * 64 + 32 * th + l31]; o[vt][r] = x; ss += x * x; }
        ss += __shfl_xor(ss, 32);
        const float rinv = rsqrtf(ss * (1.f / 64.f) + EPS);
        const int row = row0 + 32 * th + l31;
#pragma unroll
        for (int vt = 0; vt < 2; ++vt)
#pragma unroll
            for (int r4 = 0; r4 < 4; ++r4) { const int v = 32 * vt + 8 * r4 + 4 * hi;
                const u32x2 gz = *(const u32x2*)(W.Z + (size_t)row * ZLD + 2560 + h * 64 + v);
                const f32x4 nw = *(const f32x4*)(p.gla_norm_w + layer * 256 + h * 64 + v);
                const float a0 = o[vt][4 * r4] * rinv * nw[0] * silu_f(bflo(gz.x)), a1 = o[vt][4 * r4 + 1] * rinv * nw[1] * silu_f(bfhi(gz.x));
                const float a2 = o[vt][4 * r4 + 2] * rinv * nw[2] * silu_f(bflo(gz.y)), a3 = o[vt][4 * r4 + 3] * rinv * nw[3] * silu_f(bfhi(gz.y));
                u32x2 w; w.x = pk2(a0, a1); w.y = pk2(a2, a3);
                *(u32x2*)(W.Y + (size_t)row * 1024 + 768 + h * 64 + v) = w; }
    }
    __syncthreads();
}

__device__ __forceinline__ void attn_unit(const Params& p, const WS& W, int layer, int b, int g, int qb, bool isctx, LAS unsigned char* lds) {
    int tid_ = threadIdx.x; asm volatile("" : "+v"(tid_)); const int tid = tid_, lane = tid & 63, wave = __builtin_amdgcn_readfirstlane(tid >> 6);
    const int l31 = lane & 31, hi = lane >> 5, i16 = lane & 15, gi = (lane >> 4) & 1;
    const int head = g * 4 + (wave >> 1);
    const int seqbase = isctx ? ML + b * NCTX : b * SEQ;
    const int q0 = qb * 128, tq0 = q0 + (wave & 1) * 64;
    constexpr int KB = 64 * 144, VB = 64 * 192, STG = KB + VB;
    bf16x8 qf[2][4];
#pragma unroll
    for (int ct = 0; ct < 2; ++ct)
#pragma unroll
        for (int ds = 0; ds < 4; ++ds) qf[ct][ds] = *(const bf16x8*)(W.Z + (size_t)(seqbase + tq0 + 32 * ct + l31) * ZLD + 768 + 256 * (head >> 2) + 128 * (ds >> 1) + 32 * (head & 3) + 16 * (ds & 1) + 8 * hi);
    const int jlo = isctx ? 0 : (qb == 0 ? 2 : 0), jhi = isctx ? -1 : (qb == 31 ? 3 : 5);
    const int NT = 4 + (jhi - jlo + 1);
    const int kvr = tid >> 3, ch = tid & 7;
    const int gcolK = 1280 + 128 * (ch >> 2) + 32 * g + 8 * (ch & 3);
    const int ctxbase = ML + b * NCTX;
    const float sink2 = p.attn_sink[layer * 8 + head] * LOG2E;
    float mrun[2] = {sink2, sink2}, lsum[2] = {hi == 0 ? 1.f : 0.f, hi == 0 ? 1.f : 0.f};
    f32x16 O[2][2];
#pragma unroll
    for (int dt = 0; dt < 2; ++dt)
#pragma unroll
        for (int ct = 0; ct < 2; ++ct) O[dt][ct] = (f32x16){};
    u32x4 kreg, vreg;
#define ATT_KROW(ti) ((ti) < 4 ? ctxbase + 64 * (ti) : b * SEQ + q0 - 128 + 64 * (jlo + (ti) - 4))
#define ATT_LOAD(ti) do { const bf16_t* src_ = W.Z + (size_t)(ATT_KROW(ti) + kvr) * ZLD + gcolK; kreg = *(const u32x4*)src_; vreg = *(const u32x4*)(src_ + 64); } while (0)
#define ATT_STORE(st) do { *(LAS u32x4*)(lds + (st) * STG + kvr * 144 + ch * 16) = kreg; *(LAS u32x4*)(lds + (st) * STG + KB + kvr * 192 + ch * 16) = vreg; } while (0)
    ATT_LOAD(0); ATT_STORE(0);
    __syncthreads();
    for (int ti = 0; ti < NT; ++ti) {
        const int st = ti & 1;
        if (ti + 1 < NT) ATT_LOAD(ti + 1);
        bool active = true, need_mask = false; int k0 = 0;
        if (ti >= 4) { k0 = q0 - 128 + 64 * (jlo + ti - 4); active = (k0 + 63 >= tq0 - 128) && (k0 <= tq0 + 191); need_mask = !((k0 >= tq0 - 65) && (k0 <= tq0 + 65)); }
        if (active) {
            const LAS unsigned char* Kb = lds + st * STG; const LAS unsigned char* Vbp = Kb + KB;
            f32x16 s[2][2];
#pragma unroll
            for (int rt = 0; rt < 2; ++rt) {
                s[rt][0] = (f32x16){}; s[rt][1] = (f32x16){};
#pragma unroll
                for (int ds = 0; ds < 4; ++ds) { const bf16x8 kf = *(const LAS bf16x8*)(Kb + (32 * rt + l31) * 144 + (2 * ds + hi) * 16);
                    s[rt][0] = MFMA32(kf, qf[0][ds], s[rt][0]); s[rt][1] = MFMA32(kf, qf[1][ds], s[rt][1]); }
            }
            if (need_mask) {
#pragma unroll
                for (int rt = 0; rt < 2; ++rt)
#pragma unroll
                    for (int ct = 0; ct < 2; ++ct)
#pragma unroll
                        for (int r = 0; r < 16; ++r) { const int kp = k0 + 32 * rt + (r & 3) + 8 * (r >> 2) + 4 * hi, qp = tq0 + 32 * ct + l31; const int dd = qp - kp;
                            if (dd > 128 || dd < -128) s[rt][ct][r] = -1e30f; }
            }
#pragma unroll
            for (int ct = 0; ct < 2; ++ct) {
                float mx = s[0][ct][0];
#pragma unroll
                for (int r = 1; r < 16; ++r) mx = fmaxf(mx, s[0][ct][r]);
#pragma unroll
                for (int r = 0; r < 16; ++r) mx = fmaxf(mx, s[1][ct][r]);
                mx = fmaxf(mx, __shfl_xor(mx, 32));
                const float mnew = fmaxf(mrun[ct], mx); const float alpha = __builtin_amdgcn_exp2f(mrun[ct] - mnew); mrun[ct] = mnew;
                float ls = 0.f;
#pragma unroll
                for (int rt = 0; rt < 2; ++rt)
#pragma unroll
                    for (int r = 0; r < 16; ++r) { const float pe = __builtin_amdgcn_exp2f(s[rt][ct][r] - mnew); s[rt][ct][r] = pe; ls += pe; }
                lsum[ct] = lsum[ct] * alpha + ls;
#pragma unroll
                for (int dt = 0; dt < 2; ++dt) O[dt][ct] = O[dt][ct] * alpha;
            }
            const LAS unsigned char* vb = Vbp + (i16 >> 2) * 192 + (16 * gi + 4 * (i16 & 3)) * 2;
#pragma unroll
            for (int rt = 0; rt < 2; ++rt)
#pragma unroll
                for (int sk = 0; sk < 2; ++sk) {
                    const bf16x8 p0 = pack_acc8(s[rt][0], sk), p1 = pack_acc8(s[rt][1], sk);
                    const int r0 = 32 * rt + 16 * sk + 4 * hi;
#pragma unroll
                    for (int dt = 0; dt < 2; ++dt) { const bf16x8 vf = cat8(tr_read(vb + r0 * 192 + dt * 64), tr_read(vb + (r0 + 8) * 192 + dt * 64));
                        O[dt][0] = MFMA32(vf, p0, O[dt][0]); O[dt][1] = MFMA32(vf, p1, O[dt][1]); }
                }
        }
        if (ti + 1 < NT) ATT_STORE(st ^ 1);
        __syncthreads();
    }
#undef ATT_KROW
#undef ATT_LOAD
#undef ATT_STORE
#pragma unroll
    for (int ct = 0; ct < 2; ++ct) {
        const float lt = lsum[ct] + __shfl_xor(lsum[ct], 32); const float inv = 1.f / lt;
        const int row = seqbase + tq0 + 32 * ct + l31;
#pragma unroll
        for (int dt = 0; dt < 2; ++dt)
#pragma unroll
            for (int r4 = 0; r4 < 4; ++r4) { const int d = 32 * dt + 8 * r4 + 4 * hi;
                const u32x2 gz = *(const u32x2*)(W.Z + (size_t)row * ZLD + 1536 + head * 64 + d);
                const float a0 = O[dt][ct][4 * r4] * inv * silu_f(bflo(gz.x)), a1 = O[dt][ct][4 * r4 + 1] * inv * silu_f(bfhi(gz.x));
                const float a2 = O[dt][ct][4 * r4 + 2] * inv * silu_f(bflo(gz.y)), a3 = O[dt][ct][4 * r4 + 3] * inv * silu_f(bfhi(gz.y));
                u32x2 w; w.x = pk2(a0, a1); w.y = pk2(a2, a3);
                *(u32x2*)(W.Y + (size_t)row * 1024 + 256 + head * 64 + d) = w; }
    }
}

__device__ __forceinline__ void phase_final(const Params& p, const WS& W) {
    int tid_ = threadIdx.x; asm volatile("" : "+v"(tid_)); const int tid = tid_, lane = tid & 63, wave = tid >> 6;
    const int gw = blockIdx.x * 8 + wave, NGW = gridDim.x * 8;
    f32x4 fw[4];
#pragma unroll
    for (int j = 0; j < 4; ++j) fw[j] = *(const f32x4*)(p.final_norm_w + j * 256 + lane * 4);
    for (int row = gw; row < ML; row += NGW) {
        const float rinv = rsqrtf(W.rss2[row] * (1.f / 1024.f) + EPS);
        float* xr = p.out + (size_t)row * 1024;
#pragma unroll
        for (int j = 0; j < 4; ++j) { const f32x4 v = *(const f32x4*)(xr + j * 256 + lane * 4); *(f32x4*)(xr + j * 256 + lane * 4) = v * rinv * fw[j]; }
    }
}

__global__ void __launch_bounds__(512, 2) fwd_kernel(Params p) {
    extern __shared__ __attribute__((aligned(16))) unsigned char lds_raw[];
    LAS unsigned char* lds = (LAS unsigned char*)lds_raw;
    const int G = gridDim.x;
    volatile LAS unsigned* bst = (volatile LAS unsigned*)(lds + 131072 + 512);
    if (threadIdx.x < 2) bst[threadIdx.x] = 0u;
    __syncthreads();
    XcdBarrier xbar = xcd_barrier_post((unsigned*)(p.ws + WS_CTL), bst);
    for (int ph = p.ph_lo; ph < p.ph_hi; ++ph) {
        if (ph > p.ph_lo) {
#if USE_CG_SYNC
            cg::this_grid().sync();
#else
            xcd_barrier(xbar);
#endif
        }
        unsigned char* wsb = p.ws; asm volatile("" : "+s"(wsb));
        int bx = blockIdx.x; asm volatile("" : "+s"(bx));
        const WS W = make_ws(wsb);
        if (RUNSUB(10) && ph == 0) { for (int rep = 0; rep < NREP(10); ++rep) { phase_prep0(p, W, lds); __syncthreads(); } }
        else if (RUNSUB(11) && ph == 1) { for (int rep = 0; rep < NREP(11); ++rep) phase_prep1(p, W); }
        else if (RUNSUB(12) && ph == 12) { phase_final(p, W); }
        else if (ph >= 2 && ph < 12) {
            const int layer = (ph - 2) / 5, sub = (ph - 2) % 5;
            if (RUNSUB(0) && sub == 0) {
                pg8::Gemm gm{W.A, W.WinT + (size_t)layer * NPAD * 1024, MT, NPAD, 1024}; pg8::StaticOrder S; S.init(MT, NPAD, G, bx);
                pg8::EpiIn E{W.Z, W.LA, layer == 0 ? W.rss0 : W.rss1, W.biasz + layer * 9 * NPAD, W.rope};
#if DUP_SUB == 21
                { pg8::EpiInT<true> E2{W.Z, W.LA, layer == 0 ? W.rss0 : W.rss1, W.biasz + layer * 9 * NPAD, W.rope}; pg8::gemm_phase<pg8::EpiInT<true>, pg8::StaticOrder, true, true>(lds, gm, S, E2); }
#endif
                for (int rep = 0; rep < NREP(0); ++rep) pg8::gemm_phase<pg8::EpiIn, pg8::StaticOrder, true, true>(lds, gm, S, E);
            } else if ((RUNSUB(1) || RUNSUB(5)) && sub == 1) {
                const int nconv = layer == 0 ? 544 : 512;
                if (RUNSUB(1)) for (int rep = 0; rep < NREP(1); ++rep) for (int u = bx; u < nconv; u += G) { if (u < 512) conv_unit(p, W, layer, u >> 6, u & 63, lds); else conv_unit(p, W, layer, 8 + ((u - 512) >> 2), (u - 512) & 3, lds); }
                if (RUNSUB(5)) for (int rep = 0; rep < NREP(5); ++rep) for (int u = bx; u < 544; u += G) { if (u < 512) gla_state_unit(W, u >> 6, false, u & 63, lds); else gla_state_unit(W, (u - 512) >> 2, true, (u - 512) & 3, lds); }
            } else if (RUNSUB(2) && sub == 2) {
                gla_scan(W);
                const int natt = layer == 0 ? 544 : 512;
                for (int rep = 0; rep < NREP(2); ++rep) for (int u = bx; u < natt; u += G) { if (u < 512) attn_unit(p, W, layer, u >> 6, (u >> 5) & 1, u & 31, false, lds); else { const int v = u - 512; attn_unit(p, W, layer, v >> 2, (v >> 1) & 1, v & 1, true, lds); } }
            } else if (RUNSUB(3) && sub == 3) {
                const int nu = layer == 0 ? 1088 : 1024;
                for (int rep = 0; rep < NREP(3); ++rep) for (int u = bx; u < nu; u += G) { if (u < 1024) gla_out_unit(p, W, layer, u >> 7, false, (u >> 1) & 63, u & 1, lds); else { const int v = u - 1024; gla_out_unit(p, W, layer, v >> 3, true, (v >> 1) & 3, v & 1, lds); } }
            } else if (RUNSUB(4) && sub == 4) {
                const int Mo = layer == 0 ? MT : ML;
                pg8::Gemm gm{W.Y, W.WoutT + (size_t)layer * 1024 * 1024, Mo, 1024, 1024}; pg8::StaticOrder S; S.init(Mo, 1024, G, bx);
                pg8::EpiOut E{layer == 0 ? p.x : p.out, p.ctx, p.out, W.modv + layer * 9 * 3072, layer == 0 ? W.modv + 9 * 3072 : nullptr, layer == 0 ? W.A : nullptr, layer == 0 ? W.rss1 : W.rss2};
                if (DUP_SUB == 4) { pg8::EpiOut E2{layer == 0 ? p.x : p.out, p.ctx, (float*)W.Z, W.modv + layer * 9 * 3072, nullptr, nullptr, W.rss0};
                    pg8::gemm_phase<pg8::EpiOut, pg8::StaticOrder, true, true>(lds, gm, S, E2); }
                pg8::gemm_phase<pg8::EpiOut, pg8::StaticOrder, true, true>(lds, gm, S, E);
            }
        }
    }
}

extern "C" void kernel_launch(void* const* d_in, const int* in_sizes, int n_in, void* d_out, int out_size, void* d_ws, size_t ws_size, hipStream_t stream) {
    static int grid = 0;
    if (grid == 0) {
        if (n_in != 17 || out_size != ML * D || ws_size < WS_END) { fprintf(stderr, "kernel_launch: unexpected shapes (n_in %d, out %d, ws %zu)\n", n_in, out_size, ws_size); grid = -1; return; }
        int dev = 0, cus = 0, per_cu = 0;
        hipGetDevice(&dev); hipDeviceGetAttribute(&cus, hipDeviceAttributeMultiprocessorCount, dev);
        hipFuncSetAttribute((const void*)fwd_kernel, hipFuncAttributeMaxDynamicSharedMemorySize, LDS_BYTES);
        hipOccupancyMaxActiveBlocksPerMultiprocessor(&per_cu, (const void*)fwd_kernel, 512, LDS_BYTES);
        if (per_cu < 1) { fprintf(stderr, "kernel_launch: occupancy query says %d blocks/CU\n", per_cu); per_cu = 1; }
        (void)hipGetLastError();
        grid = cus;
    }
    if (grid < 0) return;
    Params p{};
    p.x = (const float*)d_in[0]; p.c = (const float*)d_in[1]; p.ctx = (const float*)d_in[2]; p.c_ctx = (const float*)d_in[3]; p.w_mod = (const float*)d_in[4]; p.b_mod = (const float*)d_in[5];
    p.w_in = (const float*)d_in[6]; p.conv_w = (const float*)d_in[7]; p.conv_b = (const float*)d_in[8]; p.conv_ln_w = (const float*)d_in[9]; p.conv_ln_b = (const float*)d_in[10];
    p.attn_sink = (const float*)d_in[11]; p.gla_w_up = (const float*)d_in[12]; p.gla_b_up = (const float*)d_in[13]; p.gla_norm_w = (const float*)d_in[14]; p.w_out = (const float*)d_in[15];
    p.final_norm_w = (const float*)d_in[16]; p.out = (float*)d_out; p.ws = (unsigned char*)d_ws;
#if MK_MULTI
    for (int ph = 0; ph < NPHASE; ++ph) { p.ph_lo = ph; p.ph_hi = ph + 1; hipLaunchKernelGGL(fwd_kernel, dim3(grid), dim3(512), LDS_BYTES, stream, p); }
#else
    p.ph_lo = 0; p.ph_hi = NPHASE;
    if (hipMemsetAsync((char*)d_ws + WS_CTL, 0, 16384, stream) != hipSuccess) { fprintf(stderr, "kernel_launch: memset failed\n"); return; }
    void* args[] = {&p};
    hipError_t e = hipLaunchCooperativeKernel((void*)fwd_kernel, dim3(grid), dim3(512), args, LDS_BYTES, stream);
    if (e != hipSuccess) fprintf(stderr, "cooperative launch failed: %s (grid %d)\n", hipGetErrorString(e), grid);
#endif
}
```

```cpp
#include <hip/hip_runtime.h>
#include <hip/hip_cooperative_groups.h>
#include <cstdio>
#include <cstdint>
namespace cg = cooperative_groups;
namespace pg8 {
#define PG8_LAS __attribute__((address_space(3)))
typedef unsigned short bf16_t;
typedef short bf16x8 __attribute__((ext_vector_type(8)));
typedef float f32x4 __attribute__((ext_vector_type(4)));
typedef unsigned u32x4 __attribute__((ext_vector_type(4)));
constexpr int BM = 256, BK = 64, HALF = 128, HTB = HALF * BK * 2  , STAGE_BYTES = 8 * HTB, NXCD = 8, WGM = 8;

__host__ __device__ __forceinline__ int lds_byte(int r, int c) { const int st = (r >> 4) * 2 + (c >> 5), rr = r & 15, cc = c & 31, ob = rr * 64 + cc * 2; return st * 1024 + (ob ^ (((ob >> 9) & 1) << 5)); }
__host__ __device__ __forceinline__ void stage_rc(int b, int& R, int& C) { const int st = b / 1024, sb = b % 1024, swz = sb ^ (((sb >> 9) & 1) << 5); R = (st >> 1) * 16 + swz / 64; C = (st & 1) * 32 + (swz % 64) / 2; }
__host__ __device__ __forceinline__ int perm32(int rho) { const int n = rho >> 4, i = rho & 15; return 8 * (i >> 2) + 4 * n + (i & 3); }

struct Unit { int pm, pn; };
struct Gemm { const bf16_t* A; const bf16_t* Bt; int M, N, K; };

struct StaticOrder {
    int nM, nN, nwg, G, c;
    __host__ __device__ void init(int M, int N, int G_, int c_) { nM = M / BM; nN = N / BM; nwg = nM * nN; G = G_; c = c_; }
    __host__ __device__ bool next(int i, Unit& u) const {
        const long L = (long)i * G + c; if (L >= nwg) return false;
        int wgid = (int)L; { const int q = nwg / NXCD, r = nwg % NXCD, xcd = wgid % NXCD, off = wgid / NXCD; wgid = (xcd < r ? xcd * (q + 1) : r * (q + 1) + (xcd - r) * q) + off; }
        const int nig = WGM * nN, gid = wgid / nig, fm = gid * WGM, gsz = (nM - fm) < WGM ? (nM - fm) : WGM;
        u.pm = fm + ((wgid % nig) % gsz); u.pn = (wgid % nig) / gsz; return true;
    }
    __device__ __forceinline__ void a_ready(const Unit&) const {}
    __device__ __forceinline__ void done(const Unit&) const {}
};
__device__ __forceinline__ unsigned cvt_pk_bf16(float lo, float hi) { unsigned r; asm volatile("v_cvt_pk_bf16_f32 %0, %1, %2" : "=v"(r) : "v"(lo), "v"(hi)); return r; }
template <class Epi, class Sched, bool ALIGN_EPI = false, bool SP2 = false>
__device__ __forceinline__ void gemm_phase(PG8_LAS unsigned char* lds, const Gemm g, const Sched& S, const Epi& E) {
    int tid_ = threadIdx.x; asm volatile("" : "+v"(tid_)); const int tid = tid_, wid = __builtin_amdgcn_readfirstlane(tid >> 6), lane = tid & 63, wr = wid >> 2, wc = wid & 3, fr = lane & 15, fq = lane >> 4;
    const int K = g.K, nt = K / BK;
    unsigned voffA[2], voffB[2];
#pragma unroll
    for (int i = 0; i < 2; ++i) { int R, C; stage_rc(tid * 16 + i * 8192, R, C); const int Rb = Epi::PERM ? ((R & ~31) + perm32(R & 31)) : R;
        voffA[i] = (unsigned)(R * K + C) * 2u; voffB[i] = (unsigned)(Rb * K + C) * 2u; }
    const size_t kstep = (size_t)(BK * 2);
    const size_t hstep = (size_t)HALF * K * 2;
    const size_t tstep = 2 * hstep;
    const unsigned ldsw = (unsigned)wid * 1024u;
    const int aoff = lds_byte(wr * 64 + fr, fq * 8), boff = lds_byte(wc * 32 + fr, fq * 8);
#define PG8_SA(b, h) (((b) * 2 + (h)) * HTB)
#define PG8_SB(b, h) ((4 + (b) * 2 + (h)) * HTB)
#define PG8_STAGE(bufoff, gbase, voff) do { _Pragma("unroll") for (int _i = 0; _i < 2; ++_i) \
        __builtin_amdgcn_global_load_lds((const unsigned*)((const char*)(gbase) + (voff)[_i]), (PG8_LAS unsigned*)(lds + (bufoff) + ldsw + _i * 8192), 16, 0, 0); } while (0)
#define PG8_LDA(dst, b, h) do { _Pragma("unroll") for (int m = 0; m < 4; ++m) _Pragma("unroll") for (int k = 0; k < 2; ++k) dst[m][k] = *(const PG8_LAS bf16x8*)(lds + PG8_SA(b, h) + aoff + m * 2048 + k * 1024); } while (0)
#define PG8_LDB(dst, b, h) do { _Pragma("unroll") for (int n = 0; n < 2; ++n) _Pragma("unroll") for (int k = 0; k < 2; ++k) dst[n][k] = *(const PG8_LAS bf16x8*)(lds + PG8_SB(b, h) + boff + n * 2048 + k * 1024); } while (0)
#define PG8_MMA(ai, bj, At, Bt) do { __builtin_amdgcn_s_setprio(1); _Pragma("unroll") for (int m = 0; m < 4; ++m) _Pragma("unroll") for (int n = 0; n < 2; ++n) _Pragma("unroll") for (int k = 0; k < 2; ++k) \
        acc[ai][bj][m][n] = __builtin_amdgcn_mfma_f32_16x16x32_bf16(Bt[n][k], At[m][k], acc[ai][bj][m][n], 0, 0, 0); __builtin_amdgcn_s_setprio(0); } while (0)
#define PG8_WAIT_V(n) asm volatile("s_waitcnt vmcnt(" #n ")" ::: "memory")
#define PG8_WAIT_L(n) asm volatile("s_waitcnt lgkmcnt(" #n ")" ::: "memory")
#define PG8_BAR __builtin_amdgcn_s_barrier()
#define PG8_SCHED __builtin_amdgcn_sched_barrier(0)
    Unit cur, nxt; int ui = 0;
    if (!S.next(0, cur)) return;
    f32x4 acc[2][2][4][2];
#pragma unroll
    for (int a = 0; a < 2; ++a)
#pragma unroll
        for (int b = 0; b < 2; ++b)
#pragma unroll
            for (int m = 0; m < 4; ++m)
#pragma unroll
                for (int n = 0; n < 2; ++n) acc[a][b][m][n] = (f32x4){0.f, 0.f, 0.f, 0.f};
    bf16x8 At[4][2], B0[2][2], B1[2][2];
    const char* cA = (const char*)g.A + (size_t)cur.pm * tstep; const char* cB = (const char*)g.Bt + (size_t)cur.pn * tstep;
    S.a_ready(cur);
    if constexpr (SP2) {
        PG8_STAGE(PG8_SB(0, 0), cB, voffB); PG8_STAGE(PG8_SB(0, 1), cB + hstep, voffB); PG8_STAGE(PG8_SA(0, 0), cA, voffA); PG8_STAGE(PG8_SA(0, 1), cA + hstep, voffA);
        if (wr == 1) PG8_BAR;
        PG8_WAIT_V(2); PG8_BAR;
        PG8_STAGE(PG8_SB(1, 0), cB + kstep, voffB); PG8_STAGE(PG8_SA(1, 0), cA + kstep, voffA); PG8_STAGE(PG8_SB(1, 1), cB + hstep + kstep, voffB);
        PG8_WAIT_V(6); PG8_BAR;
    } else {
        PG8_STAGE(PG8_SB(0, 0), cB, voffB); PG8_STAGE(PG8_SA(0, 0), cA, voffA); PG8_STAGE(PG8_SB(0, 1), cB + hstep, voffB); PG8_STAGE(PG8_SA(0, 1), cA + hstep, voffA);
        if (wr == 1) PG8_BAR;
        PG8_WAIT_V(4); PG8_BAR;
        PG8_STAGE(PG8_SB(1, 0), cB + kstep, voffB); PG8_STAGE(PG8_SA(1, 0), cA + kstep, voffA); PG8_STAGE(PG8_SB(1, 1), cB + hstep + kstep, voffB);
        PG8_WAIT_V(6); PG8_BAR;
    }
    for (;;) {
        const bool has_next = S.next(ui + 1, nxt);
        const char* nA = has_next ? (const char*)g.A + (size_t)nxt.pm * tstep : cA; const char* nB = has_next ? (const char*)g.Bt + (size_t)nxt.pn * tstep : cB;
        for (int t = 0; t < nt; t += 2) {
            const bool last = (t == nt - 2);
            const char* a1 = cA + (size_t)(t + 1) * kstep;
            const char* a2 = last ? nA : cA + (size_t)(t + 2) * kstep; const char* b2 = last ? nB : cB + (size_t)(t + 2) * kstep;
            const char* a3 = a2 + kstep; const char* b3 = b2 + kstep;
            if (last && has_next) S.a_ready(nxt);
            if constexpr (SP2) {
            PG8_LDB(B0, 0, 0); PG8_LDB(B1, 0, 1); PG8_SCHED; PG8_LDA(At, 0, 0); PG8_STAGE(PG8_SA(1, 1), a1 + hstep, voffA);
            PG8_WAIT_V(8); PG8_WAIT_L(0); PG8_BAR; PG8_MMA(0, 0, At, B0); PG8_MMA(0, 1, At, B1); PG8_BAR; PG8_SCHED;
            PG8_LDA(At, 0, 1); PG8_STAGE(PG8_SB(0, 0), b2, voffB); PG8_STAGE(PG8_SB(0, 1), b2 + hstep, voffB); PG8_STAGE(PG8_SA(0, 0), a2, voffA);
            PG8_WAIT_V(8); PG8_WAIT_L(0); PG8_BAR; PG8_MMA(1, 0, At, B0); PG8_MMA(1, 1, At, B1); PG8_BAR; PG8_SCHED;
            PG8_LDB(B0, 1, 0); PG8_LDB(B1, 1, 1); PG8_SCHED; PG8_LDA(At, 1, 0); PG8_STAGE(PG8_SA(0, 1), a2 + hstep, voffA);
            PG8_WAIT_V(8); PG8_WAIT_L(0); PG8_BAR; PG8_MMA(0, 0, At, B0); PG8_MMA(0, 1, At, B1); PG8_BAR; PG8_SCHED;
            PG8_LDA(At, 1, 1); PG8_STAGE(PG8_SB(1, 0), b3, voffB); PG8_STAGE(PG8_SB(1, 1), b3 + hstep, voffB); PG8_STAGE(PG8_SA(1, 0), a3, voffA);
            PG8_WAIT_V(8); PG8_WAIT_L(0); PG8_BAR; PG8_MMA(1, 0, At, B0); PG8_MMA(1, 1, At, B1); PG8_BAR; PG8_SCHED;
            } else {
            PG8_LDB(B0, 0, 0); PG8_SCHED; PG8_LDA(At, 0, 0); PG8_STAGE(PG8_SA(1, 1), a1 + hstep, voffA);
            PG8_WAIT_L(8); PG8_BAR; PG8_WAIT_L(0); PG8_MMA(0, 0, At, B0); PG8_BAR; PG8_SCHED;
            PG8_LDB(B1, 0, 1); PG8_STAGE(PG8_SB(0, 0), b2, voffB);
            PG8_BAR; PG8_WAIT_L(0); PG8_MMA(0, 1, At, B1); PG8_BAR;
            PG8_LDA(At, 0, 1); PG8_STAGE(PG8_SA(0, 0), a2, voffA);
            PG8_BAR; PG8_WAIT_L(0); PG8_MMA(1, 0, At, B0); PG8_BAR; PG8_SCHED;
            PG8_STAGE(PG8_SB(0, 1), b2 + hstep, voffB);
            PG8_WAIT_V(6); PG8_BAR; PG8_MMA(1, 1, At, B1); PG8_BAR;
            PG8_LDB(B0, 1, 0); PG8_SCHED; PG8_LDA(At, 1, 0); PG8_STAGE(PG8_SA(0, 1), a2 + hstep, voffA);
            PG8_WAIT_L(8); PG8_BAR; PG8_WAIT_L(0); PG8_MMA(0, 0, At, B0); PG8_BAR; PG8_SCHED;
            PG8_LDB(B1, 1, 1); PG8_STAGE(PG8_SB(1, 0), b3, voffB);
            PG8_BAR; PG8_WAIT_L(0); PG8_MMA(0, 1, At, B1); PG8_BAR;
            PG8_LDA(At, 1, 1); PG8_STAGE(PG8_SA(1, 0), a3, voffA);
            PG8_BAR; PG8_WAIT_L(0); PG8_MMA(1, 0, At, B0); PG8_BAR; PG8_SCHED;
            PG8_STAGE(PG8_SB(1, 1), b3 + hstep, voffB);
            PG8_WAIT_V(6); PG8_BAR; PG8_MMA(1, 1, At, B1); PG8_BAR;
            }
        }
        if constexpr (ALIGN_EPI) { if (wr == 0) PG8_BAR; }
        if constexpr (!Epi::AFTER_DRAIN) { E(acc, cur, wr, wc, fr, fq); S.done(cur); }
        if (!has_next) break;
#pragma unroll
        for (int a = 0; a < 2; ++a)
#pragma unroll
            for (int b = 0; b < 2; ++b)
#pragma unroll
                for (int m = 0; m < 4; ++m)
#pragma unroll
                    for (int n = 0; n < 2; ++n) acc[a][b][m][n] = (f32x4){0.f, 0.f, 0.f, 0.f};
        cur = nxt; cA = nA; cB = nB; ++ui;
        if constexpr (ALIGN_EPI) { if (wr == 1) PG8_BAR; }
    }
    PG8_WAIT_V(0);
    if constexpr (!ALIGN_EPI) { if (wr == 0) PG8_BAR; }
    PG8_BAR;
    if constexpr (Epi::AFTER_DRAIN) { E.fused(acc, cur, wr, wc, fr, fq, lds, wid, lane); S.done(cur); }
#undef PG8_SA
#undef PG8_SB
#undef PG8_STAGE
#undef PG8_LDA
#undef PG8_LDB
#undef PG8_MMA
#undef PG8_WAIT_V
#undef PG8_WAIT_L
#undef PG8_BAR
#undef PG8_SCHED
}
}

#ifndef DIAG_SUB
#define DIAG_SUB -1
#endif
#define RUNSUB(k) (DIAG_SUB < 0 || DIAG_SUB == (k))
#ifndef DUP_SUB
#define DUP_SUB -1
#endif
#define NREP(k) ((DUP_SUB == (k)) ? 2 : 1)
#ifndef USE_CG_SYNC
#define USE_CG_SYNC 0
#endif
#ifndef MK_MULTI
#define MK_MULTI 0
#endif
constexpr int D = 1024, NB = 8, SEQ = 4096, NCTX = 256;
constexpr int ML = NB * SEQ;
constexpr int MC = NB * NCTX;
constexpr int MT = ML + MC;
constexpr int NPAD = 3072, ZLD = 2816;
constexpr float EPS = 1e-6f;
constexpr float LOG2E = 1.4426950408889634f;
constexpr float QSCALE = 0.125f * LOG2E;
constexpr float GQSCALE = 0.17677669529663687f;
constexpr int NCHAIN = 68;
constexpr int NPHASE = 12;
constexpr int LDS_BYTES = 147456;

constexpr size_t MiB = 1u << 20;
constexpr size_t WS_CTL = 0, WS_WINT = 2 * MiB, WS_WOUTT = 14 * MiB, WS_MODV = 18 * MiB, WS_BIASZ = 18 * MiB + 256 * 1024, WS_ROPE = 18 * MiB + 512 * 1024;
constexpr size_t WS_RSS0 = 19 * MiB, WS_RSS1 = 19 * MiB + 256 * 1024, WS_RSS2 = 19 * MiB + 512 * 1024, WS_DEC = 20 * MiB;
constexpr size_t WS_A = 24 * MiB, WS_Y = 92 * MiB, WS_LA = 160 * MiB, WS_ST = 194 * MiB, WS_Z = 228 * MiB, WS_END = 415 * MiB;

#define LAS __attribute__((address_space(3)))
typedef unsigned short bf16_t;
typedef float f32x4 __attribute__((ext_vector_type(4)));
typedef float f32x2 __attribute__((ext_vector_type(2)));
typedef float f32x16 __attribute__((ext_vector_type(16)));
typedef short bf16x8 __attribute__((ext_vector_type(8)));
typedef short s16x4 __attribute__((ext_vector_type(4)));
typedef unsigned u32x4 __attribute__((ext_vector_type(4)));
typedef unsigned u32x2 __attribute__((ext_vector_type(2)));

struct Params {
    const float *x, *c, *ctx, *c_ctx, *w_mod, *b_mod, *w_in, *conv_w, *conv_b, *conv_ln_w, *conv_ln_b, *attn_sink, *gla_w_up, *gla_b_up, *gla_norm_w, *w_out, *final_norm_w;
    float* out; unsigned char* ws;
    int ph_lo, ph_hi;
};
struct WS {
    bf16_t *WinT, *WoutT, *A, *Y, *Z;
    float *modv, *biasz, *rope, *rss0, *rss1, *rss2, *dec, *LA, *ST;
};
__device__ __forceinline__ WS make_ws(unsigned char* ws) {
    WS W; W.WinT = (bf16_t*)(ws + WS_WINT); W.WoutT = (bf16_t*)(ws + WS_WOUTT); W.A = (bf16_t*)(ws + WS_A); W.Y = (bf16_t*)(ws + WS_Y); W.Z = (bf16_t*)(ws + WS_Z);
    W.modv = (float*)(ws + WS_MODV); W.biasz = (float*)(ws + WS_BIASZ); W.rope = (float*)(ws + WS_ROPE); W.rss0 = (float*)(ws + WS_RSS0); W.rss1 = (float*)(ws + WS_RSS1);
    W.rss2 = (float*)(ws + WS_RSS2); W.dec = (float*)(ws + WS_DEC); W.LA = (float*)(ws + WS_LA); W.ST = (float*)(ws + WS_ST); return W;
}

__device__ __forceinline__ unsigned pk2(float lo, float hi) { typedef __bf16 b2 __attribute__((ext_vector_type(2))); f32x2 v = {lo, hi}; b2 b = __builtin_convertvector(v, b2); return __builtin_bit_cast(unsigned, b); }
__device__ __forceinline__ float bflo(unsigned w) { return __uint_as_float(w << 16); }
__device__ __forceinline__ float bfhi(unsigned w) { return __uint_as_float(w & 0xffff0000u); }
__device__ __forceinline__ float silu_f(float v) { return v * __builtin_amdgcn_rcpf(1.f + __expf(-v)); }
__device__ __forceinline__ float sigmoid_f(float v) { return __builtin_amdgcn_rcpf(1.f + __expf(-v)); }
__device__ __forceinline__ float wave_sum(float v) {
#pragma unroll
    for (int o = 1; o < 64; o <<= 1) v += __shfl_xor(v, o);
    return v;
}
typedef short v4i16_t __attribute__((ext_vector_type(4)));
__device__ __forceinline__ s16x4 tr_read(const LAS unsigned char* p) { return __builtin_bit_cast(s16x4, __builtin_amdgcn_ds_read_tr16_b64_v4i16((LAS v4i16_t*)p)); }
__device__ __forceinline__ bf16x8 cat8(s16x4 a, s16x4 b) { return (bf16x8){a[0], a[1], a[2], a[3], b[0], b[1], b[2], b[3]}; }
#define MFMA32(a, b, c) __builtin_amdgcn_mfma_f32_32x32x16_bf16((a), (b), (c), 0, 0, 0)
__device__ __forceinline__ bf16x8 pack_acc8(const f32x16& v, int s) {
    u32x4 w; w.x = pk2(v[8 * s + 0], v[8 * s + 1]); w.y = pk2(v[8 * s + 2], v[8 * s + 3]); w.z = pk2(v[8 * s + 4], v[8 * s + 5]); w.w = pk2(v[8 * s + 6], v[8 * s + 7]);
    return __builtin_bit_cast(bf16x8, w);
}

#define XB_TMO      128
#define XB_XCNT(j)  (256  + 64 * (j))
#define XB_XSUB(j)  (1280 + 64 * (j))
#define XB_XGEN(j)  (2304 + 64 * (j))
#define XB_TOP      3328
#define XB_TOPGEN   3392
#define XCD_BAR_WORDS 3456
#define XB_SPIN_CAP (1u << 18)

__device__ __forceinline__ unsigned xb_ld(unsigned* p)              { return __hip_atomic_load(p, __ATOMIC_RELAXED, __HIP_MEMORY_SCOPE_AGENT); }
__device__ __forceinline__ unsigned xb_add(unsigned* p, unsigned v) { return __hip_atomic_fetch_add(p, v, __ATOMIC_RELAXED, __HIP_MEMORY_SCOPE_AGENT); }
__device__ __forceinline__ unsigned xb_xcc_id() { return (unsigned)__builtin_amdgcn_s_getreg((3 << 11) | 20) & 0xFu; }
#define XB_SPIN(cond, bar) do { unsigned _sp = 0; while (cond) { __builtin_amdgcn_s_sleep(1); \
    if ((++_sp & 255u) == 0u) { if (xb_ld(&(bar)[XB_TMO])) break; if (_sp > XB_SPIN_CAP) { atomicAdd(&(bar)[XB_TMO], 1u); break; } } } } while (0)

struct XcdBarrier {
    unsigned* bar; unsigned x;
    volatile LAS unsigned* st;
};

__device__ __forceinline__ XcdBarrier xcd_barrier_post(unsigned* bar, volatile LAS unsigned* st) {
    XcdBarrier b; b.bar = bar; b.x = xb_xcc_id(); b.st = st;
    if (threadIdx.x == 0) (void)xb_add(&bar[XB_XCNT(b.x)], 1u);
    return b;
}
__device__ __forceinline__ void xcd_barrier_complete(unsigned* bar, unsigned x, unsigned& nloc, unsigned& nx) {
    const unsigned G = gridDim.x * gridDim.y * gridDim.z;
    unsigned sum, cnt, mine, sp = 0u;
    for (;;) {
        sum = 0u; cnt = 0u; mine = 0u;
#pragma unroll
        for (unsigned j = 0; j < 16; ++j) { const unsigned c = xb_ld(&bar[XB_XCNT(j)]); sum += c; cnt += (c > 0u) ? 1u : 0u; mine = (j == x) ? c : mine; }
        if (sum == G) break;
        __builtin_amdgcn_s_sleep(1);
        if ((++sp & 255u) == 0u) { if (xb_ld(&bar[XB_TMO])) break; if (sp > XB_SPIN_CAP) { atomicAdd(&bar[XB_TMO], 1u); break; } }
    }
    nloc = mine > 0u ? mine : 1u; nx = cnt > 0u ? cnt : 1u;
}

__device__ __forceinline__ void xcd_barrier(const XcdBarrier& b) {
    asm volatile("s_waitcnt vmcnt(0)" ::: "memory");
    __syncthreads();
    if (threadIdx.x == 0) {
        unsigned* bar = b.bar;
        __builtin_amdgcn_s_waitcnt(0);
        unsigned nloc = b.st[0], nx = b.st[1];
        if (nloc == 0u) { xcd_barrier_complete(bar, b.x, nloc, nx); b.st[0] = nloc; b.st[1] = nx; }
        const unsigned old = xb_add(&bar[XB_XSUB(b.x)], 1u);
        const unsigned gen = old / nloc;
        if (old + 1u == (gen + 1u) * nloc) {
            __builtin_amdgcn_fence(__ATOMIC_RELEASE, "agent");
            asm volatile("s_waitcnt vmcnt(0)" ::: "memory");
            const unsigned og = xb_add(&bar[XB_TOP], 1u);
            const unsigned tg = og / nx;
            if (og + 1u == (tg + 1u) * nx) xb_add(&bar[XB_TOPGEN], 1u);
            else XB_SPIN(xb_ld(&bar[XB_TOPGEN]) == tg, bar);
            __builtin_amdgcn_fence(__ATOMIC_ACQUIRE, "agent");
            xb_add(&bar[XB_XGEN(b.x)], 1u);
            asm volatile("s_waitcnt vmcnt(0)" ::: "memory");
        } else {
            XB_SPIN(xb_ld(&bar[XB_XGEN(b.x)]) == gen, bar);
            __builtin_amdgcn_fence(__ATOMIC_ACQUIRE, "agent");
            asm volatile("s_waitcnt vmcnt(0)" ::: "memory");
        }
    }
    __syncthreads();
}

namespace pg8 {

template <bool DRY> struct EpiInT {
    static constexpr bool PERM = true, AFTER_DRAIN = false;
    bf16_t* Z; float* LA; const float* rss; const float* biasz; const float* rope;
    __device__ __forceinline__ void operator()(const f32x4 (&acc)[2][2][4][2], const Unit& u, int wr, int wc, int fr_, int fq_) const {
        int fr = fr_, fq = fq_; asm volatile("" : "+v"(fr), "+v"(fq));
        const int pn = u.pn; const bool latent = u.pm < 128; const int bsel = latent ? (u.pm >> 4) : 8;
        const float* bz = biasz + bsel * NPAD + pn * 256 + wc * 32 + 8 * fq;
        const bool do_rope = latent && (pn == 3 || pn == 4 || (pn == 5 && wc < 2));
        const float s0 = (pn == 3 || pn == 4) ? QSCALE : (pn == 8 ? GQSCALE : 1.f), s1 = (pn == 3 || pn == 4) ? QSCALE : 1.f;
        const int ropeoff = 8 * (fq & 1);
        if (pn == 11) {
#pragma unroll
            for (int ai = 0; ai < 2; ++ai) {
                const int rowb = u.pm * 256 + ai * 128 + wr * 64 + fr;
                float rinv4[4];
#pragma unroll
                for (int m = 0; m < 4; ++m) rinv4[m] = rsqrtf(rss[rowb + 16 * m] * (1.f / 1024.f) + EPS);
#pragma unroll
                for (int bj = 0; bj < 2; ++bj)
#pragma unroll
                    for (int n = 0; n < 2; ++n) {
                        const f32x4 b4 = *(const f32x4*)(bz + bj * 128 + n * 4);
                        f32x4 x[4];
#pragma unroll
                        for (int m = 0; m < 4; ++m) { const f32x4 zz = acc[ai][bj][m][n] * rinv4[m] + b4;
#pragma unroll
                            for (int e = 0; e < 4; ++e) x[m][e] = (fminf(zz[e], 0.f) - __logf(1.f + __expf(-fabsf(zz[e])))) * (1.f / 16.f); }
#pragma unroll
                        for (int m = 0; m < 4; ++m)
#pragma unroll
                            for (int e = 0; e < 4; ++e) { float xv = x[m][e];
#pragma unroll
                                for (int o = 1; o < 16; o <<= 1) { if (bj == 0) { const float y = __shfl_up(xv, o, 16); if (fr >= o) xv += y; } else { const float y = __shfl_down(xv, o, 16); if (fr + o < 16) xv += y; } }
                                x[m][e] = xv; }
                        f32x4 tot[4];
#pragma unroll
                        for (int m = 0; m < 4; ++m)
#pragma unroll
                            for (int e = 0; e < 4; ++e) tot[m][e] = __shfl(x[m][e], bj == 0 ? 15 : 0, 16);
                        if (bj == 0) { x[1] = x[1] + tot[0]; x[2] = x[2] + (tot[0] + tot[1]); x[3] = x[3] + ((tot[0] + tot[1]) + tot[2]); }
                        else { x[2] = x[2] + tot[3]; x[1] = x[1] + (tot[3] + tot[2]); x[0] = x[0] + ((tot[3] + tot[2]) + tot[1]); }
#pragma unroll
                        for (int m = 0; m < 4; ++m) if (!DRY || x[m][0] == 12345.f) *(f32x4*)(LA + (size_t)(rowb + 16 * m) * 256 + bj * 128 + wc * 32 + 8 * fq + 4 * n) = x[m];
                    }
            }
            return;
        }
#pragma unroll
        for (int ai = 0; ai < 2; ++ai)
#pragma unroll
            for (int m = 0; m < 4; ++m) {
                const int row = u.pm * 256 + ai * 128 + wr * 64 + m * 16 + fr;
                const float rinv = rsqrtf(rss[row] * (1.f / 1024.f) + EPS);
                f32x4 v[2][2];
#pragma unroll
                for (int bj = 0; bj < 2; ++bj)
#pragma unroll
                    for (int n = 0; n < 2; ++n) v[bj][n] = acc[ai][bj][m][n] * rinv + *(const f32x4*)(bz + bj * 128 + n * 4);
                if (do_rope) {
                    const int t = row & 4095; const int pp = (fq < 2) ? (t >> 6) : (t & 63);
#pragma unroll
                    for (int n = 0; n < 2; ++n) {
                        const f32x4 c4 = *(const f32x4*)(rope + pp * 16 + ropeoff + 4 * n), s4 = *(const f32x4*)(rope + 1024 + pp * 16 + ropeoff + 4 * n);
                        const f32x4 x1 = v[0][n], x2 = v[1][n];
                        v[0][n] = x1 * c4 - x2 * s4; v[1][n] = x2 * c4 + x1 * s4;
                    }
                }
                if (pn == 11) {
                } else {
                    bf16_t* zr = Z + (size_t)row * ZLD + pn * 256 + wc * 32 + 8 * fq;
#pragma unroll
                    for (int bj = 0; bj < 2; ++bj) { const float sc = bj == 0 ? s0 : s1; const f32x4 a = v[bj][0] * sc, b = v[bj][1] * sc;
                        u32x4 w; w.x = pk2(a[0], a[1]); w.y = pk2(a[2], a[3]); w.z = pk2(b[0], b[1]); w.w = pk2(b[2], b[3]);
                        if (!DRY || w.x == 0x12345678u) *(u32x4*)(zr + bj * 128) = w; }
                }
            }
    }
};
typedef EpiInT<false> EpiIn;
struct EpiOut {
    static constexpr bool PERM = true, AFTER_DRAIN = false;
    const float* xl; const float* xc; float* xout; const float* modv_l; const float* modv_next; bf16_t* Anext; float* rss_out;
    __device__ __forceinline__ void operator()(const f32x4 (&acc)[2][2][4][2], const Unit& u, int wr, int wc, int fr_, int fq_) const {
        int fr = fr_, fq = fq_; asm volatile("" : "+v"(fr), "+v"(fq));
        const int pn = u.pn; const bool latent = u.pm < 128; const int bsel = latent ? (u.pm >> 4) : 8;
        const int colb = pn * 256 + wc * 32 + 8 * fq;
        const float* gp = modv_l + bsel * 3072 + 2048 + colb;
        const float* sp = modv_next ? modv_next + bsel * 3072 + 1024 + colb : nullptr;
#pragma unroll
        for (int ai = 0; ai < 2; ++ai)
#pragma unroll
            for (int m = 0; m < 4; ++m) {
                const int row = u.pm * 256 + ai * 128 + wr * 64 + m * 16 + fr;
                const float* xin = (latent ? xl + (size_t)row * 1024 : xc + (size_t)(row - ML) * 1024) + colb;
                float ss = 0.f;
#pragma unroll
                for (int bj = 0; bj < 2; ++bj) {
                    f32x4 o[2];
#pragma unroll
                    for (int n = 0; n < 2; ++n) { const f32x4 x4 = *(const f32x4*)(xin + bj * 128 + 4 * n); const f32x4 g4 = *(const f32x4*)(gp + bj * 128 + 4 * n);
                        o[n] = x4 + g4 * acc[ai][bj][m][n]; ss += (o[n][0] * o[n][0] + o[n][1] * o[n][1]) + (o[n][2] * o[n][2] + o[n][3] * o[n][3]); }
                    if (latent) { float* xo = xout + (size_t)row * 1024 + colb + bj * 128; *(f32x4*)xo = o[0]; *(f32x4*)(xo + 4) = o[1]; }
                    if (sp) { const f32x4 a = o[0] * (*(const f32x4*)(sp + bj * 128) + 1.f), b = o[1] * (*(const f32x4*)(sp + bj * 128 + 4) + 1.f);
                        u32x4 w; w.x = pk2(a[0], a[1]); w.y = pk2(a[2], a[3]); w.z = pk2(b[0], b[1]); w.w = pk2(b[2], b[3]);
                        *(u32x4*)(Anext + (size_t)row * 1024 + colb + bj * 128) = w; }
                }
                ss += __shfl_xor(ss, 16); ss += __shfl_xor(ss, 32);
                if (fq == 0) atomicAdd(rss_out + row, ss);
            }
    }
};
struct EpiOutFin {
    static constexpr bool PERM = true, AFTER_DRAIN = false;
    const float* xl; float* out; const float* modv_l; const float* fw; float* rss; unsigned* cnt; LAS unsigned* flag;
    __device__ __forceinline__ void operator()(const f32x4 (&acc_)[2][2][4][2], const Unit& u, int wr, int wc, int fr_, int fq_) const {
        f32x4 (&acc)[2][2][4][2] = const_cast<f32x4 (&)[2][2][4][2]>(acc_);
        int fr = fr_, fq = fq_; asm volatile("" : "+v"(fr), "+v"(fq));
        const int pn = u.pn; const int bsel = u.pm >> 4;
        const int colb = pn * 256 + wc * 32 + 8 * fq;
        const float* gp = modv_l + bsel * 3072 + 2048 + colb;
#pragma unroll
        for (int ai = 0; ai < 2; ++ai)
#pragma unroll
            for (int m = 0; m < 4; ++m) {
                const int row = u.pm * 256 + ai * 128 + wr * 64 + m * 16 + fr;
                const float* xin = xl + (size_t)row * 1024 + colb;
                float ss = 0.f;
#pragma unroll
                for (int bj = 0; bj < 2; ++bj)
#pragma unroll
                    for (int n = 0; n < 2; ++n) { const f32x4 x4 = *(const f32x4*)(xin + bj * 128 + 4 * n); const f32x4 g4 = *(const f32x4*)(gp + bj * 128 + 4 * n);
                        const f32x4 o = x4 + g4 * acc[ai][bj][m][n]; acc[ai][bj][m][n] = o; ss += (o[0] * o[0] + o[1] * o[1]) + (o[2] * o[2] + o[3] * o[3]); }
                ss += __shfl_xor(ss, 16); ss += __shfl_xor(ss, 32);
                if (fq == 0) atomicAdd(rss + row, ss);
            }
        asm volatile("s_waitcnt vmcnt(0)" ::: "memory");
        __syncthreads();
        if (threadIdx.x == 0) {
            __hip_atomic_fetch_add(cnt + 64 * u.pm, 1u, __ATOMIC_RELAXED, __HIP_MEMORY_SCOPE_AGENT);
            unsigned sp_ = 0;
            while (__hip_atomic_load(cnt + 64 * u.pm, __ATOMIC_RELAXED, __HIP_MEMORY_SCOPE_AGENT) < 4u) { __builtin_amdgcn_s_sleep(2); if (++sp_ > (1u << 22)) break; }
        }
        __syncthreads();
#pragma unroll
        for (int ai = 0; ai < 2; ++ai)
#pragma unroll
            for (int m = 0; m < 4; ++m) {
                const int row = u.pm * 256 + ai * 128 + wr * 64 + m * 16 + fr;
                const float rinv = rsqrtf(__hip_atomic_load(rss + row, __ATOMIC_RELAXED, __HIP_MEMORY_SCOPE_AGENT) * (1.f / 1024.f) + EPS);
                float* xo = out + (size_t)row * 1024 + colb;
#pragma unroll
                for (int bj = 0; bj < 2; ++bj)
#pragma unroll
                    for (int n = 0; n < 2; ++n) *(f32x4*)(xo + bj * 128 + 4 * n) = acc[ai][bj][m][n] * rinv * *(const f32x4*)(fw + colb + bj * 128 + 4 * n);
            }
    }
};
}

__device__ __forceinline__ int win_src_col(int n0) {
    if (n0 < 768) return n0;
    if (n0 < 1280) { const int r = n0 - 768, tq = r >> 8, bj = (r >> 7) & 1, wc = (r >> 5) & 3; return 768 + (4 * tq + wc) * 64 + 32 * bj; }
    if (n0 < 1536) { const int r = n0 - 1280, bj = (r >> 7) & 1, wc = (r >> 5) & 3; return wc < 2 ? 1280 + wc * 64 + 32 * bj : 1408 + (wc - 2) * 64 + 32 * bj; }
    if (n0 < 2560) return n0;
    if (n0 < 2816) return n0 + 32;
    return -1;
}
__device__ __forceinline__ void transpose_item(const float* Wsrc, int N, int srccol, const float* wup  , int lrcol, int j0, bf16_t* WT, int n0dst, int k0, LAS float* scr, int lane) {
#pragma unroll 4
    for (int i = 0; i < 32; ++i) {
        const int kk = 2 * i + (lane >> 5), cc = lane & 31; float v;
        if (wup == nullptr) v = Wsrc[(size_t)(k0 + kk) * N + srccol + cc];
        else { v = 0.f; const float* wr_ = Wsrc + (size_t)(k0 + kk) * N + lrcol;
#pragma unroll
            for (int r = 0; r < 16; ++r) v += wr_[r] * wup[r * 128 + j0 + cc]; }
        scr[kk * 33 + cc] = v;
    }
    asm volatile("s_waitcnt lgkmcnt(0)" ::: "memory");
    const int c = lane & 7;
#pragma unroll
    for (int j = 0; j < 4; ++j) { const int n = (lane >> 3) + 8 * j; const LAS float* s = scr + (8 * c) * 33 + n;
        u32x4 o; o.x = pk2(s[0 * 33], s[1 * 33]); o.y = pk2(s[2 * 33], s[3 * 33]); o.z = pk2(s[4 * 33], s[5 * 33]); o.w = pk2(s[6 * 33], s[7 * 33]);
        *(u32x4*)(WT + (size_t)(n0dst + n) * 1024 + k0 + 8 * c) = o; }
    asm volatile("s_waitcnt lgkmcnt(0)" ::: "memory");
}
__device__ __forceinline__ void phase_prep0(const Params& p, const WS& W, LAS unsigned char* lds) {
    int tid_ = threadIdx.x; asm volatile("" : "+v"(tid_)); const int tid = tid_, lane = tid & 63, wave = tid >> 6;
    {
        LAS float* sc = (LAS float*)lds; LAS float* red = sc + 9 * 1024;
        if ((int)blockIdx.x < 192) {
            for (int idx = tid; idx < 9216; idx += 512) { const int r = idx >> 10, k = idx & 1023; const float v = r < 8 ? p.c[r * 1024 + k] : p.c_ctx[k]; sc[idx] = silu_f(v); }
            __syncthreads();
            for (int it = blockIdx.x; it < 192; it += gridDim.x) {
                const int l = it / 96, cb = it % 96, cc = tid & 31, kg = tid >> 5;
                float a[9];
#pragma unroll
                for (int r = 0; r < 9; ++r) a[r] = 0.f;
                const float* wp = p.w_mod + (size_t)l * 1024 * 3072 + (size_t)(kg * 64) * 3072 + cb * 32 + cc;
#pragma unroll 8
                for (int kk = 0; kk < 64; ++kk) { const float w = wp[(size_t)kk * 3072];
#pragma unroll
                    for (int r = 0; r < 9; ++r) a[r] += sc[r * 1024 + kg * 64 + kk] * w; }
#pragma unroll
                for (int r = 0; r < 9; ++r) red[(kg * 9 + r) * 32 + cc] = a[r];
                __syncthreads();
                if (tid < 288) { const int r = tid >> 5; float s = 0.f;
#pragma unroll
                    for (int g = 0; g < 16; ++g) s += red[(g * 9 + r) * 32 + cc];
                    W.modv[(l * 9 + r) * 3072 + cb * 32 + cc] = s + p.b_mod[l * 3072 + cb * 32 + cc]; }
                __syncthreads();
            }
        }
    }
    if (blockIdx.x == gridDim.x - 1) {
        for (int idx = tid; idx < 1024; idx += 512) { const int pp = idx >> 4, f = idx & 15;
            const float inv = __builtin_amdgcn_exp2f(-(float)f * (13.287712379549449f / 16.f)); const float ang = (float)pp * inv;
            W.rope[idx] = __cosf(ang); W.rope[1024 + idx] = __sinf(ang); }
    }
    for (int i = blockIdx.x * 512 + tid; i < MT; i += gridDim.x * 512) { W.rss1[i] = 0.f; if (i < ML) W.rss2[i] = 0.f; }
    __syncthreads();
    {
        LAS float* scr = (LAS float*)(lds + wave * 16384);
        const int gw = blockIdx.x * 8 + wave, NGW = gridDim.x * 8;
        constexpr int I_IN = 96 * 16, I_OUT = 32 * 16, I_L = I_IN + I_OUT;
        for (int it = gw; it < 2 * I_L; it += NGW) {
            const int l = it / I_L; int r = it % I_L;
            if (r < I_IN) { const int nb = r % 96, kb = r / 96, n0 = nb * 32; const int src = win_src_col(n0);
                if (src >= 0) transpose_item(p.w_in + (size_t)l * 1024 * 2848, 2848, src, nullptr, 0, 0, W.WinT + (size_t)l * NPAD * 1024, n0, kb * 64, scr, lane);
                else { const int dir = (n0 - 2816) >> 7, j0 = (n0 - 2816) & 127;
                    transpose_item(p.w_in + (size_t)l * 1024 * 2848, 2848, 0, p.gla_w_up + (size_t)(l * 2 + dir) * 16 * 128, 2560 + 16 * dir, j0, W.WinT + (size_t)l * NPAD * 1024, n0, kb * 64, scr, lane); } }
            else { r -= I_IN; const int nb = r % 32, kb = r / 32;
                transpose_item(p.w_out + (size_t)l * 1024 * 1024, 1024, nb * 32, nullptr, 0, 0, W.WoutT + (size_t)l * 1024 * 1024, nb * 32, kb * 64, scr, lane); }
        }
    }
}

__device__ __forceinline__ void phase_prep1(const Params& p, const WS& W) {
    int tid_ = threadIdx.x; asm volatile("" : "+v"(tid_)); const int tid = tid_, lane = tid & 63, wave = tid >> 6;
    const int gw = blockIdx.x * 8 + wave, NGW = gridDim.x * 8;
    for (int row = gw; row < MT; row += NGW) {
        const bool latent = row < ML; const int bsel = latent ? (row >> 12) : 8;
        const float* xr = latent ? p.x + (size_t)row * 1024 : p.ctx + (size_t)(row - ML) * 1024;
        const float* sc = W.modv + bsel * 3072 + 1024;
        float ss = 0.f; u32x2* ao = (u32x2*)(W.A + (size_t)row * 1024);
#pragma unroll
        for (int j = 0; j < 4; ++j) { const f32x4 v = *(const f32x4*)(xr + j * 256 + lane * 4); const f32x4 s4 = *(const f32x4*)(sc + j * 256 + lane * 4);
            ss += (v[0] * v[0] + v[1] * v[1]) + (v[2] * v[2] + v[3] * v[3]);
            const f32x4 a = v * (s4 + 1.f); u32x2 w; w.x = pk2(a[0], a[1]); w.y = pk2(a[2], a[3]); ao[j * 64 + lane] = w; }
        ss = wave_sum(ss);
        if (lane == 0) W.rss0[row] = ss;
    }
    for (int it = gw; it < 2 * NPAD; it += NGW) {
        const int l = it / NPAD, n = it % NPAD;
        const bf16_t* wrow = W.WinT + ((size_t)l * NPAD + n) * 1024 + lane * 16;
        const u32x4 w0 = *(const u32x4*)wrow, w1 = *(const u32x4*)(wrow + 8);
        float wf[16];
#pragma unroll
        for (int e = 0; e < 4; ++e) { wf[2 * e] = bflo(w0[e]); wf[2 * e + 1] = bfhi(w0[e]); wf[8 + 2 * e] = bflo(w1[e]); wf[8 + 2 * e + 1] = bfhi(w1[e]); }
        float extra = 0.f;
        if (n >= 2816) extra = p.gla_b_up[(l * 2 + ((n - 2816) >> 7)) * 128 + ((n - 2816) & 127)];
#pragma unroll
        for (int r = 0; r < 9; ++r) {
            const float* sh = W.modv + (l * 9 + r) * 3072 + lane * 16; float s = 0.f;
#pragma unroll
            for (int q = 0; q < 4; ++q) { const f32x4 s4 = *(const f32x4*)(sh + 4 * q); s += s4[0] * wf[4 * q] + s4[1] * wf[4 * q + 1] + s4[2] * wf[4 * q + 2] + s4[3] * wf[4 * q + 3]; }
            s = wave_sum(s);
            if (lane == 0) W.biasz[(l * 9 + r) * NPAD + n] = s + extra;
        }
    }
}

__device__ __forceinline__ void conv_unit(const Params& p, const WS& W, int layer, int sidx, int tile, LAS unsigned char* lds) {
    int tid_ = threadIdx.x; asm volatile("" : "+v"(tid_)); const int tid = tid_, lane = tid & 63, wave = tid >> 6;
    const bool isctx = sidx >= 8; const int b = sidx & 7;
    const int L = isctx ? NCTX : SEQ; const int rowbase = isctx ? ML + b * NCTX : b * SEQ; const int t0 = tile * 64;
    LAS float* U = (LAS float*)lds;
    for (int idx = tid; idx < 94 * 32; idx += 512) {
        const int tt = idx >> 5, ch = idx & 31, t = t0 - 15 + tt;
        f32x4 u0 = {0.f, 0.f, 0.f, 0.f}, u1 = {0.f, 0.f, 0.f, 0.f};
        if (t >= 0 && t < L) { const bf16_t* zr = W.Z + (size_t)(rowbase + t) * ZLD + ch * 8; const u32x4 a = *(const u32x4*)zr, g = *(const u32x4*)(zr + 256);
            u0[0] = bflo(a[0]) * sigmoid_f(bflo(g[0])); u0[1] = bfhi(a[0]) * sigmoid_f(bfhi(g[0])); u0[2] = bflo(a[1]) * sigmoid_f(bflo(g[1])); u0[3] = bfhi(a[1]) * sigmoid_f(bfhi(g[1]));
            u1[0] = bflo(a[2]) * sigmoid_f(bflo(g[2])); u1[1] = bfhi(a[2]) * sigmoid_f(bfhi(g[2])); u1[2] = bflo(a[3]) * sigmoid_f(bflo(g[3])); u1[3] = bfhi(a[3]) * sigmoid_f(bfhi(g[3])); }
        *(LAS f32x4*)(U + tt * 256 + ch * 8) = u0; *(LAS f32x4*)(U + tt * 256 + ch * 8 + 4) = u1;
    }
    __syncthreads();
    {
        const int c = tid & 255, half = tid >> 8;
        float uu[62], wgt[31];
#pragma unroll
        for (int i = 0; i < 62; ++i) uu[i] = U[(half * 32 + i) * 256 + c];
#pragma unroll
        for (int j = 0; j < 31; ++j) wgt[j] = p.conv_w[(layer * 31 + j) * 256 + c];
        const float cb = p.conv_b[layer * 256 + c];
        __syncthreads();
#pragma unroll
        for (int t = 0; t < 32; ++t) { float a = cb;
#pragma unroll
            for (int j = 0; j < 31; ++j) a = fmaf(wgt[j], uu[t + j], a);
            U[(half * 32 + t) * 256 + c] = a; }
    }
    __syncthreads();
    {
        const f32x4 lw = *(const f32x4*)(p.conv_ln_w + layer * 256 + lane * 4), lb = *(const f32x4*)(p.conv_ln_b + layer * 256 + lane * 4);
#pragma unroll 2
        for (int tk = 0; tk < 8; ++tk) {
            const int t = wave * 8 + tk; const int row = rowbase + t0 + t;
            const f32x4 v = *(const LAS f32x4*)(U + t * 256 + lane * 4);
            const float mean = wave_sum((v[0] + v[1]) + (v[2] + v[3])) * (1.f / 256.f);
            const f32x4 dv = v - mean;
            const float var = wave_sum((dv[0] * dv[0] + dv[1] * dv[1]) + (dv[2] * dv[2] + dv[3] * dv[3])) * (1.f / 256.f);
            const float rstd = rsqrtf(var + EPS);
            const u32x2 gz = *(const u32x2*)(W.Z + (size_t)row * ZLD + 512 + lane * 4);
            f32x4 y = dv * rstd * lw + lb;
            const float o0 = silu_f(y[0]) * silu_f(bflo(gz.x)), o1 = silu_f(y[1]) * silu_f(bfhi(gz.x)), o2 = silu_f(y[2]) * silu_f(bflo(gz.y)), o3 = silu_f(y[3]) * silu_f(bfhi(gz.y));
            u32x2 w; w.x = pk2(o0, o1); w.y = pk2(o2, o3);
            *(u32x2*)(W.Y + (size_t)row * 1024 + lane * 4) = w;
        }
    }
    __syncthreads();
}

#define GLA_CUMSUM(bc, tot, larow, dir, lane)                                                               \
    do {                                                                                                    \
        _Pragma("unroll") for (int q_ = 0; q_ < 8; ++q_) { const f32x4 t4_ = *(const f32x4*)((larow) + 4 * q_); bc[4 * q_] = t4_[0]; bc[4 * q_ + 1] = t4_[1]; bc[4 * q_ + 2] = t4_[2]; bc[4 * q_ + 3] = t4_[3]; } \
        _Pragma("unroll") for (int d_ = 0; d_ < 32; ++d_) { float x_ = bc[d_];                                \
            if ((dir) == 0) { _Pragma("unroll") for (int o_ = 1; o_ < 64; o_ <<= 1) { const float y_ = __shfl_up(x_, o_); if ((lane) >= o_) x_ += y_; } tot[d_] = __shfl(x_, 63); } \
            else { _Pragma("unroll") for (int o_ = 1; o_ < 64; o_ <<= 1) { const float y_ = __shfl_down(x_, o_); if ((lane) + o_ < 64) x_ += y_; } tot[d_] = __shfl(x_, 0); } \
            bc[d_] = x_; }                                                                                  \
    } while (0)

#define GLA_LOADB(bc, tot, W_, row0_, dir_, h_, lane_) do { \
        const float* lr_ = (W_).LA + (size_t)((row0_) + (lane_)) * 256 + (dir_) * 128 + (h_) * 32; const float* lt_ = (W_).LA + (size_t)((row0_) + ((dir_) == 0 ? 63 : 0)) * 256 + (dir_) * 128 + (h_) * 32; \
        _Pragma("unroll") for (int q_ = 0; q_ < 8; ++q_) { const f32x4 a_ = *(const f32x4*)(lr_ + 4 * q_), t_ = *(const f32x4*)(lt_ + 4 * q_); \
            bc[4 * q_] = a_[0]; bc[4 * q_ + 1] = a_[1]; bc[4 * q_ + 2] = a_[2]; bc[4 * q_ + 3] = a_[3]; tot[4 * q_] = t_[0]; tot[4 * q_ + 1] = t_[1]; tot[4 * q_ + 2] = t_[2]; tot[4 * q_ + 3] = t_[3]; } } while (0)

__device__ __forceinline__ void gla_state_unit(const WS& W, int b, bool isctx, int n, LAS unsigned char* lds) {
    int tid_ = threadIdx.x; asm volatile("" : "+v"(tid_)); const int tid = tid_, lane = tid & 63, wave = __builtin_amdgcn_readfirstlane(tid >> 6);
    const int dir = wave >> 2, h = wave & 3;
    const int row0 = (isctx ? ML + b * NCTX : b * SEQ) + n * 64;
    LAS unsigned char* Vb = lds;
    LAS unsigned char* KW = lds + 49152 + wave * 5120;
#pragma unroll
    for (int i = 0; i < 4; ++i) { const int idx = tid + 512 * i, t = idx >> 5, hh = (idx >> 3) & 3, ch = idx & 7;
        *(LAS u32x4*)(Vb + hh * 12288 + t * 192 + ch * 16) = *(const u32x4*)(W.Z + (size_t)(row0 + t) * ZLD + 2304 + hh * 64 + ch * 8); }
    float bc[32], tot[32];
    GLA_LOADB(bc, tot, W, row0, dir, h, lane);
    const int c = dir == 0 ? (isctx ? n : 4 + n) : (isctx ? 3 - n : 67 - n);
    const size_t cbase = (size_t)(((b * 2 + dir) * NCHAIN + c) * 4 + h);
    {
        const bf16_t* kp = W.Z + (size_t)(row0 + lane) * ZLD + 2176 + h * 32;
#pragma unroll
        for (int q = 0; q < 4; ++q) { const u32x4 kk = *(const u32x4*)(kp + 8 * q); u32x4 o;
#pragma unroll
            for (int e = 0; e < 4; ++e) { const int d = 8 * q + 2 * e; o[e] = pk2(bflo(kk[e]) * __expf(tot[d] - bc[d]), bfhi(kk[e]) * __expf(tot[d + 1] - bc[d + 1])); }
            *(LAS u32x4*)(KW + lane * 80 + q * 16) = o; }
        if (lane == 0) { float* dp = W.dec + cbase * 32;
#pragma unroll
            for (int q = 0; q < 8; ++q) { f32x4 o = {__expf(tot[4 * q]), __expf(tot[4 * q + 1]), __expf(tot[4 * q + 2]), __expf(tot[4 * q + 3])}; *(f32x4*)(dp + 4 * q) = o; } }
    }
    __syncthreads();
    {
        const int i16 = lane & 15, gi = (lane >> 4) & 1, hi = lane >> 5, l31 = lane & 31;
        const LAS unsigned char* kwb = KW + (i16 >> 2) * 80 + (16 * gi + 4 * (i16 & 3)) * 2 + (8 * hi) * 80;
        const LAS unsigned char* vb = Vb + h * 12288 + (i16 >> 2) * 192 + (16 * gi + 4 * (i16 & 3)) * 2 + (8 * hi) * 192;
        float* stp = W.ST + cbase * 2048;
#pragma unroll
        for (int vt = 0; vt < 2; ++vt) {
            f32x16 acc = {};
#pragma unroll
            for (int s = 0; s < 4; ++s) {
                const bf16x8 a = cat8(tr_read(kwb + (16 * s) * 80), tr_read(kwb + (16 * s + 4) * 80));
                const bf16x8 bb = cat8(tr_read(vb + (16 * s) * 192 + vt * 64), tr_read(vb + (16 * s + 4) * 192 + vt * 64));
                acc = MFMA32(a, bb, acc);
            }
#pragma unroll
            for (int r = 0; r < 16; ++r) { const int d = (r & 3) + 8 * (r >> 2) + 4 * hi; stp[d * 64 + 32 * vt + l31] = acc[r]; }
        }
    }
    __syncthreads();
}

__device__ __forceinline__ void gla_scan(const WS& W) {
    int tid_ = threadIdx.x; asm volatile("" : "+v"(tid_));
    for (int idx = blockIdx.x * 512 + tid_; idx < 131072; idx += gridDim.x * 512) {
        const int v = idx & 63, d = (idx >> 6) & 31, h = (idx >> 11) & 3, bd = idx >> 13;
        float* sp = W.ST + ((size_t)(bd * NCHAIN) * 4 + h) * 2048 + d * 64 + v;
        const float* dp = W.dec + ((size_t)(bd * NCHAIN) * 4 + h) * 32 + d;
        float S = 0.f;
#pragma unroll
        for (int c0 = 0; c0 < NCHAIN; c0 += 34) {
            float st[34], dc[34];
#pragma unroll
            for (int j = 0; j < 34; ++j) { st[j] = sp[(size_t)(c0 + j) * 8192]; dc[j] = dp[(size_t)(c0 + j) * 128]; }
#pragma unroll
            for (int j = 0; j < 34; ++j) { sp[(size_t)(c0 + j) * 8192] = S; S = dc[j] * S + st[j]; }
        }
    }
}

__device__ __forceinline__ void gla_out_unit(const Params& p, const WS& W, int layer, int b, bool isctx, int n, int hp, LAS unsigned char* lds) {
    int tid_ = threadIdx.x; asm volatile("" : "+v"(tid_)); const int tid = tid_, lane = tid & 63, wave = __builtin_amdgcn_readfirstlane(tid >> 6);
    const int dh = wave >> 1, dir = dh >> 1, hl = dh & 1, h = hp * 2 + hl, th = wave & 1;
    const int row0 = (isctx ? ML + b * NCTX : b * SEQ) + n * 64;
    LAS unsigned char* Vb = lds;
    LAS unsigned char* QK = lds + 24576;
    LAS unsigned char* SI = lds + 65536;
    LAS float* OB = (LAS float*)(lds + 90112);
#pragma unroll
    for (int i = 0; i < 2; ++i) { const int idx = tid + 512 * i, t = idx >> 4, hh = (idx >> 3) & 1, ch = idx & 7;
        *(LAS u32x4*)(Vb + hh * 12288 + t * 192 + ch * 16) = *(const u32x4*)(W.Z + (size_t)(row0 + t) * ZLD + 2304 + (hp * 2 + hh) * 64 + ch * 8); }
#pragma unroll
    for (int i = 0; i < 2; ++i) { const int idx = tid + 512 * i, q = idx >> 8, d = (idx >> 3) & 31, ch = idx & 7;
        const int qdir = q >> 1, qh = hp * 2 + (q & 1);
        const int c = qdir == 0 ? (isctx ? n : 4 + n) : (isctx ? 3 - n : 67 - n);
        const float* sp = W.ST + ((size_t)(((b * 2 + qdir) * NCHAIN + c) * 4 + qh)) * 2048 + d * 64 + ch * 8;
        const f32x4 s0 = *(const f32x4*)sp, s1 = *(const f32x4*)(sp + 4);
        u32x4 o; o.x = pk2(s0[0], s0[1]); o.y = pk2(s0[2], s0[3]); o.z = pk2(s1[0], s1[1]); o.w = pk2(s1[2], s1[3]);
        *(LAS u32x4*)(SI + q * 6144 + d * 192 + ch * 16) = o; }
    if (th == 0) {
        float bc[32], tot[32];
        GLA_LOADB(bc, tot, W, row0, dir, h, lane);
        const bf16_t* qp = W.Z + (size_t)(row0 + lane) * ZLD + 2048 + h * 32;
        LAS unsigned char* qi = QK + dh * 10240 + lane * 80; LAS unsigned char* ki = qi + 5120;
#pragma unroll
        for (int q = 0; q < 4; ++q) { const u32x4 qq = *(const u32x4*)(qp + 8 * q), kk = *(const u32x4*)(qp + 128 + 8 * q); u32x4 oq, ok;
#pragma unroll
            for (int e = 0; e < 4; ++e) { const int d = 8 * q + 2 * e; const float e0 = __expf(bc[d]), e1 = __expf(bc[d + 1]);
                oq[e] = pk2(bflo(qq[e]) * e0, bfhi(qq[e]) * e1); ok[e] = pk2(bflo(kk[e]) / e0, bfhi(kk[e]) / e1); }
            *(LAS u32x4*)(qi + q * 16) = oq; *(LAS u32x4*)(ki + q * 16) = ok; }
    }
    __syncthreads();
    const int i16 = lane & 15, gi = (lane >> 4) & 1, hi = lane >> 5, l31 = lane & 31;
    f32x16 o[2];
    {
        const LAS unsigned char* qib = QK + dh * 10240; const LAS unsigned char* kib = qib + 5120;
        bf16x8 qf[2];
#pragma unroll
        for (int s = 0; s < 2; ++s) qf[s] = *(const LAS bf16x8*)(qib + (32 * th + l31) * 80 + (2 * s + hi) * 16);
        f32x16 at[2];
#pragma unroll
        for (int st = 0; st < 2; ++st) { f32x16 a = {};
#pragma unroll
            for (int s = 0; s < 2; ++s) { const bf16x8 kf = *(const LAS bf16x8*)(kib + (32 * st + l31) * 80 + (2 * s + hi) * 16); a = MFMA32(kf, qf[s], a); }
            const int tq = 32 * th + l31;
#pragma unroll
            for (int r = 0; r < 16; ++r) { const int sk = 32 * st + (r & 3) + 8 * (r >> 2) + 4 * hi; const bool keep = dir == 0 ? (sk <= tq) : (sk >= tq); a[r] = keep ? a[r] : 0.f; }
            at[st] = a; }
        const LAS unsigned char* vb = Vb + hl * 12288 + (i16 >> 2) * 192 + (16 * gi + 4 * (i16 & 3)) * 2;
        const LAS unsigned char* sb = SI + dh * 6144 + (i16 >> 2) * 192 + (16 * gi + 4 * (i16 & 3)) * 2 + (8 * hi) * 192;
#pragma unroll
        for (int vt = 0; vt < 2; ++vt) {
            f32x16 acc = {};
#pragma unroll
            for (int st = 0; st < 2; ++st)
#pragma unroll
                for (int sk = 0; sk < 2; ++sk) { const int r0 = 32 * st + 16 * sk + 4 * hi;
                    const bf16x8 a = cat8(tr_read(vb + r0 * 192 + vt * 64), tr_read(vb + (r0 + 8) * 192 + vt * 64));
                    acc = MFMA32(a, pack_acc8(at[st], sk), acc); }
#pragma unroll
            for (int s = 0; s < 2; ++s) { const bf16x8 a = cat8(tr_read(sb + (16 * s) * 192 + vt * 64), tr_read(sb + (16 * s + 4) * 192 + vt * 64)); acc = MFMA32(a, qf[s], acc); }
            o[vt] = acc;
        }
    }
    if (dir == 1) {
#pragma unroll
        for (int vt = 0; vt < 2; ++vt)
#pragma unroll
            for (int r = 0; r < 16; ++r) { const int v = 32 * vt + (r & 3) + 8 * (r >> 2) + 4 * hi; OB[hl * 4096 + v * 64 + 32 * th + l31] = o[vt][r]; }
    }
    __syncthreads();
    if (dir == 0) {
        float ss = 0.f;
#pragma unroll
        for (int vt = 0; vt < 2; ++vt)
#pragma unroll
            for (int r = 0; r < 16; ++r) { const int v = 32 * vt + (r & 3) + 8 * (r >> 2) + 4 * hi; const float x = o[vt][r] + OB[hl * 4096 + v * 64 + 32 * th + l31]; o[vt][r] = x; ss += x * x; }
        ss += __shfl_xor(ss, 32);
        const float rinv = rsqrtf(ss * (1.f / 64.f) + EPS);
        const int row = row0 + 32 * th + l31;
#pragma unroll
        for (int vt = 0; vt < 2; ++vt)
#pragma unroll
            for (int r4 = 0; r4 < 4; ++r4) { const int v = 32 * vt + 8 * r4 + 4 * hi;
                const u32x2 gz = *(const u32x2*)(W.Z + (size_t)row * ZLD + 2560 + h * 64 + v);
                const f32x4 nw = *(const f32x4*)(p.gla_norm_w + layer * 256 + h * 64 + v);
                const float a0 = o[vt][4 * r4] * rinv * nw[0] * silu_f(bflo(gz.x)), a1 = o[vt][4 * r4 + 1] * rinv * nw[1] * silu_f(bfhi(gz.x));
                const float a2 = o[vt][4 * r4 + 2] * rinv * nw[2] * silu_f(bflo(gz.y)), a3 = o[vt][4 * r4 + 3] * rinv * nw[3] * silu_f(bfhi(gz.y));
                u32x2 w; w.x = pk2(a0, a1); w.y = pk2(a2, a3);
                *(u32x2*)(W.Y + (size_t)row * 1024 + 768 + h * 64 + v) = w; }
    }
    __syncthreads();
}

__device__ __forceinline__ void attn_unit(const Params& p, const WS& W, int layer, int b, int g, int qb, bool isctx, LAS unsigned char* lds) {
    int tid_ = threadIdx.x; asm volatile("" : "+v"(tid_)); const int tid = tid_, lane = tid & 63, wave = __builtin_amdgcn_readfirstlane(tid >> 6);
    const int l31 = lane & 31, hi = lane >> 5, i16 = lane & 15, gi = (lane >> 4) & 1;
    const int head = g * 4 + (wave >> 1);
    const int seqbase = isctx ? ML + b * NCTX : b * SEQ;
    const int q0 = qb * 128, tq0 = q0 + (wave & 1) * 64;
    constexpr int KB = 64 * 144, VB = 64 * 192, STG = KB + VB;
    bf16x8 qf[2][4];
#pragma unroll
    for (int ct = 0; ct < 2; ++ct)
#pragma unroll
        for (int ds = 0; ds < 4; ++ds) qf[ct][ds] = *(const bf16x8*)(W.Z + (size_t)(seqbase + tq0 + 32 * ct + l31) * ZLD + 768 + 256 * (head >> 2) + 128 * (ds >> 1) + 32 * (head & 3) + 16 * (ds & 1) + 8 * hi);
    const int jlo = isctx ? 0 : (qb == 0 ? 2 : 0), jhi = isctx ? -1 : (qb == 31 ? 3 : 5);
    const int NT = 4 + (jhi - jlo + 1);
    const int kvr = tid >> 3, ch = tid & 7;
    const int gcolK = 1280 + 128 * (ch >> 2) + 32 * g + 8 * (ch & 3);
    const int ctxbase = ML + b * NCTX;
    const float sink2 = p.attn_sink[layer * 8 + head] * LOG2E;
    float mrun[2] = {sink2, sink2}, lsum[2] = {hi == 0 ? 1.f : 0.f, hi == 0 ? 1.f : 0.f};
    f32x16 O[2][2];
#pragma unroll
    for (int dt = 0; dt < 2; ++dt)
#pragma unroll
        for (int ct = 0; ct < 2; ++ct) O[dt][ct] = (f32x16){};
    u32x4 kreg, vreg;
#define ATT_KROW(ti) ((ti) < 4 ? ctxbase + 64 * (ti) : b * SEQ + q0 - 128 + 64 * (jlo + (ti) - 4))
#define ATT_LOAD(ti) do { const bf16_t* src_ = W.Z + (size_t)(ATT_KROW(ti) + kvr) * ZLD + gcolK; kreg = *(const u32x4*)src_; vreg = *(const u32x4*)(src_ + 64); } while (0)
#define ATT_STORE(st) do { *(LAS u32x4*)(lds + (st) * STG + kvr * 144 + ch * 16) = kreg; *(LAS u32x4*)(lds + (st) * STG + KB + kvr * 192 + ch * 16) = vreg; } while (0)
    ATT_LOAD(0); ATT_STORE(0);
    __syncthreads();
    for (int ti = 0; ti < NT; ++ti) {
        const int st = ti & 1;
        if (ti + 1 < NT) ATT_LOAD(ti + 1);
        bool active = true, need_mask = false; int k0 = 0;
        if (ti >= 4) { k0 = q0 - 128 + 64 * (jlo + ti - 4); active = (k0 + 63 >= tq0 - 128) && (k0 <= tq0 + 191); need_mask = !((k0 >= tq0 - 65) && (k0 <= tq0 + 65)); }
        if (active) {
            const LAS unsigned char* Kb = lds + st * STG; const LAS unsigned char* Vbp = Kb + KB;
            f32x16 s[2][2];
#pragma unroll
            for (int rt = 0; rt < 2; ++rt) {
                s[rt][0] = (f32x16){}; s[rt][1] = (f32x16){};
#pragma unroll
                for (int ds = 0; ds < 4; ++ds) { const bf16x8 kf = *(const LAS bf16x8*)(Kb + (32 * rt + l31) * 144 + (2 * ds + hi) * 16);
                    s[rt][0] = MFMA32(kf, qf[0][ds], s[rt][0]); s[rt][1] = MFMA32(kf, qf[1][ds], s[rt][1]); }
            }
            if (need_mask) {
#pragma unroll
                for (int rt = 0; rt < 2; ++rt)
#pragma unroll
                    for (int ct = 0; ct < 2; ++ct)
#pragma unroll
                        for (int r = 0; r < 16; ++r) { const int kp = k0 + 32 * rt + (r & 3) + 8 * (r >> 2) + 4 * hi, qp = tq0 + 32 * ct + l31; const int dd = qp - kp;
                            if (dd > 128 || dd < -128) s[rt][ct][r] = -1e30f; }
            }
#pragma unroll
            for (int ct = 0; ct < 2; ++ct) {
                float mx = s[0][ct][0];
#pragma unroll
                for (int r = 1; r < 16; ++r) mx = fmaxf(mx, s[0][ct][r]);
#pragma unroll
                for (int r = 0; r < 16; ++r) mx = fmaxf(mx, s[1][ct][r]);
                mx = fmaxf(mx, __shfl_xor(mx, 32));
                const float mnew = fmaxf(mrun[ct], mx); const float alpha = __builtin_amdgcn_exp2f(mrun[ct] - mnew); mrun[ct] = mnew;
                float ls = 0.f;
#pragma unroll
                for (int rt = 0; rt < 2; ++rt)
#pragma unroll
                    for (int r = 0; r < 16; ++r) { const float pe = __builtin_amdgcn_exp2f(s[rt][ct][r] - mnew); s[rt][ct][r] = pe; ls += pe; }
                lsum[ct] = lsum[ct] * alpha + ls;
#pragma unroll
                for (int dt = 0; dt < 2; ++dt) O[dt][ct] = O[dt][ct] * alpha;
            }
            const LAS unsigned char* vb = Vbp + (i16 >> 2) * 192 + (16 * gi + 4 * (i16 & 3)) * 2;
#pragma unroll
            for (int rt = 0; rt < 2; ++rt)
#pragma unroll
                for (int sk = 0; sk < 2; ++sk) {
                    const bf16x8 p0 = pack_acc8(s[rt][0], sk), p1 = pack_acc8(s[rt][1], sk);
                    const int r0 = 32 * rt + 16 * sk + 4 * hi;
#pragma unroll
                    for (int dt = 0; dt < 2; ++dt) { const bf16x8 vf = cat8(tr_read(vb + r0 * 192 + dt * 64), tr_read(vb + (r0 + 8) * 192 + dt * 64));
                        O[dt][0] = MFMA32(vf, p0, O[dt][0]); O[dt][1] = MFMA32(vf, p1, O[dt][1]); }
                }
        }
        if (ti + 1 < NT) ATT_STORE(st ^ 1);
        __syncthreads();
    }
#undef ATT_KROW
#undef ATT_LOAD
#undef ATT_STORE
#pragma unroll
    for (int ct = 0; ct < 2; ++ct) {
        const float lt = lsum[ct] + __shfl_xor(lsum[ct], 32); const float inv = 1.f / lt;
        const int row = seqbase + tq0 + 32 * ct + l31;
#pragma unroll
        for (int dt = 0; dt < 2; ++dt)
#pragma unroll
            for (int r4 = 0; r4 < 4; ++r4) { const int d = 32 * dt + 8 * r4 + 4 * hi;
                const u32x2 gz = *(const u32x2*)(W.Z + (size_t)row * ZLD + 1536 + head * 64 + d);
                const float a0 = O[dt][ct][4 * r4] * inv * silu_f(bflo(gz.x)), a1 = O[dt][ct][4 * r4 + 1] * inv * silu_f(bfhi(gz.x));
                const float a2 = O[dt][ct][4 * r4 + 2] * inv * silu_f(bflo(gz.y)), a3 = O[dt][ct][4 * r4 + 3] * inv * silu_f(bfhi(gz.y));
                u32x2 w; w.x = pk2(a0, a1); w.y = pk2(a2, a3);
                *(u32x2*)(W.Y + (size_t)row * 1024 + 256 + head * 64 + d) = w; }
    }
}

__device__ __forceinline__ void phase_final(const Params& p, const WS& W) {
    int tid_ = threadIdx.x; asm volatile("" : "+v"(tid_)); const int tid = tid_, lane = tid & 63, wave = tid >> 6;
    const int gw = blockIdx.x * 8 + wave, NGW = gridDim.x * 8;
    f32x4 fw[4];
#pragma unroll
    for (int j = 0; j < 4; ++j) fw[j] = *(const f32x4*)(p.final_norm_w + j * 256 + lane * 4);
    for (int row = gw; row < ML; row += NGW) {
        const float rinv = rsqrtf(W.rss2[row] * (1.f / 1024.f) + EPS);
        float* xr = p.out + (size_t)row * 1024;
#pragma unroll
        for (int j = 0; j < 4; ++j) { const f32x4 v = *(const f32x4*)(xr + j * 256 + lane * 4); *(f32x4*)(xr + j * 256 + lane * 4) = v * rinv * fw[j]; }
    }
}

__device__ __forceinline__ int q_next(unsigned* ctr, volatile LAS unsigned* slot) {
    __syncthreads();
    if (threadIdx.x == 0) *slot = __hip_atomic_fetch_add(ctr, 1u, __ATOMIC_RELAXED, __HIP_MEMORY_SCOPE_AGENT);
    __syncthreads();
    return (int)*slot;
}
#define QCTR(k) ((unsigned*)(wsb + WS_CTL) + 4096 + 64 * (k))

__global__ void __launch_bounds__(512, 2) fwd_kernel(Params p) {
    extern __shared__ __attribute__((aligned(16))) unsigned char lds_raw[];
    LAS unsigned char* lds = (LAS unsigned char*)lds_raw;
    const int G = gridDim.x;
    volatile LAS unsigned* bst = (volatile LAS unsigned*)(lds + 131072 + 512);
    if (threadIdx.x < 2) bst[threadIdx.x] = 0u;
    __syncthreads();
    XcdBarrier xbar = xcd_barrier_post((unsigned*)(p.ws + WS_CTL), bst);
    volatile LAS unsigned* qslot = (volatile LAS unsigned*)(lds + 131072 + 640);
    for (int ph = p.ph_lo; ph < p.ph_hi; ++ph) {
        if (ph > p.ph_lo) {
#if USE_CG_SYNC
            cg::this_grid().sync();
#else
            xcd_barrier(xbar);
#endif
        }
        unsigned char* wsb = p.ws; asm volatile("" : "+s"(wsb));
        int bx = blockIdx.x; asm volatile("" : "+s"(bx));
        const WS W = make_ws(wsb);
        if (RUNSUB(10) && ph == 0) { for (int rep = 0; rep < NREP(10); ++rep) { phase_prep0(p, W, lds); __syncthreads(); } }
        else if (RUNSUB(11) && ph == 1) { for (int rep = 0; rep < NREP(11); ++rep) phase_prep1(p, W); }
        else if (ph >= 2 && ph < 12) {
            const int layer = (ph - 2) / 5, sub = (ph - 2) % 5;
            if (RUNSUB(0) && sub == 0) {
                pg8::Gemm gm{W.A, W.WinT + (size_t)layer * NPAD * 1024, MT, NPAD, 1024}; pg8::StaticOrder S; S.init(MT, NPAD, G, bx);
                pg8::EpiIn E{W.Z, W.LA, layer == 0 ? W.rss0 : W.rss1, W.biasz + layer * 9 * NPAD, W.rope};
#if DUP_SUB == 21
                { pg8::EpiInT<true> E2{W.Z, W.LA, layer == 0 ? W.rss0 : W.rss1, W.biasz + layer * 9 * NPAD, W.rope}; pg8::gemm_phase<pg8::EpiInT<true>, pg8::StaticOrder, true, true>(lds, gm, S, E2); }
#endif
                for (int rep = 0; rep < NREP(0); ++rep) pg8::gemm_phase<pg8::EpiIn, pg8::StaticOrder, true, true>(lds, gm, S, E);
            } else if (sub == 1) {
                const int nconv = layer == 0 ? 544 : 512;
                for (int u; (u = q_next(QCTR(layer * 4 + 0), qslot)) < nconv;) { if (u < 512) conv_unit(p, W, layer, u >> 6, u & 63, lds); else conv_unit(p, W, layer, 8 + ((u - 512) >> 2), (u - 512) & 3, lds); }
                for (int u; (u = q_next(QCTR(layer * 4 + 1), qslot)) < 544;) { if (u < 512) gla_state_unit(W, u >> 6, false, u & 63, lds); else gla_state_unit(W, (u - 512) >> 2, true, (u - 512) & 3, lds); }
            } else if (sub == 2) {
                gla_scan(W);
                const int natt = layer == 0 ? 544 : 512;
                for (int u; (u = q_next(QCTR(layer * 4 + 2), qslot)) < natt;) { if (u < 512) attn_unit(p, W, layer, u >> 6, (u >> 5) & 1, u & 31, false, lds); else { const int v = u - 512; attn_unit(p, W, layer, v >> 2, (v >> 1) & 1, v & 1, true, lds); } }
            } else if (sub == 3) {
                const int nu = layer == 0 ? 1088 : 1024;
                for (int u; (u = q_next(QCTR(layer * 4 + 3), qslot)) < nu;) { if (u < 1024) gla_out_unit(p, W, layer, u >> 7, false, (u >> 1) & 63, u & 1, lds); else { const int v = u - 1024; gla_out_unit(p, W, layer, v >> 3, true, (v >> 1) & 3, v & 1, lds); } }
            } else {
                if (layer == 0) {
                    pg8::Gemm gm{W.Y, W.WoutT, MT, 1024, 1024}; pg8::StaticOrder S; S.init(MT, 1024, G, bx);
                    pg8::EpiOut E{p.x, p.ctx, p.out, W.modv, W.modv + 9 * 3072, W.A, W.rss1};
                    pg8::gemm_phase<pg8::EpiOut, pg8::StaticOrder, true, true>(lds, gm, S, E);
                } else {
                    pg8::Gemm gm{W.Y, W.WoutT + (size_t)1024 * 1024, ML, 1024, 1024}; pg8::StaticOrder S; S.init(ML, 1024, G, bx);
                    pg8::EpiOutFin E{p.out, p.out, W.modv + 9 * 3072, p.final_norm_w, W.rss2, (unsigned*)(wsb + WS_CTL) + 8192, (LAS unsigned*)(lds + 131072 + 576)};
                    pg8::gemm_phase<pg8::EpiOutFin, pg8::StaticOrder, true, true>(lds, gm, S, E);
                }
            }
        }
    }
}

extern "C" void kernel_launch(void* const* d_in, const int* in_sizes, int n_in, void* d_out, int out_size, void* d_ws, size_t ws_size, hipStream_t stream) {
    static int grid = 0;
    if (grid == 0) {
        if (n_in != 17 || out_size != ML * D || ws_size < WS_END) { fprintf(stderr, "kernel_launch: unexpected shapes (n_in %d, out %d, ws %zu)\n", n_in, out_size, ws_size); grid = -1; return; }
        int dev = 0, cus = 0, per_cu = 0;
        hipGetDevice(&dev); hipDeviceGetAttribute(&cus, hipDeviceAttributeMultiprocessorCount, dev);
        hipFuncSetAttribute((const void*)fwd_kernel, hipFuncAttributeMaxDynamicSharedMemorySize, LDS_BYTES);
        hipOccupancyMaxActiveBlocksPerMultiprocessor(&per_cu, (const void*)fwd_kernel, 512, LDS_BYTES);
        if (per_cu < 1) { fprintf(stderr, "kernel_launch: occupancy query says %d blocks/CU\n", per_cu); per_cu = 1; }
        (void)hipGetLastError();
        grid = cus;
    }
    if (grid < 0) return;
    Params p{};
    p.x = (const float*)d_in[0]; p.c = (const float*)d_in[1]; p.ctx = (const float*)d_in[2]; p.c_ctx = (const float*)d_in[3]; p.w_mod = (const float*)d_in[4]; p.b_mod = (const float*)d_in[5];
    p.w_in = (const float*)d_in[6]; p.conv_w = (const float*)d_in[7]; p.conv_b = (const float*)d_in[8]; p.conv_ln_w = (const float*)d_in[9]; p.conv_ln_b = (const float*)d_in[10];
    p.attn_sink = (const float*)d_in[11]; p.gla_w_up = (const float*)d_in[12]; p.gla_b_up = (const float*)d_in[13]; p.gla_norm_w = (const float*)d_in[14]; p.w_out = (const float*)d_in[15];
    p.final_norm_w = (const float*)d_in[16]; p.out = (float*)d_out; p.ws = (unsigned char*)d_ws;
    if (hipMemsetAsync((char*)d_ws + WS_CTL, 0, 65536, stream) != hipSuccess) { fprintf(stderr, "kernel_launch: memset failed\n"); return; }
#if MK_MULTI
    for (int ph = 0; ph < NPHASE; ++ph) { p.ph_lo = ph; p.ph_hi = ph + 1; hipLaunchKernelGGL(fwd_kernel, dim3(grid), dim3(512), LDS_BYTES, stream, p); }
#else
    p.ph_lo = 0; p.ph_hi = NPHASE;
    void* args[] = {&p};
    hipError_t e = hipLaunchCooperativeKernel((void*)fwd_kernel, dim3(grid), dim3(512), args, LDS_BYTES, stream);
    if (e != hipSuccess) fprintf(stderr, "cooperative launch failed: %s (grid %d)\n", hipGetErrorString(e), grid);
#endif
}
```

```cpp
#include <hip/hip_runtime.h>
#include <hip/hip_cooperative_groups.h>
#include <cstdio>
#include <cstdint>
namespace cg = cooperative_groups;
namespace pg8 {
#define PG8_LAS __attribute__((address_space(3)))
typedef unsigned short bf16_t;
typedef short bf16x8 __attribute__((ext_vector_type(8)));
typedef float f32x4 __attribute__((ext_vector_type(4)));
typedef unsigned u32x4 __attribute__((ext_vector_type(4)));
constexpr int BM = 256, BK = 64, HALF = 128, HTB = HALF * BK * 2  , STAGE_BYTES = 8 * HTB, NXCD = 8, WGM = 2;

__host__ __device__ __forceinline__ int lds_byte(int r, int c) { const int st = (r >> 4) * 2 + (c >> 5), rr = r & 15, cc = c & 31, ob = rr * 64 + cc * 2; return st * 1024 + (ob ^ (((ob >> 9) & 1) << 5)); }
__host__ __device__ __forceinline__ void stage_rc(int b, int& R, int& C) { const int st = b / 1024, sb = b % 1024, swz = sb ^ (((sb >> 9) & 1) << 5); R = (st >> 1) * 16 + swz / 64; C = (st & 1) * 32 + (swz % 64) / 2; }
__host__ __device__ __forceinline__ int perm32(int rho) { const int n = rho >> 4, i = rho & 15; return 8 * (i >> 2) + 4 * n + (i & 3); }

struct Unit { int pm, pn, half; };
struct Gemm { const bf16_t* A; const bf16_t* Bt; int M, N, K; };

struct StaticOrder {
    int nM, nN, nwg, G, c;
    __host__ __device__ void init(int M, int N, int G_, int c_) { nM = M / BM; nN = N / BM; nwg = nM * nN; G = G_; c = c_; }
    __host__ __device__ void map(long L, Unit& u) const {
        int wgid = (int)L; { const int q = nwg / NXCD, r = nwg % NXCD, xcd = wgid % NXCD, off = wgid / NXCD; wgid = (xcd < r ? xcd * (q + 1) : r * (q + 1) + (xcd - r) * q) + off; }
        const int nig = WGM * nN, gid = wgid / nig, fm = gid * WGM, gsz = (nM - fm) < WGM ? (nM - fm) : WGM;
        u.pm = fm + ((wgid % nig) % gsz); u.pn = (wgid % nig) / gsz; u.half = -1;
    }
    __host__ __device__ bool next(int i, Unit& u) const { const long L = (long)i * G + c; if (L >= nwg) return false; map(L, u); return true; }
    __device__ __forceinline__ void a_ready(const Unit&) const {}
    __device__ __forceinline__ void done(const Unit&) const {}
};
__device__ __forceinline__ unsigned cvt_pk_bf16(float lo, float hi) { unsigned r; asm volatile("v_cvt_pk_bf16_f32 %0, %1, %2" : "=v"(r) : "v"(lo), "v"(hi)); return r; }
template <class Epi, class Sched, bool ALIGN_EPI = false, bool SP2 = false>
__device__ __forceinline__ void gemm_phase(PG8_LAS unsigned char* lds, const Gemm g, const Sched& S, const Epi& E) {
    int tid_ = threadIdx.x; asm volatile("" : "+v"(tid_)); const int tid = tid_, wid = __builtin_amdgcn_readfirstlane(tid >> 6), lane = tid & 63, wr = wid >> 2, wc = wid & 3, fr = lane & 15, fq = lane >> 4;
    const int K = g.K, nt = K / BK;
    unsigned voffA[2], voffB[2];
#pragma unroll
    for (int i = 0; i < 2; ++i) { int R, C; stage_rc(tid * 16 + i * 8192, R, C); const int Rb = Epi::PERM ? ((R & ~31) + perm32(R & 31)) : R;
        voffA[i] = (unsigned)(R * K + C) * 2u; voffB[i] = (unsigned)(Rb * K + C) * 2u; }
    const size_t kstep = (size_t)(BK * 2);
    const size_t hstep = (size_t)HALF * K * 2;
    const size_t tstep = 2 * hstep;
    const unsigned ldsw = (unsigned)wid * 1024u;
    const int aoff = lds_byte(wr * 64 + fr, fq * 8), boff = lds_byte(wc * 32 + fr, fq * 8);
#define PG8_SA(b, h) (((b) * 2 + (h)) * HTB)
#define PG8_SB(b, h) ((4 + (b) * 2 + (h)) * HTB)
#define PG8_STAGE(bufoff, gbase, voff) do { _Pragma("unroll") for (int _i = 0; _i < 2; ++_i) \
        __builtin_amdgcn_global_load_lds((const unsigned*)((const char*)(gbase) + (voff)[_i]), (PG8_LAS unsigned*)(lds + (bufoff) + ldsw + _i * 8192), 16, 0, 0); } while (0)
#define PG8_LDA(dst, b, h) do { _Pragma("unroll") for (int m = 0; m < 4; ++m) _Pragma("unroll") for (int k = 0; k < 2; ++k) dst[m][k] = *(const PG8_LAS bf16x8*)(lds + PG8_SA(b, h) + aoff + m * 2048 + k * 1024); } while (0)
#define PG8_LDB(dst, b, h) do { _Pragma("unroll") for (int n = 0; n < 2; ++n) _Pragma("unroll") for (int k = 0; k < 2; ++k) dst[n][k] = *(const PG8_LAS bf16x8*)(lds + PG8_SB(b, h) + boff + n * 2048 + k * 1024); } while (0)
#define PG8_MMA(ai, bj, At, Bt) do { if (cur.half >= 0 && cur.half != (ai)) break; __builtin_amdgcn_s_setprio(1); _Pragma("unroll") for (int m = 0; m < 4; ++m) _Pragma("unroll") for (int n = 0; n < 2; ++n) _Pragma("unroll") for (int k = 0; k < 2; ++k) \
        acc[ai][bj][m][n] = __builtin_amdgcn_mfma_f32_16x16x32_bf16(Bt[n][k], At[m][k], acc[ai][bj][m][n], 0, 0, 0); __builtin_amdgcn_s_setprio(0); } while (0)
#define PG8_WAIT_V(n) asm volatile("s_waitcnt vmcnt(" #n ")" ::: "memory")
#define PG8_WAIT_L(n) asm volatile("s_waitcnt lgkmcnt(" #n ")" ::: "memory")
#define PG8_BAR __builtin_amdgcn_s_barrier()
#define PG8_SCHED __builtin_amdgcn_sched_barrier(0)
    Unit cur, nxt; int ui = 0;
    if (!S.next(0, cur)) return;
    f32x4 acc[2][2][4][2];
#pragma unroll
    for (int a = 0; a < 2; ++a)
#pragma unroll
        for (int b = 0; b < 2; ++b)
#pragma unroll
            for (int m = 0; m < 4; ++m)
#pragma unroll
                for (int n = 0; n < 2; ++n) acc[a][b][m][n] = (f32x4){0.f, 0.f, 0.f, 0.f};
    bf16x8 At[4][2], B0[2][2], B1[2][2];
    const char* cA = (const char*)g.A + (size_t)cur.pm * tstep; const char* cB = (const char*)g.Bt + (size_t)cur.pn * tstep;
    S.a_ready(cur);
    if constexpr (SP2) {
        PG8_STAGE(PG8_SB(0, 0), cB, voffB); PG8_STAGE(PG8_SB(0, 1), cB + hstep, voffB); PG8_STAGE(PG8_SA(0, 0), cA, voffA); PG8_STAGE(PG8_SA(0, 1), cA + hstep, voffA);
        if (wr == 1) PG8_BAR;
        PG8_WAIT_V(2); PG8_BAR;
        PG8_STAGE(PG8_SB(1, 0), cB + kstep, voffB); PG8_STAGE(PG8_SA(1, 0), cA + kstep, voffA); PG8_STAGE(PG8_SB(1, 1), cB + hstep + kstep, voffB);
        PG8_WAIT_V(6); PG8_BAR;
    } else {
        PG8_STAGE(PG8_SB(0, 0), cB, voffB); PG8_STAGE(PG8_SA(0, 0), cA, voffA); PG8_STAGE(PG8_SB(0, 1), cB + hstep, voffB); PG8_STAGE(PG8_SA(0, 1), cA + hstep, voffA);
        if (wr == 1) PG8_BAR;
        PG8_WAIT_V(4); PG8_BAR;
        PG8_STAGE(PG8_SB(1, 0), cB + kstep, voffB); PG8_STAGE(PG8_SA(1, 0), cA + kstep, voffA); PG8_STAGE(PG8_SB(1, 1), cB + hstep + kstep, voffB);
        PG8_WAIT_V(6); PG8_BAR;
    }
    for (;;) {
        const bool has_next = S.next(ui + 1, nxt);
        const char* nA = has_next ? (const char*)g.A + (size_t)nxt.pm * tstep : cA; const char* nB = has_next ? (const char*)g.Bt + (size_t)nxt.pn * tstep : cB;
        for (int t = 0; t < nt; t += 2) {
            const bool last = (t == nt - 2);
            const char* a1 = cA + (size_t)(t + 1) * kstep;
            const char* a2 = last ? nA : cA + (size_t)(t + 2) * kstep; const char* b2 = last ? nB : cB + (size_t)(t + 2) * kstep;
            const char* a3 = a2 + kstep; const char* b3 = b2 + kstep;
            if (last && has_next) S.a_ready(nxt);
            if constexpr (SP2) {
            PG8_LDB(B0, 0, 0); PG8_LDB(B1, 0, 1); PG8_SCHED; PG8_LDA(At, 0, 0); PG8_STAGE(PG8_SA(1, 1), a1 + hstep, voffA);
            PG8_WAIT_V(8); PG8_WAIT_L(0); PG8_BAR; PG8_MMA(0, 0, At, B0); PG8_MMA(0, 1, At, B1); PG8_BAR; PG8_SCHED;
            PG8_LDA(At, 0, 1); PG8_STAGE(PG8_SB(0, 0), b2, voffB); PG8_STAGE(PG8_SB(0, 1), b2 + hstep, voffB); PG8_STAGE(PG8_SA(0, 0), a2, voffA);
            PG8_WAIT_V(8); PG8_WAIT_L(0); PG8_BAR; PG8_MMA(1, 0, At, B0); PG8_MMA(1, 1, At, B1); PG8_BAR; PG8_SCHED;
            PG8_LDB(B0, 1, 0); PG8_LDB(B1, 1, 1); PG8_SCHED; PG8_LDA(At, 1, 0); PG8_STAGE(PG8_SA(0, 1), a2 + hstep, voffA);
            PG8_WAIT_V(8); PG8_WAIT_L(0); PG8_BAR; PG8_MMA(0, 0, At, B0); PG8_MMA(0, 1, At, B1); PG8_BAR; PG8_SCHED;
            PG8_LDA(At, 1, 1); PG8_STAGE(PG8_SB(1, 0), b3, voffB); PG8_STAGE(PG8_SB(1, 1), b3 + hstep, voffB); PG8_STAGE(PG8_SA(1, 0), a3, voffA);
            PG8_WAIT_V(8); PG8_WAIT_L(0); PG8_BAR; PG8_MMA(1, 0, At, B0); PG8_MMA(1, 1, At, B1); PG8_BAR; PG8_SCHED;
            } else {
            PG8_LDB(B0, 0, 0); PG8_SCHED; PG8_LDA(At, 0, 0); PG8_STAGE(PG8_SA(1, 1), a1 + hstep, voffA);
            PG8_WAIT_L(8); PG8_BAR; PG8_WAIT_L(0); PG8_MMA(0, 0, At, B0); PG8_BAR; PG8_SCHED;
            PG8_LDB(B1, 0, 1); PG8_STAGE(PG8_SB(0, 0), b2, voffB);
            PG8_BAR; PG8_WAIT_L(0); PG8_MMA(0, 1, At, B1); PG8_BAR;
            PG8_LDA(At, 0, 1); PG8_STAGE(PG8_SA(0, 0), a2, voffA);
            PG8_BAR; PG8_WAIT_L(0); PG8_MMA(1, 0, At, B0); PG8_BAR; PG8_SCHED;
            PG8_STAGE(PG8_SB(0, 1), b2 + hstep, voffB);
            PG8_WAIT_V(6); PG8_BAR; PG8_MMA(1, 1, At, B1); PG8_BAR;
            PG8_LDB(B0, 1, 0); PG8_SCHED; PG8_LDA(At, 1, 0); PG8_STAGE(PG8_SA(0, 1), a2 + hstep, voffA);
            PG8_WAIT_L(8); PG8_BAR; PG8_WAIT_L(0); PG8_MMA(0, 0, At, B0); PG8_BAR; PG8_SCHED;
            PG8_LDB(B1, 1, 1); PG8_STAGE(PG8_SB(1, 0), b3, voffB);
            PG8_BAR; PG8_WAIT_L(0); PG8_MMA(0, 1, At, B1); PG8_BAR;
            PG8_LDA(At, 1, 1); PG8_STAGE(PG8_SA(1, 0), a3, voffA);
            PG8_BAR; PG8_WAIT_L(0); PG8_MMA(1, 0, At, B0); PG8_BAR; PG8_SCHED;
            PG8_STAGE(PG8_SB(1, 1), b3 + hstep, voffB);
            PG8_WAIT_V(6); PG8_BAR; PG8_MMA(1, 1, At, B1); PG8_BAR;
            }
        }
        if constexpr (ALIGN_EPI) { if (wr == 0) PG8_BAR; }
#if PROBE_PH == 50
        const unsigned long long te0_ = __builtin_amdgcn_s_memrealtime();
#endif
        if constexpr (!Epi::AFTER_DRAIN) { E(acc, cur, wr, wc, fr, fq); S.done(cur); }
#if PROBE_PH == 50
        { volatile PG8_LAS unsigned long long* tp_ = (volatile PG8_LAS unsigned long long*)(lds + 155648 + 768); if (threadIdx.x == 0 && tp_[3] == PROBE_TGT) tp_[2] += __builtin_amdgcn_s_memrealtime() - te0_; }
#endif
        if (!has_next) break;
#pragma unroll
        for (int a = 0; a < 2; ++a)
#pragma unroll
            for (int b = 0; b < 2; ++b)
#pragma unroll
                for (int m = 0; m < 4; ++m)
#pragma unroll
                    for (int n = 0; n < 2; ++n) acc[a][b][m][n] = (f32x4){0.f, 0.f, 0.f, 0.f};
        cur = nxt; cA = nA; cB = nB; ++ui;
        if constexpr (ALIGN_EPI) { if (wr == 1) PG8_BAR; }
    }
    PG8_WAIT_V(0);
    if constexpr (!ALIGN_EPI) { if (wr == 0) PG8_BAR; }
    PG8_BAR;
    if constexpr (Epi::AFTER_DRAIN) { E.fused(acc, cur, wr, wc, fr, fq, lds, wid, lane); S.done(cur); }
#undef PG8_SA
#undef PG8_SB
#undef PG8_STAGE
#undef PG8_LDA
#undef PG8_LDB
#undef PG8_MMA
#undef PG8_WAIT_V
#undef PG8_WAIT_L
#undef PG8_BAR
#undef PG8_SCHED
}
}

#ifndef DIAG_SUB
#define DIAG_SUB -1
#endif
#define RUNSUB(k) (DIAG_SUB < 0 || DIAG_SUB == (k))
#ifndef DUP_SUB
#define DUP_SUB -1
#endif
#define NREP(k) ((DUP_SUB == (k)) ? 2 : 1)
#ifndef MERGE12
#define MERGE12 1
#endif
#ifndef PROBE_PH
#define PROBE_PH -1
#endif
#ifndef SKEW_TICKS
#define SKEW_TICKS 1800ull
#endif
#ifndef USE_CG_SYNC
#define USE_CG_SYNC 0
#endif
#ifndef MK_MULTI
#define MK_MULTI 0
#endif
constexpr int D = 1024, NB = 8, SEQ = 4096, NCTX = 256;
constexpr int ML = NB * SEQ;
constexpr int MC = NB * NCTX;
constexpr int MT = ML + MC;
constexpr int NPAD = 3072, ZLD = 2816;
constexpr float EPS = 1e-6f;
constexpr float LOG2E = 1.4426950408889634f;
constexpr float QSCALE = 0.125f * LOG2E;
constexpr float GQSCALE = 0.17677669529663687f;
constexpr int NCHAIN = 68;
constexpr int NPHASE = 12;
constexpr int LDS_BYTES = 159744;
constexpr int CTLW_OFF = 155648;
constexpr int WREG = 19456;

constexpr size_t MiB = 1u << 20;
constexpr size_t WS_CTL = 0, WS_WINT = 2 * MiB, WS_WOUTT = 14 * MiB, WS_MODV = 18 * MiB, WS_BIASZ = 18 * MiB + 256 * 1024, WS_ROPE = 18 * MiB + 512 * 1024;
constexpr size_t WS_PRM = 18 * MiB + 768 * 1024;
constexpr int PRM_CONVW = 0, PRM_CONVB = 15872, PRM_LNW = 16384, PRM_LNB = 16896, PRM_SINK = 17408, PRM_GNW = 17424, PRM_FNW = 17936, PRM_N = 18960;
constexpr size_t WS_RSS0 = 19 * MiB, WS_RSS1 = 19 * MiB + 256 * 1024, WS_RSS2 = 19 * MiB + 512 * 1024, WS_DEC = 20 * MiB;
constexpr size_t WS_A = 24 * MiB, WS_Y = 92 * MiB, WS_LA = 160 * MiB, WS_ST = 194 * MiB, WS_Z = 228 * MiB, WS_X1H = 416 * MiB, WS_END = 480 * MiB;

#define LAS __attribute__((address_space(3)))
typedef unsigned short bf16_t;
typedef float f32x4 __attribute__((ext_vector_type(4)));
typedef float f32x2 __attribute__((ext_vector_type(2)));
typedef float f32x16 __attribute__((ext_vector_type(16)));
typedef short bf16x8 __attribute__((ext_vector_type(8)));
typedef short s16x4 __attribute__((ext_vector_type(4)));
typedef unsigned u32x4 __attribute__((ext_vector_type(4)));
typedef unsigned u32x2 __attribute__((ext_vector_type(2)));
typedef _Float16 f16x2 __attribute__((ext_vector_type(2)));

struct Params {
    const float *x, *c, *ctx, *c_ctx, *w_mod, *b_mod, *w_in, *conv_w, *conv_b, *conv_ln_w, *conv_ln_b, *attn_sink, *gla_w_up, *gla_b_up, *gla_norm_w, *w_out, *final_norm_w;
    float* out; unsigned char* ws;
    int ph_lo, ph_hi;
};
struct WS {
    bf16_t *WinT, *WoutT, *A, *Y, *Z;
    float *modv, *biasz, *rope, *rss0, *rss1, *rss2, *dec, *LA, *ST, *prm;
};
__device__ __forceinline__ WS make_ws(unsigned char* ws) {
    WS W; W.WinT = (bf16_t*)(ws + WS_WINT); W.WoutT = (bf16_t*)(ws + WS_WOUTT); W.A = (bf16_t*)(ws + WS_A); W.Y = (bf16_t*)(ws + WS_Y); W.Z = (bf16_t*)(ws + WS_Z);
    W.modv = (float*)(ws + WS_MODV); W.biasz = (float*)(ws + WS_BIASZ); W.rope = (float*)(ws + WS_ROPE); W.rss0 = (float*)(ws + WS_RSS0); W.rss1 = (float*)(ws + WS_RSS1);
    W.rss2 = (float*)(ws + WS_RSS2); W.dec = (float*)(ws + WS_DEC); W.LA = (float*)(ws + WS_LA); W.ST = (float*)(ws + WS_ST); W.prm = (float*)(ws + WS_PRM); return W;
}

__device__ __forceinline__ unsigned pk2(float lo, float hi) { typedef __bf16 b2 __attribute__((ext_vector_type(2))); f32x2 v = {lo, hi}; b2 b = __builtin_convertvector(v, b2); return __builtin_bit_cast(unsigned, b); }
__device__ __forceinline__ unsigned pkh2(float lo, float hi) { f32x2 v = {lo, hi}; f16x2 h = __builtin_convertvector(v, f16x2); return __builtin_bit_cast(unsigned, h); }
__device__ __forceinline__ f32x2 unpkh2(unsigned w) { return __builtin_convertvector(__builtin_bit_cast(f16x2, w), f32x2); }
__device__ __forceinline__ float bflo(unsigned w) { return __uint_as_float(w << 16); }
__device__ __forceinline__ float bfhi(unsigned w) { return __uint_as_float(w & 0xffff0000u); }
__device__ __forceinline__ float silu_f(float v) { return v * __builtin_amdgcn_rcpf(1.f + __expf(-v)); }
__device__ __forceinline__ float sigmoid_f(float v) { return __builtin_amdgcn_rcpf(1.f + __expf(-v)); }
__device__ __forceinline__ float wave_sum(float v) {
#pragma unroll
    for (int o = 1; o < 64; o <<= 1) v += __shfl_xor(v, o);
    return v;
}
typedef short v4i16_t __attribute__((ext_vector_type(4)));
__device__ __forceinline__ s16x4 tr_read(const LAS unsigned char* p) { return __builtin_bit_cast(s16x4, __builtin_amdgcn_ds_read_tr16_b64_v4i16((LAS v4i16_t*)p)); }
__device__ __forceinline__ bf16x8 cat8(s16x4 a, s16x4 b) { return (bf16x8){a[0], a[1], a[2], a[3], b[0], b[1], b[2], b[3]}; }
#define MFMA32(a, b, c) __builtin_amdgcn_mfma_f32_32x32x16_bf16((a), (b), (c), 0, 0, 0)
__device__ __forceinline__ bf16x8 pack_acc8(const f32x16& v, int s) {
    u32x4 w; w.x = pk2(v[8 * s + 0], v[8 * s + 1]); w.y = pk2(v[8 * s + 2], v[8 * s + 3]); w.z = pk2(v[8 * s + 4], v[8 * s + 5]); w.w = pk2(v[8 * s + 6], v[8 * s + 7]);
    return __builtin_bit_cast(bf16x8, w);
}

#define XB_TMO      128
#define XB_XCNT(j)  (256  + 64 * (j))
#define XB_XSUB(j)  (1280 + 64 * (j))
#define XB_XGEN(j)  (2304 + 64 * (j))
#define XB_TOP      3328
#define XB_TOPGEN   3392
#define XCD_BAR_WORDS 3456
#define XB_SPIN_CAP (1u << 18)

__device__ __forceinline__ unsigned xb_ld(unsigned* p)              { return __hip_atomic_load(p, __ATOMIC_RELAXED, __HIP_MEMORY_SCOPE_AGENT); }
__device__ __forceinline__ unsigned xb_add(unsigned* p, unsigned v) { return __hip_atomic_fetch_add(p, v, __ATOMIC_RELAXED, __HIP_MEMORY_SCOPE_AGENT); }
__device__ __forceinline__ unsigned xb_xcc_id() { return (unsigned)__builtin_amdgcn_s_getreg((3 << 11) | 20) & 0xFu; }
#define XB_SPIN(cond, bar) do { unsigned _sp = 0; while (cond) { __builtin_amdgcn_s_sleep(1); \
    if ((++_sp & 255u) == 0u) { if (xb_ld(&(bar)[XB_TMO])) break; if (_sp > XB_SPIN_CAP) { atomicAdd(&(bar)[XB_TMO], 1u); break; } } } } while (0)

struct XcdBarrier {
    unsigned* bar; unsigned x;
    volatile LAS unsigned* st;
};

__device__ __forceinline__ XcdBarrier xcd_barrier_post(unsigned* bar, volatile LAS unsigned* st) {
    XcdBarrier b; b.bar = bar; b.x = xb_xcc_id(); b.st = st;
    if (threadIdx.x == 0) (void)xb_add(&bar[XB_XCNT(b.x)], 1u);
    return b;
}
__device__ __forceinline__ void xcd_barrier_complete(unsigned* bar, unsigned x, unsigned& nloc, unsigned& nx) {
    const unsigned G = gridDim.x * gridDim.y * gridDim.z;
    unsigned sum, cnt, mine, sp = 0u;
    for (;;) {
        sum = 0u; cnt = 0u; mine = 0u;
#pragma unroll
        for (unsigned j = 0; j < 16; ++j) { const unsigned c = xb_ld(&bar[XB_XCNT(j)]); sum += c; cnt += (c > 0u) ? 1u : 0u; mine = (j == x) ? c : mine; }
        if (sum == G) break;
        __builtin_amdgcn_s_sleep(1);
        if ((++sp & 255u) == 0u) { if (xb_ld(&bar[XB_TMO])) break; if (sp > XB_SPIN_CAP) { atomicAdd(&bar[XB_TMO], 1u); break; } }
    }
    nloc = mine > 0u ? mine : 1u; nx = cnt > 0u ? cnt : 1u;
}

__device__ __forceinline__ void xcd_barrier(const XcdBarrier& b) {
    asm volatile("s_waitcnt vmcnt(0)" ::: "memory");
    __syncthreads();
    if (threadIdx.x == 0) {
        unsigned* bar = b.bar;
        __builtin_amdgcn_s_waitcnt(0);
        unsigned nloc = b.st[0], nx = b.st[1];
        if (nloc == 0u) { xcd_barrier_complete(bar, b.x, nloc, nx); b.st[0] = nloc; b.st[1] = nx; }
        const unsigned old = xb_add(&bar[XB_XSUB(b.x)], 1u);
        const unsigned gen = old / nloc;
        if (old + 1u == (gen + 1u) * nloc) {
            __builtin_amdgcn_fence(__ATOMIC_RELEASE, "agent");
            asm volatile("s_waitcnt vmcnt(0)" ::: "memory");
            const unsigned og = xb_add(&bar[XB_TOP], 1u);
            const unsigned tg = og / nx;
            if (og + 1u == (tg + 1u) * nx) xb_add(&bar[XB_TOPGEN], 1u);
            else XB_SPIN(xb_ld(&bar[XB_TOPGEN]) == tg, bar);
            __builtin_amdgcn_fence(__ATOMIC_ACQUIRE, "agent");
            xb_add(&bar[XB_XGEN(b.x)], 1u);
            asm volatile("s_waitcnt vmcnt(0)" ::: "memory");
        } else {
            XB_SPIN(xb_ld(&bar[XB_XGEN(b.x)]) == gen, bar);
            __builtin_amdgcn_fence(__ATOMIC_ACQUIRE, "agent");
            asm volatile("s_waitcnt vmcnt(0)" ::: "memory");
        }
    }
    __syncthreads();
}

namespace pg8 {

template <bool DRY> struct EpiInT {
    static constexpr bool PERM = true, AFTER_DRAIN = false;
    bf16_t* Z; float* LA; const float* rss; const float* biasz; const LAS float* rope  ;
    __device__ __forceinline__ void operator()(const f32x4 (&acc)[2][2][4][2], const Unit& u, int wr, int wc, int fr_, int fq_) const {
        int fr = fr_, fq = fq_; asm volatile("" : "+v"(fr), "+v"(fq));
        const int pn = u.pn; const bool latent = u.pm < 128; const int bsel = latent ? (u.pm >> 4) : 8;
        const float* bz = biasz + bsel * NPAD + pn * 256 + wc * 32 + 8 * fq;
        f32x4 bz4[2][2]; float rinv8[2][4];
#pragma unroll
        for (int bj = 0; bj < 2; ++bj)
#pragma unroll
            for (int n = 0; n < 2; ++n) bz4[bj][n] = *(const f32x4*)(bz + bj * 128 + n * 4);
#pragma unroll
        for (int ai = 0; ai < 2; ++ai)
#pragma unroll
            for (int m = 0; m < 4; ++m) rinv8[ai][m] = rss[u.pm * 256 + ai * 128 + wr * 64 + m * 16 + fr];
#pragma unroll
        for (int ai = 0; ai < 2; ++ai)
#pragma unroll
            for (int m = 0; m < 4; ++m) rinv8[ai][m] = rsqrtf(rinv8[ai][m] * (1.f / 1024.f) + EPS);
        const bool do_rope = latent && (pn == 3 || pn == 4 || (pn == 5 && wc < 2));
        const float s0 = (pn == 3 || pn == 4) ? QSCALE : (pn == 8 ? GQSCALE : 1.f), s1 = (pn == 3 || pn == 4) ? QSCALE : 1.f;
        const int ropeoff = 8 * (fq & 1);
        if (pn == 11) {
#pragma unroll
            for (int ai = 0; ai < 2; ++ai) { if (u.half >= 0 && u.half != ai) continue;
                const int rowb = u.pm * 256 + ai * 128 + wr * 64 + fr;
#pragma unroll
                for (int bj = 0; bj < 2; ++bj)
#pragma unroll
                    for (int n = 0; n < 2; ++n) {
                        const f32x4 b4 = bz4[bj][n];
                        f32x4 x[4];
#pragma unroll
                        for (int m = 0; m < 4; ++m) { const f32x4 zz = acc[ai][bj][m][n] * rinv8[ai][m] + b4;
#pragma unroll
                            for (int e = 0; e < 4; ++e) x[m][e] = (fminf(zz[e], 0.f) - __logf(1.f + __expf(-fabsf(zz[e])))) * (1.f / 16.f); }
#pragma unroll
                        for (int m = 0; m < 4; ++m)
#pragma unroll
                            for (int e = 0; e < 4; ++e) { float xv = x[m][e];
#define DPPF(v, ctrl) __int_as_float(__builtin_amdgcn_update_dpp(0, __float_as_int(v), ctrl, 0xf, 0xf, true))
                                if (bj == 0) { xv += DPPF(xv, 0x111); xv += DPPF(xv, 0x112); xv += DPPF(xv, 0x114); xv += DPPF(xv, 0x118); }
                                else { xv += DPPF(xv, 0x101); xv += DPPF(xv, 0x102); xv += DPPF(xv, 0x104); xv += DPPF(xv, 0x108); }
                                x[m][e] = xv; }
                        f32x4 tot[4];
#pragma unroll
                        for (int m = 0; m < 4; ++m)
#pragma unroll
                            for (int e = 0; e < 4; ++e) tot[m][e] = bj == 0 ? DPPF(x[m][e], 0x15f) : DPPF(x[m][e], 0x150);
#undef DPPF
                        if (bj == 0) { x[1] = x[1] + tot[0]; x[2] = x[2] + (tot[0] + tot[1]); x[3] = x[3] + ((tot[0] + tot[1]) + tot[2]); }
                        else { x[2] = x[2] + tot[3]; x[1] = x[1] + (tot[3] + tot[2]); x[0] = x[0] + ((tot[3] + tot[2]) + tot[1]); }
#pragma unroll
                        for (int m = 0; m < 4; ++m) { u32x2 w; w.x = pkh2(x[m][0], x[m][1]); w.y = pkh2(x[m][2], x[m][3]); if (!DRY || w.x == 0x12345678u) *(u32x2*)((bf16_t*)LA + (size_t)(rowb + 16 * m) * 256 + bj * 128 + wc * 32 + 8 * fq + 4 * n) = w; }
                    }
            }
            return;
        }
#pragma unroll
        for (int ai = 0; ai < 2; ++ai) { if (u.half >= 0 && u.half != ai) continue;
#pragma unroll
            for (int m = 0; m < 4; ++m) {
                const int row = u.pm * 256 + ai * 128 + wr * 64 + m * 16 + fr;
                const float rinv = rinv8[ai][m];
                f32x4 v[2][2];
#pragma unroll
                for (int bj = 0; bj < 2; ++bj)
#pragma unroll
                    for (int n = 0; n < 2; ++n) v[bj][n] = acc[ai][bj][m][n] * rinv + bz4[bj][n];
                if (do_rope) {
                    const int t = row & 4095; const int pp = (fq < 2) ? (t >> 6) : (t & 63);
#pragma unroll
                    for (int n = 0; n < 2; ++n) {
                        const f32x4 c4 = *(const LAS f32x4*)(rope + pp * 16 + ropeoff + 4 * n), s4 = *(const LAS f32x4*)(rope + 1024 + pp * 16 + ropeoff + 4 * n);
                        const f32x4 x1 = v[0][n], x2 = v[1][n];
                        v[0][n] = x1 * c4 - x2 * s4; v[1][n] = x2 * c4 + x1 * s4;
                    }
                }
                if (pn == 11) {
                } else if (pn < 2) {
                    const f32x4 a = v[0][0], b = v[0][1], ga = v[1][0], gb = v[1][1];
                    u32x4 w; w.x = pk2(a[0] * sigmoid_f(ga[0]), a[1] * sigmoid_f(ga[1])); w.y = pk2(a[2] * sigmoid_f(ga[2]), a[3] * sigmoid_f(ga[3]));
                    w.z = pk2(b[0] * sigmoid_f(gb[0]), b[1] * sigmoid_f(gb[1])); w.w = pk2(b[2] * sigmoid_f(gb[2]), b[3] * sigmoid_f(gb[3]));
                    if (!DRY || w.x == 0x12345678u) *(u32x4*)(Z + (size_t)row * ZLD + pn * 128 + wc * 32 + 8 * fq) = w;
                } else {
                    if (pn == 2) {
#pragma unroll
                        for (int bj = 0; bj < 2; ++bj)
#pragma unroll
                            for (int n = 0; n < 2; ++n)
#pragma unroll
                                for (int e = 0; e < 4; ++e) v[bj][n][e] = silu_f(v[bj][n][e]);
                    }
                    bf16_t* zr = Z + (size_t)row * ZLD + pn * 256 + wc * 32 + 8 * fq;
#pragma unroll
                    for (int bj = 0; bj < 2; ++bj) { const float sc = bj == 0 ? s0 : s1; const f32x4 a = v[bj][0] * sc, b = v[bj][1] * sc;
                        u32x4 w; w.x = pk2(a[0], a[1]); w.y = pk2(a[2], a[3]); w.z = pk2(b[0], b[1]); w.w = pk2(b[2], b[3]);
                        if (!DRY || w.x == 0x12345678u) *(u32x4*)(zr + bj * 128) = w; }
                }
            }
        }
    }
};
typedef EpiInT<false> EpiIn;
struct EpiOut {
    static constexpr bool PERM = true, AFTER_DRAIN = false;
    const float* xl; const float* xc; bf16_t* xout  ; const float* modv_l; const float* modv_next; bf16_t* Anext; float* rss_out;
    __device__ __forceinline__ void operator()(const f32x4 (&acc)[2][2][4][2], const Unit& u, int wr, int wc, int fr_, int fq_) const {
        int fr = fr_, fq = fq_; asm volatile("" : "+v"(fr), "+v"(fq));
        const int pn = u.pn; const bool latent = u.pm < 128; const int bsel = latent ? (u.pm >> 4) : 8;
        const int colb = pn * 256 + wc * 32 + 8 * fq;
        const float* gp = modv_l + bsel * 3072 + 2048 + colb;
        const float* sp = modv_next ? modv_next + bsel * 3072 + 1024 + colb : nullptr;
#pragma unroll
        for (int ai = 0; ai < 2; ++ai)
#pragma unroll
            for (int m = 0; m < 4; ++m) {
                const int row = u.pm * 256 + ai * 128 + wr * 64 + m * 16 + fr;
                const float* xin = (latent ? xl + (size_t)row * 1024 : xc + (size_t)(row - ML) * 1024) + colb;
                float ss = 0.f;
#pragma unroll
                for (int bj = 0; bj < 2; ++bj) {
                    f32x4 o[2];
#pragma unroll
                    for (int n = 0; n < 2; ++n) { const f32x4 x4 = *(const f32x4*)(xin + bj * 128 + 4 * n); const f32x4 g4 = *(const f32x4*)(gp + bj * 128 + 4 * n);
                        o[n] = x4 + g4 * acc[ai][bj][m][n]; ss += (o[n][0] * o[n][0] + o[n][1] * o[n][1]) + (o[n][2] * o[n][2] + o[n][3] * o[n][3]); }
                    if (latent) { u32x4 w; w.x = pkh2(o[0][0], o[0][1]); w.y = pkh2(o[0][2], o[0][3]); w.z = pkh2(o[1][0], o[1][1]); w.w = pkh2(o[1][2], o[1][3]); *(u32x4*)(xout + (size_t)row * 1024 + colb + bj * 128) = w; }
                    if (sp) { const f32x4 a = o[0] * (*(const f32x4*)(sp + bj * 128) + 1.f), b = o[1] * (*(const f32x4*)(sp + bj * 128 + 4) + 1.f);
                        u32x4 w; w.x = pk2(a[0], a[1]); w.y = pk2(a[2], a[3]); w.z = pk2(b[0], b[1]); w.w = pk2(b[2], b[3]);
                        *(u32x4*)(Anext + (size_t)row * 1024 + colb + bj * 128) = w; }
                }
                ss += __shfl_xor(ss, 16); ss += __shfl_xor(ss, 32);
                if (fq == 0) atomicAdd(rss_out + row, ss);
            }
    }
};
struct EpiOutFin {
    static constexpr bool PERM = true, AFTER_DRAIN = false;
    const bf16_t* xl  ; float* out; const float* modv_l; const float* fw; float* rss; unsigned* cnt; LAS unsigned* flag;
    __device__ __forceinline__ void operator()(const f32x4 (&acc_)[2][2][4][2], const Unit& u, int wr, int wc, int fr_, int fq_) const {
        f32x4 (&acc)[2][2][4][2] = const_cast<f32x4 (&)[2][2][4][2]>(acc_);
        int fr = fr_, fq = fq_; asm volatile("" : "+v"(fr), "+v"(fq));
        const int pn = u.pn; const int bsel = u.pm >> 4;
        const int colb = pn * 256 + wc * 32 + 8 * fq;
        const float* gp = modv_l + bsel * 3072 + 2048 + colb;
#pragma unroll
        for (int ai = 0; ai < 2; ++ai)
#pragma unroll
            for (int m = 0; m < 4; ++m) {
                const int row = u.pm * 256 + ai * 128 + wr * 64 + m * 16 + fr;
                const bf16_t* xin = xl + (size_t)row * 1024 + colb;
                float ss = 0.f;
#pragma unroll
                for (int bj = 0; bj < 2; ++bj) { const u32x4 xh = *(const u32x4*)(xin + bj * 128);
#pragma unroll
                    for (int n = 0; n < 2; ++n) { const f32x2 xa = unpkh2(n == 0 ? xh.x : xh.z), xb = unpkh2(n == 0 ? xh.y : xh.w); const f32x4 x4 = {xa[0], xa[1], xb[0], xb[1]}; const f32x4 g4 = *(const f32x4*)(gp + bj * 128 + 4 * n);
                        const f32x4 o = x4 + g4 * acc[ai][bj][m][n]; acc[ai][bj][m][n] = o; ss += (o[0] * o[0] + o[1] * o[1]) + (o[2] * o[2] + o[3] * o[3]); } }
                ss += __shfl_xor(ss, 16); ss += __shfl_xor(ss, 32);
                if (fq == 0) atomicAdd(rss + row, ss);
            }
        asm volatile("s_waitcnt vmcnt(0)" ::: "memory");
        __syncthreads();
        if (threadIdx.x == 0) {
            __hip_atomic_fetch_add(cnt + 64 * u.pm, 1u, __ATOMIC_RELAXED, __HIP_MEMORY_SCOPE_AGENT);
            unsigned sp_ = 0;
            while (__hip_atomic_load(cnt + 64 * u.pm, __ATOMIC_RELAXED, __HIP_MEMORY_SCOPE_AGENT) < 4u) { __builtin_amdgcn_s_sleep(2); if (++sp_ > (1u << 22)) break; }
        }
        __syncthreads();
#pragma unroll
        for (int ai = 0; ai < 2; ++ai)
#pragma unroll
            for (int m = 0; m < 4; ++m) {
                const int row = u.pm * 256 + ai * 128 + wr * 64 + m * 16 + fr;
                const float rinv = rsqrtf(__hip_atomic_load(rss + row, __ATOMIC_RELAXED, __HIP_MEMORY_SCOPE_AGENT) * (1.f / 1024.f) + EPS);
                float* xo = out + (size_t)row * 1024 + colb;
#pragma unroll
                for (int bj = 0; bj < 2; ++bj)
#pragma unroll
                    for (int n = 0; n < 2; ++n) *(f32x4*)(xo + bj * 128 + 4 * n) = acc[ai][bj][m][n] * rinv * *(const f32x4*)(fw + colb + bj * 128 + 4 * n);
            }
    }
};
struct OneUnit {
    int pm, pn; unsigned* cnt;
    __device__ __forceinline__ bool next(int i, Unit& u) const { if (i != 0) return false; u.pm = pm; u.pn = pn; u.half = -1; return true; }
    __device__ __forceinline__ void a_ready(const Unit&) const {}
    __device__ __forceinline__ void done(const Unit&) const {
        asm volatile("s_waitcnt vmcnt(0)" ::: "memory");
        __builtin_amdgcn_fence(__ATOMIC_RELEASE, "agent");
        asm volatile("s_waitcnt vmcnt(0)" ::: "memory");
        if ((threadIdx.x & 63) == 0) __hip_atomic_fetch_add(cnt, 1u, __ATOMIC_RELAXED, __HIP_MEMORY_SCOPE_AGENT);
    }
};
struct GatedOrder : StaticOrder {
    int pm_gate; const unsigned* cnt; unsigned need;
    int nfull, nextra;
    __device__ __forceinline__ bool next(int i, Unit& u) const {
        if (i < nfull) { map((long)i * G + ((c & 7) | ((((c >> 3) + 2 * i) & 31) << 3)), u); return true; }
        int k = i - nfull;
        if (c < nextra) { if (k == 0) { map((long)nfull * G + c, u); return true; } k -= 1; }
        if (k != 0) return false;
        const int rem = nwg - nfull * G - nextra; if (c >= 2 * rem) return false;
        map((long)nfull * G + nextra + (c >> 1), u); u.half = c & 1; return true;
    }
    __device__ __forceinline__ void a_ready(const Unit& u) const {
        if (u.pm < pm_gate) return;
        if (threadIdx.x < 64) {
            unsigned sp_ = 0;
            while ((unsigned)__builtin_amdgcn_readfirstlane(__hip_atomic_load(cnt, __ATOMIC_RELAXED, __HIP_MEMORY_SCOPE_AGENT)) < need) { __builtin_amdgcn_s_sleep(2); if (++sp_ > (1u << 22)) break; }
            __builtin_amdgcn_fence(__ATOMIC_ACQUIRE, "agent");
            asm volatile("s_waitcnt vmcnt(0)" ::: "memory");
        }
        asm volatile("" ::: "memory"); __builtin_amdgcn_s_barrier(); asm volatile("" ::: "memory");
    }
};
}

__device__ __forceinline__ int win_src_col(int n0) {
    if (n0 < 512) { const int t = n0 >> 8, bj = (n0 >> 7) & 1, off = n0 & 127; return (bj ? 256 : 0) + t * 128 + off; }
    if (n0 < 768) return n0;
    if (n0 < 1280) { const int r = n0 - 768, tq = r >> 8, bj = (r >> 7) & 1, wc = (r >> 5) & 3; return 768 + (4 * tq + wc) * 64 + 32 * bj; }
    if (n0 < 1536) { const int r = n0 - 1280, bj = (r >> 7) & 1, wc = (r >> 5) & 3; return wc < 2 ? 1280 + wc * 64 + 32 * bj : 1408 + (wc - 2) * 64 + 32 * bj; }
    if (n0 < 2560) return n0;
    if (n0 < 2816) return n0 + 32;
    return -1;
}
__device__ __forceinline__ void transpose_item(const float* Wsrc, int N, int srccol, const float* wup  , int lrcol, int j0, bf16_t* WT, int n0dst, int k0, LAS float* scr, int lane) {
    const int cc = lane & 31, kh = lane >> 5;
    if (wup == nullptr) {
        float v[32];
#pragma unroll
        for (int i = 0; i < 32; ++i) v[i] = Wsrc[(size_t)(k0 + 2 * i + kh) * N + srccol + cc];
#pragma unroll
        for (int i = 0; i < 32; ++i) scr[(2 * i + kh) * 33 + cc] = v[i];
    } else {
        LAS float* wl = scr + 64 * 33;
        f32x4 w4[4]; float up[16];
#pragma unroll
        for (int q = 0; q < 4; ++q) w4[q] = *(const f32x4*)(Wsrc + (size_t)(k0 + lane) * N + lrcol + 4 * q);
#pragma unroll
        for (int r = 0; r < 16; ++r) up[r] = wup[r * 128 + j0 + cc];
#pragma unroll
        for (int q = 0; q < 4; ++q) *(LAS f32x4*)(wl + lane * 16 + 4 * q) = w4[q];
        asm volatile("s_waitcnt lgkmcnt(0)" ::: "memory");
#pragma unroll 8
        for (int i = 0; i < 32; ++i) { const int kk = 2 * i + kh; float v = 0.f;
#pragma unroll
            for (int q = 0; q < 4; ++q) { const f32x4 a = *(const LAS f32x4*)(wl + kk * 16 + 4 * q); v += a[0] * up[4 * q] + a[1] * up[4 * q + 1] + a[2] * up[4 * q + 2] + a[3] * up[4 * q + 3]; }
            scr[kk * 33 + cc] = v; }
    }
    asm volatile("s_waitcnt lgkmcnt(0)" ::: "memory");
    const int c = lane & 7;
#pragma unroll
    for (int j = 0; j < 4; ++j) { const int n = (lane >> 3) + 8 * j; const LAS float* s = scr + (8 * c) * 33 + n;
        u32x4 o; o.x = pk2(s[0 * 33], s[1 * 33]); o.y = pk2(s[2 * 33], s[3 * 33]); o.z = pk2(s[4 * 33], s[5 * 33]); o.w = pk2(s[6 * 33], s[7 * 33]);
        *(u32x4*)(WT + (size_t)(n0dst + n) * 1024 + k0 + 8 * c) = o; }
    asm volatile("s_waitcnt lgkmcnt(0)" ::: "memory");
}
__device__ __forceinline__ void phase_prep0(const Params& p, const WS& W, LAS unsigned char* lds) {
    int tid_ = threadIdx.x; asm volatile("" : "+v"(tid_)); const int tid = tid_, lane = tid & 63, wave = tid >> 6;
    {
        LAS float* sc = (LAS float*)lds; LAS float* red = sc + 9 * 1024;
        if ((int)blockIdx.x < 192) {
            const int it = blockIdx.x, l = it / 96, cb = it % 96, cc = tid & 31, kg = tid >> 5;
            const float* wp = p.w_mod + (size_t)l * 1024 * 3072 + (size_t)(kg * 64) * 3072 + cb * 32 + cc;
            float w[64];
#pragma unroll
            for (int kk = 0; kk < 64; ++kk) w[kk] = wp[(size_t)kk * 3072];
            for (int idx = tid; idx < 9216; idx += 512) { const int r = idx >> 10, k = idx & 1023; const float v = r < 8 ? p.c[r * 1024 + k] : p.c_ctx[k]; sc[idx] = silu_f(v); }
            __syncthreads();
            float a[9];
#pragma unroll
            for (int r = 0; r < 9; ++r) a[r] = 0.f;
#pragma unroll
            for (int kk = 0; kk < 64; ++kk) {
#pragma unroll
                for (int r = 0; r < 9; ++r) a[r] += sc[r * 1024 + kg * 64 + kk] * w[kk]; }
#pragma unroll
            for (int r = 0; r < 9; ++r) red[(kg * 9 + r) * 32 + cc] = a[r];
            __syncthreads();
            if (tid < 288) { const int r = tid >> 5; float s = 0.f;
#pragma unroll
                for (int g = 0; g < 16; ++g) s += red[(g * 9 + r) * 32 + cc];
                W.modv[(l * 9 + r) * 3072 + cb * 32 + cc] = s + p.b_mod[l * 3072 + cb * 32 + cc]; }
        }
    }
    if (blockIdx.x == gridDim.x - 1) {
        for (int idx = tid; idx < 1024; idx += 512) { const int pp = idx >> 4, f = idx & 15;
            const float inv = __builtin_amdgcn_exp2f(-(float)f * (13.287712379549449f / 16.f)); const float ang = (float)pp * inv;
            W.rope[idx] = __cosf(ang); W.rope[1024 + idx] = __sinf(ang); }
    }
    for (int i = blockIdx.x * 512 + tid; i < PRM_N; i += gridDim.x * 512) {
        float v;
        if (i < PRM_CONVB) v = p.conv_w[i]; else if (i < PRM_LNW) v = p.conv_b[i - PRM_CONVB]; else if (i < PRM_LNB) v = p.conv_ln_w[i - PRM_LNW]; else if (i < PRM_SINK) v = p.conv_ln_b[i - PRM_LNB];
        else if (i < PRM_GNW) v = p.attn_sink[i - PRM_SINK]; else if (i < PRM_FNW) v = p.gla_norm_w[i - PRM_GNW]; else v = p.final_norm_w[i - PRM_FNW];
        W.prm[i] = v; }
    for (int i = blockIdx.x * 512 + tid; i < MT; i += gridDim.x * 512) { W.rss0[i] = (1.f - EPS) * 1024.f; W.rss1[i] = 0.f; if (i < ML) W.rss2[i] = 0.f; }
    __syncthreads();
    {
        LAS float* scr = (LAS float*)(lds + wave * 16384);
        const int bxr = (int)blockIdx.x >= 192 ? (int)blockIdx.x - 192 : (int)blockIdx.x + 64;
        const int gw = bxr * 8 + wave, NGW = gridDim.x * 8;
        constexpr int I_IN = 96 * 16, I_OUT = 32 * 16, I_L = I_IN + I_OUT;
        for (int it = gw; it < 2 * I_L; it += NGW) {
            const int l = it / I_L; int r = it % I_L;
            if (r < I_IN) { const int nb = r % 96, kb = r / 96, n0 = nb * 32; const int src = win_src_col(n0);
                if (src >= 0) transpose_item(p.w_in + (size_t)l * 1024 * 2848, 2848, src, nullptr, 0, 0, W.WinT + (size_t)l * NPAD * 1024, n0, kb * 64, scr, lane);
                else { const int dir = (n0 - 2816) >> 7, j0 = (n0 - 2816) & 127;
                    transpose_item(p.w_in + (size_t)l * 1024 * 2848, 2848, 0, p.gla_w_up + (size_t)(l * 2 + dir) * 16 * 128, 2560 + 16 * dir, j0, W.WinT + (size_t)l * NPAD * 1024, n0, kb * 64, scr, lane); } }
            else { r -= I_IN; const int nb = r % 32, kb = r / 32;
                transpose_item(p.w_out + (size_t)l * 1024 * 1024, 1024, nb * 32, nullptr, 0, 0, W.WoutT + (size_t)l * 1024 * 1024, nb * 32, kb * 64, scr, lane); }
        }
    }
}

__device__ __forceinline__ void phase_prep1(const Params& p, const WS& W) {
    int tid_ = threadIdx.x; asm volatile("" : "+v"(tid_)); const int tid = tid_, lane = tid & 63, wave = tid >> 6;
    const int gw = blockIdx.x * 8 + wave;
    {
        const int bsel = gw >> 8, rb = bsel * 4096 + (gw & 255);
        const float* md = W.modv + bsel * 3072; const float* mc = W.modv + 8 * 3072;
        f32x4 s4[4], h4[4], sc4[4], hc4[4], vc[4];
#pragma unroll
        for (int j = 0; j < 4; ++j) { s4[j] = *(const f32x4*)(md + 1024 + j * 256 + lane * 4); h4[j] = *(const f32x4*)(md + j * 256 + lane * 4);
            sc4[j] = *(const f32x4*)(mc + 1024 + j * 256 + lane * 4); hc4[j] = *(const f32x4*)(mc + j * 256 + lane * 4);
            vc[j] = __builtin_nontemporal_load((const f32x4*)(p.ctx + (size_t)gw * 1024 + j * 256 + lane * 4)); }
#define P1_LOAD(V, ST) _Pragma("unroll") for (int q = 0; q < 4; ++q) { const float* xr = p.x + (size_t)(rb + 256 * (4 * (ST) + q)) * 1024; \
            _Pragma("unroll") for (int j = 0; j < 4; ++j) V[q][j] = __builtin_nontemporal_load((const f32x4*)(xr + j * 256 + lane * 4)); }
#define P1_PROC(V, ST) do { float ss[4]; \
            _Pragma("unroll") for (int q = 0; q < 4; ++q) { ss[q] = 0.f; \
                _Pragma("unroll") for (int j = 0; j < 4; ++j) { const f32x4 x4 = V[q][j]; ss[q] += (x4[0] * x4[0] + x4[1] * x4[1]) + (x4[2] * x4[2] + x4[3] * x4[3]); } } \
            _Pragma("unroll") for (int o = 1; o < 64; o <<= 1) { _Pragma("unroll") for (int q = 0; q < 4; ++q) ss[q] += __shfl_xor(ss[q], o); } \
            _Pragma("unroll") for (int q = 0; q < 4; ++q) { const int row = rb + 256 * (4 * (ST) + q); \
                const float rinv = rsqrtf(ss[q] * (1.f / 1024.f) + EPS); u32x2* ao = (u32x2*)(W.A + (size_t)row * 1024); \
                _Pragma("unroll") for (int j = 0; j < 4; ++j) { const f32x4 a = V[q][j] * rinv * (s4[j] + 1.f) + h4[j]; u32x2 w; w.x = pk2(a[0], a[1]); w.y = pk2(a[2], a[3]); ao[j * 64 + lane] = w; } } } while (0)
        {
            f32x4 va[4][4], vb[4][4];
            P1_LOAD(va, 0);
        {
            float ss = 0.f;
#pragma unroll
            for (int j = 0; j < 4; ++j) { const f32x4 x4 = vc[j]; ss += (x4[0] * x4[0] + x4[1] * x4[1]) + (x4[2] * x4[2] + x4[3] * x4[3]); }
#pragma unroll
            for (int o = 1; o < 64; o <<= 1) ss += __shfl_xor(ss, o);
            const float rinv = rsqrtf(ss * (1.f / 1024.f) + EPS); u32x2* ao = (u32x2*)(W.A + (size_t)(ML + gw) * 1024);
#pragma unroll
            for (int j = 0; j < 4; ++j) { const f32x4 a = vc[j] * rinv * (sc4[j] + 1.f) + hc4[j]; u32x2 w; w.x = pk2(a[0], a[1]); w.y = pk2(a[2], a[3]); ao[j * 64 + lane] = w; }
        }
            asm volatile("" ::: "memory");
            P1_LOAD(vb, 1);
            P1_PROC(va, 0); asm volatile("" ::: "memory");
            P1_LOAD(va, 2);
            P1_PROC(vb, 1); asm volatile("" ::: "memory");
            P1_LOAD(vb, 3);
            P1_PROC(va, 2);
            P1_PROC(vb, 3);
        }
#undef P1_LOAD
#undef P1_PROC
    }
    for (int i = blockIdx.x * 512 + tid; i < 9 * NPAD; i += gridDim.x * 512) { const int n = i % NPAD; W.biasz[i] = n >= 2816 ? p.gla_b_up[((n - 2816) >> 7) * 128 + ((n - 2816) & 127)] : 0.f; }
}
__device__ __forceinline__ void bias1_tasks(const Params& p, const WS& W, int gw, int NGW, int lane) {
    for (int it = gw; it < NPAD; it += NGW) {
        const int l = 1, n = it;
        const bf16_t* wrow = W.WinT + ((size_t)l * NPAD + n) * 1024 + lane * 16;
        const u32x4 w0 = *(const u32x4*)wrow, w1 = *(const u32x4*)(wrow + 8);
        float wf[16];
#pragma unroll
        for (int e = 0; e < 4; ++e) { wf[2 * e] = bflo(w0[e]); wf[2 * e + 1] = bfhi(w0[e]); wf[8 + 2 * e] = bflo(w1[e]); wf[8 + 2 * e + 1] = bfhi(w1[e]); }
        float extra = 0.f;
        if (n >= 2816) extra = p.gla_b_up[(l * 2 + ((n - 2816) >> 7)) * 128 + ((n - 2816) & 127)];
        float sv[9];
#pragma unroll
        for (int r = 0; r < 9; ++r) {
            const float* sh = W.modv + (l * 9 + r) * 3072 + lane * 16; float s = 0.f;
#pragma unroll
            for (int q = 0; q < 4; ++q) { const f32x4 s4 = *(const f32x4*)(sh + 4 * q); s += s4[0] * wf[4 * q] + s4[1] * wf[4 * q + 1] + s4[2] * wf[4 * q + 2] + s4[3] * wf[4 * q + 3]; }
            sv[r] = s; }
#pragma unroll
        for (int o = 1; o < 64; o <<= 1) {
#pragma unroll
            for (int r = 0; r < 9; ++r) sv[r] += __shfl_xor(sv[r], o); }
        if (lane < 9) { float s = sv[0];
#pragma unroll
            for (int r = 1; r < 9; ++r) s = lane == r ? sv[r] : s;
            W.biasz[(l * 9 + lane) * NPAD + n] = s + extra; }
    }
}

__device__ __forceinline__ void conv_unit(const Params& p, const WS& W, int layer, int sidx, int tile, LAS unsigned char* lds) {
    int tid_ = threadIdx.x; asm volatile("" : "+v"(tid_)); const int tid = tid_, lane = tid & 63, wave = tid >> 6;
    const bool isctx = sidx >= 8; const int b = sidx & 7;
    const int L = isctx ? NCTX : SEQ; const int rowbase = isctx ? ML + b * NCTX : b * SEQ; const int t0 = tile * 64;
    LAS float* U = (LAS float*)lds;
    {
        u32x4 a[6];
#pragma unroll
        for (int i = 0; i < 6; ++i) { const int idx = tid + 512 * i, tt = idx >> 5, ch = idx & 31, t = t0 - 15 + tt;
            a[i] = (u32x4){0u, 0u, 0u, 0u};
            if (tt < 94 && t >= 0 && t < L) a[i] = *(const u32x4*)(W.Z + (size_t)(rowbase + t) * ZLD + ch * 8); }
#pragma unroll
        for (int i = 0; i < 6; ++i) { const int idx = tid + 512 * i, tt = idx >> 5, ch = idx & 31;
            if (tt < 94) { const f32x4 u0 = {bflo(a[i][0]), bfhi(a[i][0]), bflo(a[i][1]), bfhi(a[i][1])}, u1 = {bflo(a[i][2]), bfhi(a[i][2]), bflo(a[i][3]), bfhi(a[i][3])};
                *(LAS f32x4*)(U + tt * 256 + ch * 8) = u0; *(LAS f32x4*)(U + tt * 256 + ch * 8 + 4) = u1; } }
    }
    __syncthreads();
    {
        const int c = tid & 255, half = tid >> 8;
        float uu[62], wgt[31];
#pragma unroll
        for (int j = 0; j < 31; ++j) wgt[j] = W.prm[PRM_CONVW + (layer * 31 + j) * 256 + c];
#pragma unroll
        for (int i = 0; i < 62; ++i) uu[i] = U[(half * 32 + i) * 256 + c];
        const float cb = W.prm[PRM_CONVB + layer * 256 + c];
        __syncthreads();
#pragma unroll
        for (int t = 0; t < 32; ++t) { float a = cb;
#pragma unroll
            for (int j = 0; j < 31; ++j) a = fmaf(wgt[j], uu[t + j], a);
            U[(half * 32 + t) * 256 + c] = a; }
    }
    __syncthreads();
    {
        const f32x4 lw = *(const f32x4*)(W.prm + PRM_LNW + layer * 256 + lane * 4), lb = *(const f32x4*)(W.prm + PRM_LNB + layer * 256 + lane * 4);
        f32x4 v[8]; u32x2 gz[8]; float sm[8];
#pragma unroll
        for (int tk = 0; tk < 8; ++tk) { const int t = wave * 8 + tk; v[tk] = *(const LAS f32x4*)(U + t * 256 + lane * 4); gz[tk] = *(const u32x2*)(W.Z + (size_t)(rowbase + t0 + t) * ZLD + 512 + lane * 4);
            sm[tk] = (v[tk][0] + v[tk][1]) + (v[tk][2] + v[tk][3]); }
#pragma unroll
        for (int o = 1; o < 64; o <<= 1) {
#pragma unroll
            for (int tk = 0; tk < 8; ++tk) sm[tk] += __shfl_xor(sm[tk], o); }
#pragma unroll
        for (int tk = 0; tk < 8; ++tk) { v[tk] = v[tk] - sm[tk] * (1.f / 256.f); sm[tk] = (v[tk][0] * v[tk][0] + v[tk][1] * v[tk][1]) + (v[tk][2] * v[tk][2] + v[tk][3] * v[tk][3]); }
#pragma unroll
        for (int o = 1; o < 64; o <<= 1) {
#pragma unroll
            for (int tk = 0; tk < 8; ++tk) sm[tk] += __shfl_xor(sm[tk], o); }
#pragma unroll
        for (int tk = 0; tk < 8; ++tk) {
            const int row = rowbase + t0 + wave * 8 + tk;
            const float rstd = rsqrtf(sm[tk] * (1.f / 256.f) + EPS);
            const f32x4 y = v[tk] * rstd * lw + lb;
            const float o0 = silu_f(y[0]) * bflo(gz[tk].x), o1 = silu_f(y[1]) * bfhi(gz[tk].x), o2 = silu_f(y[2]) * bflo(gz[tk].y), o3 = silu_f(y[3]) * bfhi(gz[tk].y);
            u32x2 w; w.x = pk2(o0, o1); w.y = pk2(o2, o3);
            *(u32x2*)(W.Y + (size_t)row * 1024 + lane * 4) = w;
        }
    }
    __syncthreads();
}

#define GLA_CUMSUM(bc, tot, larow, dir, lane)                                                               \
    do {                                                                                                    \
        _Pragma("unroll") for (int q_ = 0; q_ < 8; ++q_) { const f32x4 t4_ = *(const f32x4*)((larow) + 4 * q_); bc[4 * q_] = t4_[0]; bc[4 * q_ + 1] = t4_[1]; bc[4 * q_ + 2] = t4_[2]; bc[4 * q_ + 3] = t4_[3]; } \
        _Pragma("unroll") for (int d_ = 0; d_ < 32; ++d_) { float x_ = bc[d_];                                \
            if ((dir) == 0) { _Pragma("unroll") for (int o_ = 1; o_ < 64; o_ <<= 1) { const float y_ = __shfl_up(x_, o_); if ((lane) >= o_) x_ += y_; } tot[d_] = __shfl(x_, 63); } \
            else { _Pragma("unroll") for (int o_ = 1; o_ < 64; o_ <<= 1) { const float y_ = __shfl_down(x_, o_); if ((lane) + o_ < 64) x_ += y_; } tot[d_] = __shfl(x_, 0); } \
            bc[d_] = x_; }                                                                                  \
    } while (0)

#define GLA_LOADB(bc, tot, W_, row0_, dir_, h_, lane_) do { \
        const float* lr_ = (W_).LA + (size_t)((row0_) + (lane_)) * 256 + (dir_) * 128 + (h_) * 32; const float* lt_ = (W_).LA + (size_t)((row0_) + ((dir_) == 0 ? 63 : 0)) * 256 + (dir_) * 128 + (h_) * 32; \
        _Pragma("unroll") for (int q_ = 0; q_ < 8; ++q_) { const f32x4 a_ = *(const f32x4*)(lr_ + 4 * q_), t_ = *(const f32x4*)(lt_ + 4 * q_); \
            bc[4 * q_] = a_[0]; bc[4 * q_ + 1] = a_[1]; bc[4 * q_ + 2] = a_[2]; bc[4 * q_ + 3] = a_[3]; tot[4 * q_] = t_[0]; tot[4 * q_ + 1] = t_[1]; tot[4 * q_ + 2] = t_[2]; tot[4 * q_ + 3] = t_[3]; } } while (0)

__device__ __forceinline__ void gla_state_unit(const WS& W, int b, bool isctx, int n, LAS unsigned char* lds) {
    int tid_ = threadIdx.x; asm volatile("" : "+v"(tid_)); const int tid = tid_, lane = tid & 63, wave = __builtin_amdgcn_readfirstlane(tid >> 6);
    const int dir = wave >> 2, h = wave & 3;
    const int row0 = (isctx ? ML + b * NCTX : b * SEQ) + n * 64;
    LAS unsigned char* Vb = lds;
    LAS unsigned char* KW = lds + 49152 + wave * 5120;
#pragma unroll
    for (int i = 0; i < 4; ++i) { const int idx = tid + 512 * i, t = idx >> 5, hh = (idx >> 3) & 3, ch = idx & 7;
        *(LAS u32x4*)(Vb + hh * 12288 + t * 192 + ch * 16) = *(const u32x4*)(W.Z + (size_t)(row0 + t) * ZLD + 2304 + hh * 64 + ch * 8); }
    float bc[32], tot[32];
    GLA_LOADB(bc, tot, W, row0, dir, h, lane);
    const int c = dir == 0 ? (isctx ? n : 4 + n) : (isctx ? 3 - n : 67 - n);
    const size_t cbase = (size_t)(((b * 2 + dir) * NCHAIN + c) * 4 + h);
    {
        const bf16_t* kp = W.Z + (size_t)(row0 + lane) * ZLD + 2176 + h * 32;
#pragma unroll
        for (int q = 0; q < 4; ++q) { const u32x4 kk = *(const u32x4*)(kp + 8 * q); u32x4 o;
#pragma unroll
            for (int e = 0; e < 4; ++e) { const int d = 8 * q + 2 * e; o[e] = pk2(bflo(kk[e]) * __expf(tot[d] - bc[d]), bfhi(kk[e]) * __expf(tot[d + 1] - bc[d + 1])); }
            *(LAS u32x4*)(KW + lane * 80 + q * 16) = o; }
        if (lane == 0) { float* dp = W.dec + cbase * 32;
#pragma unroll
            for (int q = 0; q < 8; ++q) { f32x4 o = {__expf(tot[4 * q]), __expf(tot[4 * q + 1]), __expf(tot[4 * q + 2]), __expf(tot[4 * q + 3])}; *(f32x4*)(dp + 4 * q) = o; } }
    }
    __syncthreads();
    {
        const int i16 = lane & 15, gi = (lane >> 4) & 1, hi = lane >> 5, l31 = lane & 31;
        const LAS unsigned char* kwb = KW + (i16 >> 2) * 80 + (16 * gi + 4 * (i16 & 3)) * 2 + (8 * hi) * 80;
        const LAS unsigned char* vb = Vb + h * 12288 + (i16 >> 2) * 192 + (16 * gi + 4 * (i16 & 3)) * 2 + (8 * hi) * 192;
        float* stp = W.ST + cbase * 2048;
#pragma unroll
        for (int vt = 0; vt < 2; ++vt) {
            f32x16 acc = {};
#pragma unroll
            for (int s = 0; s < 4; ++s) {
                const bf16x8 a = cat8(tr_read(kwb + (16 * s) * 80), tr_read(kwb + (16 * s + 4) * 80));
                const bf16x8 bb = cat8(tr_read(vb + (16 * s) * 192 + vt * 64), tr_read(vb + (16 * s + 4) * 192 + vt * 64));
                acc = MFMA32(a, bb, acc);
            }
#pragma unroll
            for (int r = 0; r < 16; ++r) { const int d = (r & 3) + 8 * (r >> 2) + 4 * hi; stp[d * 64 + 32 * vt + l31] = acc[r]; }
        }
    }
    __syncthreads();
}

__device__ __forceinline__ void gla_scan(const WS& W, int unit) {
    int tid_ = threadIdx.x; asm volatile("" : "+v"(tid_));
    { const int e = unit * 512 + tid_;
        const int pp = e & 1023, h = (e >> 10) & 3, bd = e >> 12, d = 2 * (pp & 15);
        unsigned* sp = (unsigned*)W.ST + ((size_t)(bd * NCHAIN) * 4 + h) * 1024 + pp;
        const float* dp = W.dec + ((size_t)(bd * NCHAIN) * 4 + h) * 32 + d;
        float S0 = 0.f, S1 = 0.f;
#pragma unroll
        for (int c0 = 0; c0 < NCHAIN; c0 += 34) {
            unsigned st[34]; f32x2 dc[34];
#pragma unroll
            for (int j = 0; j < 34; ++j) { st[j] = sp[(size_t)(c0 + j) * 4096]; dc[j] = *(const f32x2*)(dp + (size_t)(c0 + j) * 128); }
#pragma unroll
            for (int j = 0; j < 34; ++j) { sp[(size_t)(c0 + j) * 4096] = pk2(S0, S1); const f32x2 x = unpkh2(st[j]); S0 = dc[j][0] * S0 + x[0]; S1 = dc[j][1] * S1 + x[1]; }
        }
    }
}

__device__ __forceinline__ void gla_out_unit(const Params& p, const WS& W, int layer, int b, bool isctx, int n, int hp, LAS unsigned char* lds) {
    int tid_ = threadIdx.x; asm volatile("" : "+v"(tid_)); const int tid = tid_, lane = tid & 63, wave = __builtin_amdgcn_readfirstlane(tid >> 6);
    const int dh = wave >> 1, dir = dh >> 1, hl = dh & 1, h = hp * 2 + hl, th = wave & 1;
    const int row0 = (isctx ? ML + b * NCTX : b * SEQ) + n * 64;
    LAS unsigned char* Vb = lds;
    LAS unsigned char* QK = lds + 24576;
    LAS unsigned char* SI = lds + 65536;
    LAS float* OB = (LAS float*)(lds + 90112);
#pragma unroll
    for (int i = 0; i < 2; ++i) { const int idx = tid + 512 * i, t = idx >> 4, hh = (idx >> 3) & 1, ch = idx & 7;
        *(LAS u32x4*)(Vb + hh * 12288 + t * 192 + ch * 16) = *(const u32x4*)(W.Z + (size_t)(row0 + t) * ZLD + 2304 + (hp * 2 + hh) * 64 + ch * 8); }
#pragma unroll
    for (int i = 0; i < 2; ++i) { const int idx = tid + 512 * i, q = idx >> 8, d = (idx >> 3) & 31, ch = idx & 7;
        const int qdir = q >> 1, qh = hp * 2 + (q & 1);
        const int c = qdir == 0 ? (isctx ? n : 4 + n) : (isctx ? 3 - n : 67 - n);
        const float* sp = W.ST + ((size_t)(((b * 2 + qdir) * NCHAIN + c) * 4 + qh)) * 2048 + d * 64 + ch * 8;
        const f32x4 s0 = *(const f32x4*)sp, s1 = *(const f32x4*)(sp + 4);
        u32x4 o; o.x = pk2(s0[0], s0[1]); o.y = pk2(s0[2], s0[3]); o.z = pk2(s1[0], s1[1]); o.w = pk2(s1[2], s1[3]);
        *(LAS u32x4*)(SI + q * 6144 + d * 192 + ch * 16) = o; }
    if (th == 0) {
        float bc[32], tot[32];
        GLA_LOADB(bc, tot, W, row0, dir, h, lane);
        const bf16_t* qp = W.Z + (size_t)(row0 + lane) * ZLD + 2048 + h * 32;
        LAS unsigned char* qi = QK + dh * 10240 + lane * 80; LAS unsigned char* ki = qi + 5120;
#pragma unroll
        for (int q = 0; q < 4; ++q) { const u32x4 qq = *(const u32x4*)(qp + 8 * q), kk = *(const u32x4*)(qp + 128 + 8 * q); u32x4 oq, ok;
#pragma unroll
            for (int e = 0; e < 4; ++e) { const int d = 8 * q + 2 * e; const float e0 = __expf(bc[d]), e1 = __expf(bc[d + 1]);
                oq[e] = pk2(bflo(qq[e]) * e0, bfhi(qq[e]) * e1); ok[e] = pk2(bflo(kk[e]) / e0, bfhi(kk[e]) / e1); }
            *(LAS u32x4*)(qi + q * 16) = oq; *(LAS u32x4*)(ki + q * 16) = ok; }
    }
    __syncthreads();
    const int i16 = lane & 15, gi = (lane >> 4) & 1, hi = lane >> 5, l31 = lane & 31;
    f32x16 o[2];
    {
        const LAS unsigned char* qib = QK + dh * 10240; const LAS unsigned char* kib = qib + 5120;
        bf16x8 qf[2];
#pragma unroll
        for (int s = 0; s < 2; ++s) qf[s] = *(const LAS bf16x8*)(qib + (32 * th + l31) * 80 + (2 * s + hi) * 16);
        f32x16 at[2];
#pragma unroll
        for (int st = 0; st < 2; ++st) { f32x16 a = {};
#pragma unroll
            for (int s = 0; s < 2; ++s) { const bf16x8 kf = *(const LAS bf16x8*)(kib + (32 * st + l31) * 80 + (2 * s + hi) * 16); a = MFMA32(kf, qf[s], a); }
            const int tq = 32 * th + l31;
#pragma unroll
            for (int r = 0; r < 16; ++r) { const int sk = 32 * st + (r & 3) + 8 * (r >> 2) + 4 * hi; const bool keep = dir == 0 ? (sk <= tq) : (sk >= tq); a[r] = keep ? a[r] : 0.f; }
            at[st] = a; }
        const LAS unsigned char* vb = Vb + hl * 12288 + (i16 >> 2) * 192 + (16 * gi + 4 * (i16 & 3)) * 2;
        const LAS unsigned char* sb = SI + dh * 6144 + (i16 >> 2) * 192 + (16 * gi + 4 * (i16 & 3)) * 2 + (8 * hi) * 192;
#pragma unroll
        for (int vt = 0; vt < 2; ++vt) {
            f32x16 acc = {};
#pragma unroll
            for (int st = 0; st < 2; ++st)
#pragma unroll
                for (int sk = 0; sk < 2; ++sk) { const int r0 = 32 * st + 16 * sk + 4 * hi;
                    const bf16x8 a = cat8(tr_read(vb + r0 * 192 + vt * 64), tr_read(vb + (r0 + 8) * 192 + vt * 64));
                    acc = MFMA32(a, pack_acc8(at[st], sk), acc); }
#pragma unroll
            for (int s = 0; s < 2; ++s) { const bf16x8 a = cat8(tr_read(sb + (16 * s) * 192 + vt * 64), tr_read(sb + (16 * s + 4) * 192 + vt * 64)); acc = MFMA32(a, qf[s], acc); }
            o[vt] = acc;
        }
    }
    if (dir == 1) {
#pragma unroll
        for (int vt = 0; vt < 2; ++vt)
#pragma unroll
            for (int r = 0; r < 16; ++r) { const int v = 32 * vt + (r & 3) + 8 * (r >> 2) + 4 * hi; OB[hl * 4096 + v * 64 + 32 * th + l31] = o[vt][r]; }
    }
    __syncthreads();
    if (dir == 0) {
        float ss = 0.f;
#pragma unroll
        for (int vt = 0; vt < 2; ++vt)
#pragma unroll
            for (int r = 0; r < 16; ++r) { const int v = 32 * vt + (r & 3) + 8 * (r >> 2) + 4 * hi; const float x = o[vt][r] + OB[hl * 4096 + v * 64 + 32 * th + l31]; o[vt][r] = x; ss += x * x; }
        ss += __shfl_xor(ss, 32);
        const float rinv = rsqrtf(ss * (1.f / 64.f) + EPS);
        const int row = row0 + 32 * th + l31;
#pragma unroll
        for (int vt = 0; vt < 2; ++vt)
#pragma unroll
            for (int r4 = 0; r4 < 4; ++r4) { const int v = 32 * vt + 8 * r4 + 4 * hi;
                const u32x2 gz = *(const u32x2*)(W.Z + (size_t)row * ZLD + 2560 + h * 64 + v);
                const f32x4 nw = *(const f32x4*)(W.prm + PRM_GNW + layer * 256 + h * 64 + v);
                const float a0 = o[vt][4 * r4] * rinv * nw[0] * silu_f(bflo(gz.x)), a1 = o[vt][4 * r4 + 1] * rinv * nw[1] * silu_f(bfhi(gz.x));
                const float a2 = o[vt][4 * r4 + 2] * rinv * nw[2] * silu_f(bflo(gz.y)), a3 = o[vt][4 * r4 + 3] * rinv * nw[3] * silu_f(bfhi(gz.y));
                u32x2 w; w.x = pk2(a0, a1); w.y = pk2(a2, a3);
                *(u32x2*)(W.Y + (size_t)row * 1024 + 768 + h * 64 + v) = w; }
    }
    __syncthreads();
}


__device__ __forceinline__ int wq_next(unsigned* ctr, int lane) { unsigned v = 0; if (lane == 0) v = __hip_atomic_fetch_add(ctr, 1u, __ATOMIC_RELAXED, __HIP_MEMORY_SCOPE_AGENT); return (int)__builtin_amdgcn_readfirstlane(v); }
#define LDSW_WAIT() asm volatile("s_waitcnt lgkmcnt(0)" ::: "memory")
__device__ __forceinline__ void gla_stage_v(const bf16_t* z0, int h, LAS unsigned char* Vw, int lane) {
    u32x4 vv[8]; const bf16_t* zp = z0 + (size_t)(lane >> 3) * ZLD + 2304 + h * 64 + 8 * (lane & 7);
#pragma unroll
    for (int i = 0; i < 8; ++i) vv[i] = *(const u32x4*)(zp + (size_t)(8 * i) * ZLD);
#pragma unroll
    for (int i = 0; i < 8; ++i) *(LAS u32x4*)(Vw + ((lane >> 3) + 8 * i) * 144 + (lane & 7) * 16) = vv[i];
}
__device__ __forceinline__ void gla_state_wave(const WS& W, int b, bool isctx, int n, int h, LAS unsigned char* ldsw, int) {
    int lane = (int)__builtin_amdgcn_mbcnt_hi(~0u, __builtin_amdgcn_mbcnt_lo(~0u, 0u)); asm volatile("" : "+v"(lane));
    const int row0 = (isctx ? ML + b * NCTX : b * SEQ) + n * 64;
    const bf16_t* z0 = W.Z + (size_t)row0 * ZLD;
    LAS unsigned char* Vw = ldsw; LAS unsigned char* KW = ldsw + 9216;
    LDSW_WAIT();
    const int pr = lane >> 3, pc = lane & 7;
    u32x4 vv[8]; u32x2 kk[8], la0[8], la1[8], tt0, tt1;
    { const bf16_t* zp = z0 + (size_t)(lane >> 3) * ZLD + 2304 + h * 64 + 8 * (lane & 7);
#pragma unroll
      for (int i = 0; i < 8; ++i) vv[i] = *(const u32x4*)(zp + (size_t)(8 * i) * ZLD); }
    const bf16_t* lb = (const bf16_t*)W.LA + (size_t)row0 * 256 + h * 32 + 4 * pc;
    tt0 = *(const u32x2*)(lb + (size_t)63 * 256); tt1 = *(const u32x2*)(lb + 128);
#pragma unroll
    for (int i = 0; i < 8; ++i) { kk[i] = *(const u32x2*)(z0 + (size_t)(pr + 8 * i) * ZLD + 2176 + h * 32 + 4 * pc);
        la0[i] = *(const u32x2*)(lb + (size_t)(pr + 8 * i) * 256); la1[i] = *(const u32x2*)(lb + (size_t)(pr + 8 * i) * 256 + 128); }
#pragma unroll
    for (int i = 0; i < 8; ++i) *(LAS u32x4*)(Vw + ((lane >> 3) + 8 * i) * 144 + (lane & 7) * 16) = vv[i];
    const int i16 = lane & 15, gi = (lane >> 4) & 1, hi = lane >> 5, l31 = lane & 31;
    const LAS unsigned char* kwb = KW + (8 * hi + (i16 >> 2)) * 80 + (16 * gi + 4 * (i16 & 3)) * 2;
    const LAS unsigned char* vb = Vw + (8 * hi + (i16 >> 2)) * 144 + (16 * gi + 4 * (i16 & 3)) * 2;
    LAS unsigned char* Tb = ldsw + 14336;
#define GS_DIR(DIR, LAX, TT) do { \
        const int c = (DIR) == 0 ? (isctx ? n : 4 + n) : (isctx ? 3 - n : 67 - n); \
        const size_t cbase = (size_t)(((b * 2 + (DIR)) * NCHAIN + c) * 4 + h); \
        f32x4 tot; { const f32x2 a_ = unpkh2(TT.x), b_ = unpkh2(TT.y); tot = (f32x4){a_[0], a_[1], b_[0], b_[1]}; } \
        _Pragma("unroll") for (int i = 0; i < 8; ++i) { f32x4 bb; { const f32x2 a_ = unpkh2(LAX[i].x), b_ = unpkh2(LAX[i].y); bb = (f32x4){a_[0], a_[1], b_[0], b_[1]}; } u32x2 o; \
            o.x = pk2(bflo(kk[i].x) * __expf(tot[0] - bb[0]), bfhi(kk[i].x) * __expf(tot[1] - bb[1])); o.y = pk2(bflo(kk[i].y) * __expf(tot[2] - bb[2]), bfhi(kk[i].y) * __expf(tot[3] - bb[3])); \
            *(LAS u32x2*)(KW + (pr + 8 * i) * 80 + pc * 8) = o; } \
        if (pr == 0) { const f32x4 o = {__expf(tot[0]), __expf(tot[1]), __expf(tot[2]), __expf(tot[3])}; *(f32x4*)(W.dec + cbase * 32 + 4 * pc) = o; } \
        LDSW_WAIT(); \
          \
        _Pragma("unroll") for (int vt = 0; vt < 2; ++vt) { f32x16 acc = {}; \
            _Pragma("unroll") for (int s = 0; s < 4; ++s) { \
                const bf16x8 a = cat8(tr_read(kwb + (16 * s) * 80), tr_read(kwb + (16 * s + 4) * 80)); \
                const bf16x8 bb = cat8(tr_read(vb + (16 * s) * 144 + vt * 64), tr_read(vb + (16 * s + 4) * 144 + vt * 64)); \
                acc = MFMA32(a, bb, acc); } \
            _Pragma("unroll") for (int g4 = 0; g4 < 4; ++g4) { u32x2 w; w.x = pkh2(acc[4 * g4], acc[4 * g4 + 1]); w.y = pkh2(acc[4 * g4 + 2], acc[4 * g4 + 3]); \
                *(LAS u32x2*)(Tb + (32 * vt + l31) * 64 + (8 * g4 + 4 * hi) * 2) = w; } } \
        LDSW_WAIT(); \
        { bf16_t* stp = (bf16_t*)W.ST + cbase * 2048; \
          _Pragma("unroll") for (int i = 0; i < 4; ++i) *(u32x4*)(stp + (lane + 64 * i) * 8) = *(const LAS u32x4*)(Tb + (lane + 64 * i) * 16); } \
    } while (0)
    GS_DIR(0, la0, tt0);
    LDSW_WAIT();
    GS_DIR(1, la1, tt1);
#undef GS_DIR
}
__device__ __forceinline__ void gla_out_wave(const Params& p, const WS& W, int layer, int b, bool isctx, int n, int h, LAS unsigned char* ldsw, int) {
    int lane = (int)__builtin_amdgcn_mbcnt_hi(~0u, __builtin_amdgcn_mbcnt_lo(~0u, 0u)); asm volatile("" : "+v"(lane));
    const int row0 = (isctx ? ML + b * NCTX : b * SEQ) + n * 64;
    const bf16_t* z0 = W.Z + (size_t)row0 * ZLD;
    LAS unsigned char* Vw = ldsw; LAS unsigned char* QI = ldsw + 9216; LAS unsigned char* KI = ldsw + 14336;
    const int cf = isctx ? n : 4 + n, cb_ = isctx ? 3 - n : 67 - n;
    const bf16_t* sp0 = (const bf16_t*)W.ST + ((size_t)(((b * 2 + 0) * NCHAIN + cf) * 4 + h)) * 2048;
    const bf16_t* sp1 = (const bf16_t*)W.ST + ((size_t)(((b * 2 + 1) * NCHAIN + cb_) * 4 + h)) * 2048;
    float pf0 = 0.f, pf1 = 0.f;
    if (PROBE_PH < 0) { pf0 = *(const float*)(sp0 + lane * 32); pf1 = *(const float*)(sp1 + lane * 32); }
    LDSW_WAIT();
    const int pr = lane >> 3, pc = lane & 7;
    const int i16 = lane & 15, gi = (lane >> 4) & 1, hi = lane >> 5, l31 = lane & 31;
    u32x4 vv[8]; u32x2 qr[8], kr[8], la0[8], la1[8];
    { const bf16_t* zp = z0 + (size_t)(lane >> 3) * ZLD + 2304 + h * 64 + 8 * (lane & 7);
#pragma unroll
      for (int i = 0; i < 8; ++i) vv[i] = *(const u32x4*)(zp + (size_t)(8 * i) * ZLD); }
#pragma unroll
    for (int i = 0; i < 8; ++i) { const bf16_t* zp = z0 + (size_t)(pr + 8 * i) * ZLD + 2048 + h * 32 + 4 * pc; qr[i] = *(const u32x2*)zp; kr[i] = *(const u32x2*)(zp + 128);
        const bf16_t* lb = (const bf16_t*)W.LA + (size_t)(row0 + pr + 8 * i) * 256 + h * 32 + 4 * pc; la0[i] = *(const u32x2*)lb; la1[i] = *(const u32x2*)(lb + 128); }
#pragma unroll
    for (int i = 0; i < 8; ++i) *(LAS u32x4*)(Vw + ((lane >> 3) + 8 * i) * 144 + (lane & 7) * 16) = vv[i];
    const LAS unsigned char* vb = Vw + (i16 >> 2) * 144 + (16 * gi + 4 * (i16 & 3)) * 2;
    f32x16 o[2][2];
#pragma unroll
    for (int vt = 0; vt < 2; ++vt) { o[vt][0] = (f32x16){}; o[vt][1] = (f32x16){}; }
    bf16x8 sf[2][2];
#define GO_PREP(LAX, OQ, OK) _Pragma("unroll") for (int i = 0; i < 8; ++i) { const f32x2 a_ = unpkh2(LAX[i].x), b_ = unpkh2(LAX[i].y); \
            const float e0 = __expf(a_[0]), e1 = __expf(a_[1]), e2 = __expf(b_[0]), e3 = __expf(b_[1]); const u32x2 qv = qr[i], kv = kr[i]; \
            OQ[i].x = pk2(bflo(qv.x) * e0, bfhi(qv.x) * e1); OQ[i].y = pk2(bflo(qv.y) * e2, bfhi(qv.y) * e3); \
            OK[i].x = pk2(bflo(kv.x) * __builtin_amdgcn_rcpf(e0), bfhi(kv.x) * __builtin_amdgcn_rcpf(e1)); OK[i].y = pk2(bflo(kv.y) * __builtin_amdgcn_rcpf(e2), bfhi(kv.y) * __builtin_amdgcn_rcpf(e3)); }
#define GO_PUT(OQ, OK) _Pragma("unroll") for (int i = 0; i < 8; ++i) { *(LAS u32x2*)(QI + (pr + 8 * i) * 80 + pc * 8) = OQ[i]; *(LAS u32x2*)(KI + (pr + 8 * i) * 80 + pc * 8) = OK[i]; }
#define GO_SF(SP) _Pragma("unroll") for (int vt = 0; vt < 2; ++vt) _Pragma("unroll") for (int s = 0; s < 2; ++s) sf[vt][s] = *(const bf16x8*)((SP) + (32 * vt + l31) * 32 + 16 * s + 8 * hi)
#define GO_MMA(DIR) _Pragma("unroll") for (int tt = 0; tt < 2; ++tt) { bf16x8 qf[2]; \
            _Pragma("unroll") for (int s = 0; s < 2; ++s) qf[s] = *(const LAS bf16x8*)(QI + (32 * tt + l31) * 80 + (2 * s + hi) * 16); \
            _Pragma("unroll") for (int st = 0; st < 2; ++st) { f32x16 at = (f32x16){}; \
                _Pragma("unroll") for (int s = 0; s < 2; ++s) { const bf16x8 kf = *(const LAS bf16x8*)(KI + (32 * st + l31) * 80 + (2 * s + hi) * 16); at = MFMA32(kf, qf[s], at); } \
                _Pragma("unroll") for (int r = 0; r < 16; ++r) { const int sk = 32 * st + (r & 3) + 8 * (r >> 2) + 4 * hi, tq = 32 * tt + l31; const bool keep = (DIR) == 0 ? (sk <= tq) : (sk >= tq); at[r] = keep ? at[r] : 0.f; } \
                _Pragma("unroll") for (int sk = 0; sk < 2; ++sk) { const int r0 = 32 * st + 16 * sk + 4 * hi; const bf16x8 pp = pack_acc8(at, sk); \
                    _Pragma("unroll") for (int vt = 0; vt < 2; ++vt) { const bf16x8 a = cat8(tr_read(vb + r0 * 144 + vt * 64), tr_read(vb + (r0 + 8) * 144 + vt * 64)); o[vt][tt] = MFMA32(a, pp, o[vt][tt]); } } } \
            _Pragma("unroll") for (int vt = 0; vt < 2; ++vt) _Pragma("unroll") for (int s = 0; s < 2; ++s) o[vt][tt] = MFMA32(sf[vt][s], qf[s], o[vt][tt]); }
    u32x2 oq0[8], ok0[8], oq1[8], ok1[8];
    GO_PREP(la0, oq0, ok0);
    GO_PUT(oq0, ok0);
    GO_PREP(la1, oq1, ok1);
    GO_SF(sp0);
    LDSW_WAIT();
    GO_MMA(0);
    LDSW_WAIT();
    GO_PUT(oq1, ok1);
    GO_SF(sp1);
    int le = lane; asm volatile("" : "+v"(le));
    u32x4 gq[8];
#pragma unroll
    for (int i = 0; i < 8; ++i) gq[i] = *(const u32x4*)(z0 + (size_t)((le >> 3) + 8 * i) * ZLD + 2560 + h * 64 + 8 * (le & 7));
    LDSW_WAIT();
    GO_MMA(1);
#undef GO_PREP
#undef GO_PUT
#undef GO_SF
#undef GO_MMA
    LDSW_WAIT();
    {
#pragma unroll
        for (int i = 0; i < 8; ++i) *(LAS u32x4*)(Vw + ((le >> 3) + 8 * i) * 144 + (le & 7) * 16) = gq[i];
        LDSW_WAIT();
        float rinv[2];
#pragma unroll
        for (int tt = 0; tt < 2; ++tt) {
            float ss = 0.f;
#pragma unroll
            for (int vt = 0; vt < 2; ++vt)
#pragma unroll
                for (int r = 0; r < 16; ++r) ss += o[vt][tt][r] * o[vt][tt][r];
            ss += __shfl_xor(ss, 32);
            rinv[tt] = rsqrtf(ss * (1.f / 64.f) + EPS);
        }
#pragma unroll
        for (int vt = 0; vt < 2; ++vt)
#pragma unroll
            for (int r4 = 0; r4 < 4; ++r4) { const int v = 32 * vt + 8 * r4 + 4 * hi;
                const f32x4 nw = *(const f32x4*)(W.prm + PRM_GNW + layer * 256 + h * 64 + v);
#pragma unroll
                for (int tt = 0; tt < 2; ++tt) { LAS unsigned char* rowp = Vw + (32 * tt + l31) * 144;
                    const u32x2 gz = *(const LAS u32x2*)(rowp + v * 2);
                    const float a0 = o[vt][tt][4 * r4] * rinv[tt] * nw[0] * silu_f(bflo(gz.x)), a1 = o[vt][tt][4 * r4 + 1] * rinv[tt] * nw[1] * silu_f(bfhi(gz.x));
                    const float a2 = o[vt][tt][4 * r4 + 2] * rinv[tt] * nw[2] * silu_f(bflo(gz.y)), a3 = o[vt][tt][4 * r4 + 3] * rinv[tt] * nw[3] * silu_f(bfhi(gz.y));
                    u32x2 w; w.x = pk2(a0, a1); w.y = pk2(a2, a3);
                    *(LAS u32x2*)(rowp + v * 2) = w; }
                __builtin_amdgcn_sched_barrier(0); }
        LDSW_WAIT();
#pragma unroll
        for (int i = 0; i < 8; ++i) { const int tr = (le >> 3) + 8 * i;
            *(u32x4*)(W.Y + (size_t)(row0 + tr) * 1024 + 768 + h * 64 + 8 * (le & 7)) = *(const LAS u32x4*)(Vw + tr * 144 + (le & 7) * 16); }
    }
    asm volatile("" :: "v"(pf0), "v"(pf1));
}

#if (PROBE_PH >= 21 && PROBE_PH <= 23) || PROBE_PH == 41 || PROBE_PH == 42
#define ATT_PROBE_ARG , unsigned long long& g_probe_acc
#define ATT_PROBE_PASS , g_probe_acc
#else
#define ATT_PROBE_ARG
#define ATT_PROBE_PASS
#endif
constexpr float ATT_PMAX = 65536.f;
struct AttPre { u32x4 q[8]; u32x4 k0, v0, k1, v1; };
__device__ __forceinline__ void att_prefetch(const WS& W, int b, int g, int qb, bool isctx, int tid, AttPre& pre) {
    const int lane = tid & 63, wave = tid >> 6, head = g * 4 + (wave >> 1);
    const int seqbase = isctx ? ML + b * NCTX : b * SEQ, tq0 = qb * 128 + (wave & 1) * 64;
#pragma unroll
    for (int i = 0; i < 8; ++i) { const int qr = (lane >> 3) + 8 * i, cq = lane & 7;
        pre.q[i] = *(const u32x4*)(W.Z + (size_t)(seqbase + tq0 + qr) * ZLD + 768 + 256 * (head >> 2) + 128 * (cq >> 2) + 32 * (head & 3) + 8 * (cq & 3)); }
    const int kvr = tid >> 3, ch = tid & 7;
    const bf16_t* src = W.Z + (size_t)(ML + b * NCTX + kvr) * ZLD + 1280 + 128 * (ch >> 2) + 32 * g + 8 * (ch & 3);
    pre.k0 = *(const u32x4*)src; pre.v0 = *(const u32x4*)(src + 64); pre.k1 = *(const u32x4*)(src + (size_t)64 * ZLD); pre.v1 = *(const u32x4*)(src + (size_t)64 * ZLD + 64);
}
__device__ __forceinline__ void attn_unit(const Params& p, const WS& W, int layer, int b, int g, int qb, bool isctx, LAS unsigned char* lds, AttPre& pre, bool has_next, int nb, int ng, int nqb ATT_PROBE_ARG) {
    int tid_ = threadIdx.x; asm volatile("" : "+v"(tid_)); const int tid = tid_, lane = tid & 63, wave = __builtin_amdgcn_readfirstlane(tid >> 6);
#if PROBE_PH == 41 || PROBE_PH == 42
    const unsigned long long tu0 = __builtin_amdgcn_s_memrealtime();
#endif
    const int l31 = lane & 31, hi = lane >> 5, i16 = lane & 15, gi = (lane >> 4) & 1;
    const int head = g * 4 + (wave >> 1);
    const int seqbase = isctx ? ML + b * NCTX : b * SEQ;
    const int q0 = qb * 128, tq0 = q0 + (wave & 1) * 64;
    constexpr int KB = 64 * 144, VB = 64 * 192, STG = KB + VB;
    LAS unsigned char* Qw = lds + 3 * STG + wave * 9216;
#pragma unroll
    for (int i = 0; i < 8; ++i) { const int qr = (lane >> 3) + 8 * i, cq = lane & 7; *(LAS u32x4*)(Qw + qr * 144 + cq * 16) = pre.q[i]; }
    const float pfg = PROBE_PH >= 0 ? 0.f : __uint_as_float(*(const unsigned*)(W.Z + (size_t)(seqbase + tq0 + lane) * ZLD + 1536 + head * 64));
    const int jlo = isctx ? 0 : (qb == 0 ? 2 : 0), jhi = isctx ? -1 : (qb == 31 ? 3 : 5);
    const int NT = 4 + (jhi - jlo + 1);
    const int kvr = tid >> 3, ch = tid & 7;
    const int gcolK = 1280 + 128 * (ch >> 2) + 32 * g + 8 * (ch & 3);
    const int ctxbase = ML + b * NCTX;
    const float sink2 = W.prm[PRM_SINK + layer * 8 + head] * LOG2E;
    float mref[2] = {sink2, sink2}, lsum[2] = {hi == 0 ? 1.f : 0.f, hi == 0 ? 1.f : 0.f};
    f32x16 negm[2];
#pragma unroll
    for (int r = 0; r < 16; ++r) { negm[0][r] = -sink2; negm[1][r] = -sink2; }
    asm volatile("" : "+v"(negm[0]), "+v"(negm[1]));
    f32x16 O[2][2];
#pragma unroll
    for (int dt = 0; dt < 2; ++dt)
#pragma unroll
        for (int ct = 0; ct < 2; ++ct) O[dt][ct] = (f32x16){};
    u32x4 kregA, vregA;
#define ATT_KROW(ti) ((ti) < 4 ? ctxbase + 64 * (ti) : b * SEQ + q0 - 128 + 64 * (jlo + (ti) - 4))
#define ATT_LOADR(ti, R) do { const bf16_t* src_ = W.Z + (size_t)(ATT_KROW(ti) + kvr) * ZLD + gcolK; kreg##R = *(const u32x4*)src_; vreg##R = *(const u32x4*)(src_ + 64); } while (0)
#define ATT_STORER(st, R) do { *(LAS u32x4*)(lds + (st) * STG + kvr * 144 + ch * 16) = kreg##R; *(LAS u32x4*)(lds + (st) * STG + KB + kvr * 192 + ch * 16) = vreg##R; } while (0)
    const int wh = wave & 1;
    const int sA = isctx ? 0 : jlo, eA = isctx ? -1 : (jhi < 4 ? jhi : 4), sB = isctx ? 0 : (jlo > 1 ? jlo : 1), eB = jhi;
    const int NLS = isctx ? 0 : ((eA - sA > eB - sB ? eA - sA : eB - sB) + 1);
    const int NS = 4 + NLS;
    const int s_h = wh ? sB : sA, e_h = wh ? eB : eA;
    kregA = pre.k0; vregA = pre.v0; ATT_STORER(0, A);
    kregA = pre.k1; vregA = pre.v1; ATT_STORER(1, A);
    ATT_LOADR(2, A);
    __syncthreads();
#if PROBE_PH == 41
    if (layer == 1) g_probe_acc += __builtin_amdgcn_s_memrealtime() - tu0;
#endif
    for (int t2 = 0; t2 < NS; ++t2) {
        { const int TI_ = t2 < 4 ? t2 : 4 + (s_h + (t2 - 4) - jlo);
          const int st = TI_ % 3;
#if PROBE_PH >= 21 && PROBE_PH <= 23
        const unsigned long long ts0 = __builtin_amdgcn_s_memrealtime();
#endif
        bool active = true, need_mask = false; int k0 = 0;
        if (t2 >= 4) { const int j_ = s_h + (t2 - 4); k0 = q0 - 128 + 64 * j_; active = j_ <= e_h; need_mask = !((k0 >= tq0 - 65) && (k0 <= tq0 + 65)); }
        if (active) {
            const LAS unsigned char* Kb = lds + st * STG; const LAS unsigned char* Vbp = Kb + KB;
            f32x16 s[2][2];
#pragma unroll
            for (int ds = 0; ds < 4; ++ds) {
                const bf16x8 q0f = *(const LAS bf16x8*)(Qw + l31 * 144 + (2 * ds + hi) * 16), q1f = *(const LAS bf16x8*)(Qw + (32 + l31) * 144 + (2 * ds + hi) * 16);
#pragma unroll
                for (int rt = 0; rt < 2; ++rt) { const bf16x8 kf = *(const LAS bf16x8*)(Kb + (32 * rt + l31) * 144 + (2 * ds + hi) * 16);
                    s[rt][0] = MFMA32(kf, q0f, ds == 0 ? negm[0] : s[rt][0]); s[rt][1] = MFMA32(kf, q1f, ds == 0 ? negm[1] : s[rt][1]); }
            }
            if (need_mask) {
#pragma unroll
                for (int rt = 0; rt < 2; ++rt)
#pragma unroll
                    for (int ct = 0; ct < 2; ++ct)
#pragma unroll
                        for (int r = 0; r < 16; ++r) { const int kp = k0 + 32 * rt + (r & 3) + 8 * (r >> 2) + 4 * hi, qp = tq0 + 32 * ct + l31; const int dd = qp - kp;
                            if (dd > 128 || dd < -128) s[rt][ct][r] = -1e30f; }
            }
            float ls[2];
#pragma unroll
            for (int ct = 0; ct < 2; ++ct) {
#pragma unroll
                for (int rt = 0; rt < 2; ++rt)
#pragma unroll
                    for (int r = 0; r < 16; ++r) s[rt][ct][r] = __builtin_amdgcn_exp2f(s[rt][ct][r]);
                float a_ = s[0][ct][0] + s[0][ct][1], b_ = s[1][ct][0] + s[1][ct][1];
                asm("" : "+v"(a_)); asm("" : "+v"(b_));
#pragma unroll
                for (int r = 2; r < 16; ++r) { a_ += s[0][ct][r]; asm("" : "+v"(a_)); b_ += s[1][ct][r]; asm("" : "+v"(b_)); }
                ls[ct] = a_ + b_;
            }
            if (__builtin_expect(__any((ls[0] > ATT_PMAX) || (ls[1] > ATT_PMAX)), 0)) {
#pragma unroll
                for (int ct = 0; ct < 2; ++ct) {
                    float m_ = s[0][ct][0];
#pragma unroll
                    for (int r = 1; r < 16; ++r) m_ = fmaxf(m_, s[0][ct][r]);
#pragma unroll
                    for (int r = 0; r < 16; ++r) m_ = fmaxf(m_, s[1][ct][r]);
                    m_ = fmaxf(m_, __shfl_xor(m_, 32));
                    const float d_ = fmaxf(__builtin_amdgcn_logf(m_), 0.f); mref[ct] += d_; const float al = __builtin_amdgcn_exp2f(-d_);
#pragma unroll
                    for (int rt = 0; rt < 2; ++rt) s[rt][ct] = s[rt][ct] * al;
                    ls[ct] *= al; lsum[ct] *= al;
#pragma unroll
                    for (int dt = 0; dt < 2; ++dt) O[dt][ct] = O[dt][ct] * al;
#pragma unroll
                    for (int r = 0; r < 16; ++r) negm[ct][r] = -mref[ct];
                }
            }
            lsum[0] += ls[0]; lsum[1] += ls[1];
            const LAS unsigned char* vb = Vbp + (i16 >> 2) * 192 + (16 * gi + 4 * (i16 & 3)) * 2;
#pragma unroll
            for (int rt = 0; rt < 2; ++rt)
#pragma unroll
                for (int sk = 0; sk < 2; ++sk) {
                    const bf16x8 p0 = pack_acc8(s[rt][0], sk), p1 = pack_acc8(s[rt][1], sk);
                    const int r0 = 32 * rt + 16 * sk + 4 * hi;
#pragma unroll
                    for (int dt = 0; dt < 2; ++dt) { const bf16x8 vf = cat8(tr_read(vb + r0 * 192 + dt * 64), tr_read(vb + (r0 + 8) * 192 + dt * 64));
                        O[dt][0] = MFMA32(vf, p0, O[dt][0]); O[dt][1] = MFMA32(vf, p1, O[dt][1]); }
                }
        }
#if PROBE_PH >= 21 && PROBE_PH <= 23
        __builtin_amdgcn_sched_barrier(0); const unsigned long long ts1 = __builtin_amdgcn_s_memrealtime(); __builtin_amdgcn_sched_barrier(0);
#endif
        if (t2 + 2 < NT) ATT_STORER((t2 + 2) % 3, A);
        if (t2 + 3 < NT) ATT_LOADR(t2 + 3, A);
#if PROBE_PH >= 21 && PROBE_PH <= 23
        asm volatile("s_waitcnt lgkmcnt(0)" ::: "memory"); __builtin_amdgcn_sched_barrier(0); const unsigned long long ts2 = __builtin_amdgcn_s_memrealtime(); __builtin_amdgcn_sched_barrier(0);
#endif
        __syncthreads();
#if PROBE_PH >= 21 && PROBE_PH <= 23
        { const unsigned long long ts3 = __builtin_amdgcn_s_memrealtime(); if (layer == 1) g_probe_acc += (PROBE_PH == 21 ? ts1 - ts0 : PROBE_PH == 22 ? ts2 - ts1 : ts3 - ts2); }
#endif
        }
    }
#undef ATT_KROW
#undef ATT_LOADR
#undef ATT_STORER
#if PROBE_PH == 42
    const unsigned long long tu1 = __builtin_amdgcn_s_memrealtime();
#endif
    if (has_next) att_prefetch(W, nb, ng, nqb, false, tid, pre);
    {
        int le = lane; asm volatile("" : "+v"(le));
        u32x4 gq[8];
#pragma unroll
        for (int i = 0; i < 8; ++i) gq[i] = *(const u32x4*)(W.Z + (size_t)(seqbase + tq0 + (le >> 3) + 8 * i) * ZLD + 1536 + head * 64 + 8 * (le & 7));
#pragma unroll
        for (int i = 0; i < 8; ++i) *(LAS u32x4*)(Qw + ((le >> 3) + 8 * i) * 144 + (le & 7) * 16) = gq[i];
        asm volatile("s_waitcnt lgkmcnt(0)" ::: "memory");
#pragma unroll
        for (int ct = 0; ct < 2; ++ct) {
            const float lt = lsum[ct] + __shfl_xor(lsum[ct], 32); const float inv = __builtin_amdgcn_rcpf(lt);
            LAS unsigned char* rowp = Qw + (32 * ct + l31) * 144;
#pragma unroll
            for (int dt = 0; dt < 2; ++dt)
#pragma unroll
                for (int r4 = 0; r4 < 4; ++r4) { const int d = 32 * dt + 8 * r4 + 4 * hi;
                    const u32x2 gz = *(const LAS u32x2*)(rowp + d * 2);
                    const float a0 = O[dt][ct][4 * r4] * inv * silu_f(bflo(gz.x)), a1 = O[dt][ct][4 * r4 + 1] * inv * silu_f(bfhi(gz.x));
                    const float a2 = O[dt][ct][4 * r4 + 2] * inv * silu_f(bflo(gz.y)), a3 = O[dt][ct][4 * r4 + 3] * inv * silu_f(bfhi(gz.y));
                    u32x2 w; w.x = pk2(a0, a1); w.y = pk2(a2, a3);
                    *(LAS u32x2*)(rowp + d * 2) = w; }
        }
        asm volatile("s_waitcnt lgkmcnt(0)" ::: "memory");
#pragma unroll
        for (int i = 0; i < 8; ++i) { const int qr = (le >> 3) + 8 * i;
            *(u32x4*)(W.Y + (size_t)(seqbase + tq0 + qr) * 1024 + 256 + head * 64 + 8 * (le & 7)) = *(const LAS u32x4*)(Qw + qr * 144 + (le & 7) * 16); }
    }
    asm volatile("" :: "v"(pfg));
#if PROBE_PH == 42
    asm volatile("s_waitcnt vmcnt(0)" ::: "memory"); if (layer == 1) g_probe_acc += __builtin_amdgcn_s_memrealtime() - tu1;
#endif
}

__device__ __forceinline__ void phase_final(const Params& p, const WS& W) {
    int tid_ = threadIdx.x; asm volatile("" : "+v"(tid_)); const int tid = tid_, lane = tid & 63, wave = tid >> 6;
    const int gw = blockIdx.x * 8 + wave, NGW = gridDim.x * 8;
    f32x4 fw[4];
#pragma unroll
    for (int j = 0; j < 4; ++j) fw[j] = *(const f32x4*)(p.final_norm_w + j * 256 + lane * 4);
    for (int row = gw; row < ML; row += NGW) {
        const float rinv = rsqrtf(W.rss2[row] * (1.f / 1024.f) + EPS);
        float* xr = p.out + (size_t)row * 1024;
#pragma unroll
        for (int j = 0; j < 4; ++j) { const f32x4 v = *(const f32x4*)(xr + j * 256 + lane * 4); *(f32x4*)(xr + j * 256 + lane * 4) = v * rinv * fw[j]; }
    }
}

__device__ __forceinline__ int q_next(unsigned* ctr, volatile LAS unsigned* slot) {
    __syncthreads();
    if (threadIdx.x == 0) *slot = __hip_atomic_fetch_add(ctr, 1u, __ATOMIC_RELAXED, __HIP_MEMORY_SCOPE_AGENT);
    __syncthreads();
    return (int)*slot;
}
#define QCTR(k) ((unsigned*)(wsb + WS_CTL) + 4096 + 64 * (k))

__global__ void __launch_bounds__(512, 2) fwd_kernel(Params p) {
    extern __shared__ __attribute__((aligned(16))) unsigned char lds_raw[];
    LAS unsigned char* lds = (LAS unsigned char*)lds_raw;
    const int G = gridDim.x;
    volatile LAS unsigned* bst = (volatile LAS unsigned*)(lds + CTLW_OFF + 512);
    if (threadIdx.x < 2) bst[threadIdx.x] = 0u;
    __syncthreads();
    XcdBarrier xbar = xcd_barrier_post((unsigned*)(p.ws + WS_CTL), bst);
    volatile LAS unsigned* qslot = (volatile LAS unsigned*)(lds + CTLW_OFF + 640);
#if PROBE_PH >= 0
    volatile LAS unsigned long long* tps = (volatile LAS unsigned long long*)(lds + CTLW_OFF + 768); if (threadIdx.x < 4) tps[threadIdx.x] = 0ull;
    unsigned long long g_probe_acc = 0;
#endif
    for (int ph = p.ph_lo; ph < p.ph_hi; ++ph) {
        if (ph > p.ph_lo && !(MERGE12 && ph >= 2 && (ph - 2) % 5 == 2)) {
#if USE_CG_SYNC
            cg::this_grid().sync();
#else
            xcd_barrier(xbar);
#if DUP_SUB == 30
            xcd_barrier(xbar); xcd_barrier(xbar); xcd_barrier(xbar); xcd_barrier(xbar);
#endif
#endif
        }
#if PROBE_PH >= 0
        if (threadIdx.x == 0) { if (ph == (PROBE_PH == 34 ? 9 : PROBE_PH)) tps[0] = __builtin_amdgcn_s_memrealtime(); if (ph == PROBE_PH + 1) tps[1] = __builtin_amdgcn_s_memrealtime(); }
#if PROBE_PH == 50
        if (threadIdx.x == 0) tps[3] = (unsigned long long)ph;
        __syncthreads();
#endif
#endif
        size_t zoff = 0; asm volatile("" : "+s"(zoff)); unsigned char* wsb = p.ws + zoff;
        int bx = blockIdx.x; asm volatile("" : "+s"(bx));
        const WS W = make_ws(wsb);
        if (RUNSUB(10) && ph == 0) { for (int rep = 0; rep < NREP(10); ++rep) { phase_prep0(p, W, lds); __syncthreads(); } }
        else if (RUNSUB(11) && ph == 1) { for (int rep = 0; rep < NREP(11); ++rep) phase_prep1(p, W); }
        else if (ph >= 2 && ph < 12) {
            const int layer = (ph - 2) / 5, sub = (ph - 2) % 5;
            if (RUNSUB(0) && sub == 0) {
                unsigned* gate_cnt = (unsigned*)(wsb + WS_CTL) + 4096 + 64 * 40;
                { int tr_ = threadIdx.x; asm volatile("" : "+v"(tr_)); *(LAS f32x4*)(lds + 131072 + 16 * tr_) = *(const f32x4*)(W.rope + 4 * tr_); }
                if (layer == 1 && bx >= G - 32) {
                    const int ci = bx - (G - 32);
                    pg8::Gemm gmo{W.Y, W.WoutT, MT, 1024, 1024}; pg8::OneUnit S1{128 + (ci >> 2), ci & 3, gate_cnt};
                    pg8::EpiOut Eo{p.x, p.ctx, (bf16_t*)(wsb + WS_X1H), W.modv, W.modv + 9 * 3072, W.A, W.rss1};
                    pg8::gemm_phase<pg8::EpiOut, pg8::OneUnit, true, true>(lds, gmo, S1, Eo);
                }
                pg8::Gemm gm{W.A, W.WinT + (size_t)layer * NPAD * 1024, MT, NPAD, 1024}; pg8::GatedOrder S; S.init(MT, NPAD, G, bx); S.pm_gate = layer == 1 ? 128 : (1 << 30); S.cnt = gate_cnt; S.need = 256u;
                pg8::EpiIn E{W.Z, W.LA, layer == 0 ? W.rss0 : W.rss1, W.biasz + layer * 9 * NPAD, (const LAS float*)(lds + 131072)};
                S.nfull = layer == 0 ? 6 : 5; S.nextra = layer == 0 ? 0 : G - 32;
                if (layer == 0 && bx >= 192) {
                    int tw_ = threadIdx.x; asm volatile("" : "+v"(tw_)); bias1_tasks(p, W, (bx - 192) * 8 + (tw_ >> 6), (G - 192) * 8, tw_ & 63); }
                pg8::gemm_phase<pg8::EpiIn, pg8::GatedOrder, true, true>(lds, gm, S, E);
            } else if (sub == 1) {
                { int tw_ = threadIdx.x; asm volatile("" : "+v"(tw_)); const int lane = tw_ & 63, wv = __builtin_amdgcn_readfirstlane(tw_ >> 6);
                  if (RUNSUB(5)) for (int rep = 0; rep < NREP(5); ++rep) _Pragma("unroll 1") for (int it = 0, u; it < 2 && (u = it == 0 ? bx * 8 + wv : (wv == 0 && bx < 128 ? 2048 + bx : 1 << 30)) < 2176; ++it) { if (u < 2048) gla_state_wave(W, u >> 8, false, (u >> 2) & 63, u & 3, lds + wv * WREG, lane); else { const int v = u - 2048; gla_state_wave(W, v >> 4, true, (v >> 2) & 3, v & 3, lds + wv * WREG, lane); } }
                }
                if (MERGE12) {
                    asm volatile("s_waitcnt vmcnt(0)" ::: "memory"); __syncthreads();
                    if (threadIdx.x == 0) { __builtin_amdgcn_fence(__ATOMIC_RELEASE, "agent"); __hip_atomic_fetch_add(QCTR(44 + layer), 1u, __ATOMIC_RELAXED, __HIP_MEMORY_SCOPE_AGENT); }
                } else __syncthreads();
                if (RUNSUB(1)) for (int rep = 0; rep < NREP(1); ++rep) for (int u = bx; u < 512; u += G) conv_unit(p, W, layer, u >> 6, u & 63, lds);
            } else if (sub == 2) {
                const int natt = layer == 0 ? 576 : 512;
                if (RUNSUB(2)) {
                    int ta_ = threadIdx.x; asm volatile("" : "+v"(ta_));
                    AttPre pre;
                    for (int u = 2 * bx; u < 512; u += 2 * G) {
                        att_prefetch(W, u >> 6, (u >> 5) & 1, u & 31, false, ta_, pre);
#if PROBE_PH >= 31 && PROBE_PH <= 34
                        const unsigned long long tq0_ = __builtin_amdgcn_s_memrealtime();
#endif
                        attn_unit(p, W, layer, u >> 6, (u >> 5) & 1, u & 31, false, lds, pre, true, (u + 1) >> 6, ((u + 1) >> 5) & 1, (u + 1) & 31 ATT_PROBE_PASS);
#if PROBE_PH == 31
                        if (layer == 1) g_probe_acc = __builtin_amdgcn_s_memrealtime() - tq0_;
#endif
                        attn_unit(p, W, layer, (u + 1) >> 6, ((u + 1) >> 5) & 1, (u + 1) & 31, false, lds, pre, false, 0, 0, 0 ATT_PROBE_PASS);
#if PROBE_PH == 32
                        if (layer == 1) g_probe_acc = __builtin_amdgcn_s_memrealtime() - tq0_;
#endif
#if PROBE_PH >= 33 && PROBE_PH <= 34
                        if (layer == 1) g_probe_acc = tq0_;
#endif
                    }
                    for (int u; (u = q_next(QCTR(layer * 4 + 2), qslot)) < natt - 512 + 128;) {
                        if (u >= natt - 512) {
                            if (MERGE12) {
                                if (threadIdx.x < 64) { unsigned sp_ = 0;
                                    while ((unsigned)__builtin_amdgcn_readfirstlane(__hip_atomic_load(QCTR(44 + layer), __ATOMIC_RELAXED, __HIP_MEMORY_SCOPE_AGENT)) < (unsigned)G) { __builtin_amdgcn_s_sleep(2); if (++sp_ > (1u << 22)) break; }
                                    __builtin_amdgcn_fence(__ATOMIC_ACQUIRE, "agent"); asm volatile("s_waitcnt vmcnt(0)" ::: "memory"); }
                                __syncthreads();
                            }
                            gla_scan(W, u - (natt - 512)); }
                        else if (u < 32) { att_prefetch(W, u >> 2, (u >> 1) & 1, u & 1, true, ta_, pre); attn_unit(p, W, layer, u >> 2, (u >> 1) & 1, u & 1, true, lds, pre, false, 0, 0, 0 ATT_PROBE_PASS); }
                        else { const int v = u - 32; conv_unit(p, W, layer, 8 + (v >> 2), v & 3, lds); } }
#if PROBE_PH == 33
                    if (layer == 1) g_probe_acc = __builtin_amdgcn_s_memrealtime() - g_probe_acc;
#endif
                }
            } else if (sub == 3) {
                const int nu = layer == 0 ? 2176 : 2048;
                { int tw_ = threadIdx.x; asm volatile("" : "+v"(tw_)); const int lane = tw_ & 63, wv = __builtin_amdgcn_readfirstlane(tw_ >> 6);
                  if (RUNSUB(3)) for (int rep = 0; rep < NREP(3); ++rep) _Pragma("unroll 1") for (int it = 0, u; it < 2 && (u = it == 0 ? bx * 8 + wv : (wv == 0 && bx < 128 ? 2048 + bx : 1 << 30)) < nu; ++it) { if (u < 2048) gla_out_wave(p, W, layer, u >> 8, false, (u >> 2) & 63, u & 3, lds + wv * WREG, lane); else { const int v = u - 2048; gla_out_wave(p, W, layer, v >> 4, true, (v >> 2) & 3, v & 3, lds + wv * WREG, lane); } } }
            } else {
                if (!RUNSUB(4) && !RUNSUB(6)) {} else if (layer == 0) {
                    if (RUNSUB(4)) {
                    pg8::Gemm gm{W.Y, W.WoutT, ML, 1024, 1024}; pg8::StaticOrder S; S.init(ML, 1024, G, bx);
                    pg8::EpiOut E{p.x, p.ctx, (bf16_t*)(wsb + WS_X1H), W.modv, W.modv + 9 * 3072, W.A, W.rss1};
                    pg8::gemm_phase<pg8::EpiOut, pg8::StaticOrder, true, true>(lds, gm, S, E); }
                } else if (RUNSUB(6)) {
                    pg8::Gemm gm{W.Y, W.WoutT + (size_t)1024 * 1024, ML, 1024, 1024}; pg8::StaticOrder S; S.init(ML, 1024, G, bx);
                    pg8::EpiOutFin E{(const bf16_t*)(wsb + WS_X1H), p.out, W.modv + 9 * 3072, W.prm + PRM_FNW, W.rss2, (unsigned*)(wsb + WS_CTL) + 8192, (LAS unsigned*)(lds + CTLW_OFF + 576)};
                    pg8::gemm_phase<pg8::EpiOutFin, pg8::StaticOrder, true, true>(lds, gm, S, E);
                }
            }
        }
    }
#if PROBE_PH >= 0
    xcd_barrier(xbar);
    { if (threadIdx.x == 0 && tps[1] == 0ull) tps[1] = __builtin_amdgcn_s_memrealtime();
      __syncthreads();
      const float dlt = PROBE_PH == 50 ? (float)tps[2] * 1e-6f : (PROBE_PH >= 21 && PROBE_PH <= 42) ? (float)g_probe_acc * 1e-6f : (float)(tps[1] - tps[0]) * 1e-6f;
      for (size_t i = (size_t)blockIdx.x * 512 + threadIdx.x; i < (size_t)ML * 1024 / 4; i += (size_t)gridDim.x * 512) { f32x4 v = ((f32x4*)p.out)[i]; v = v + dlt; ((f32x4*)p.out)[i] = v; } }
#endif
}

extern "C" void kernel_launch(void* const* d_in, const int* in_sizes, int n_in, void* d_out, int out_size, void* d_ws, size_t ws_size, hipStream_t stream) {
    static int grid = 0;
    if (grid == 0) {
        if (n_in != 17 || out_size != ML * D || ws_size < WS_END) { fprintf(stderr, "kernel_launch: unexpected shapes (n_in %d, out %d, ws %zu)\n", n_in, out_size, ws_size); grid = -1; return; }
        int dev = 0, cus = 0, per_cu = 0;
        hipGetDevice(&dev); hipDeviceGetAttribute(&cus, hipDeviceAttributeMultiprocessorCount, dev);
        hipFuncSetAttribute((const void*)fwd_kernel, hipFuncAttributeMaxDynamicSharedMemorySize, LDS_BYTES);
        hipOccupancyMaxActiveBlocksPerMultiprocessor(&per_cu, (const void*)fwd_kernel, 512, LDS_BYTES);
        if (per_cu < 1) { fprintf(stderr, "kernel_launch: occupancy query says %d blocks/CU\n", per_cu); per_cu = 1; }
        (void)hipGetLastError();
        grid = cus;
    }
    if (grid < 0) return;
    Params p{};
    p.x = (const float*)d_in[0]; p.c = (const float*)d_in[1]; p.ctx = (const float*)d_in[2]; p.c_ctx = (const float*)d_in[3]; p.w_mod = (const float*)d_in[4]; p.b_mod = (const float*)d_in[5];
    p.w_in = (const float*)d_in[6]; p.conv_w = (const float*)d_in[7]; p.conv_b = (const float*)d_in[8]; p.conv_ln_w = (const float*)d_in[9]; p.conv_ln_b = (const float*)d_in[10];
    p.attn_sink = (const float*)d_in[11]; p.gla_w_up = (const float*)d_in[12]; p.gla_b_up = (const float*)d_in[13]; p.gla_norm_w = (const float*)d_in[14]; p.w_out = (const float*)d_in[15];
    p.final_norm_w = (const float*)d_in[16]; p.out = (float*)d_out; p.ws = (unsigned char*)d_ws;
    if (hipMemsetAsync((char*)d_ws + WS_CTL, 0, 65536, stream) != hipSuccess) { fprintf(stderr, "kernel_launch: memset failed\n"); return; }
#if MK_MULTI
    for (int ph = 0; ph < NPHASE; ++ph) { p.ph_lo = ph; p.ph_hi = ph + 1; hipLaunchKernelGGL(fwd_kernel, dim3(grid), dim3(512), LDS_BYTES, stream, p); }
#else
    p.ph_lo = 0; p.ph_hi = NPHASE;
    void* args[] = {&p};
    hipError_t e = hipLaunchCooperativeKernel((void*)fwd_kernel, dim3(grid), dim3(512), args, LDS_BYTES, stream);
    if (e != hipSuccess) fprintf(stderr, "cooperative launch failed: %s (grid %d)\n", hipGetErrorString(e), grid);
#endif
}
```

```cpp
#include <hip/hip_runtime.h>
#include <hip/hip_cooperative_groups.h>
#include <cstdio>
#include <cstdint>
namespace cg = cooperative_groups;
namespace pg8 {
#define PG8_LAS __attribute__((address_space(3)))
typedef unsigned short bf16_t;
typedef short bf16x8 __attribute__((ext_vector_type(8)));
typedef float f32x4 __attribute__((ext_vector_type(4)));
typedef unsigned u32x4 __attribute__((ext_vector_type(4)));
constexpr int BM = 256, BK = 64, HALF = 128, HTB = HALF * BK * 2  , STAGE_BYTES = 8 * HTB, NXCD = 8, WGM = 2;

__host__ __device__ __forceinline__ int lds_byte(int r, int c) { const int st = (r >> 4) * 2 + (c >> 5), rr = r & 15, cc = c & 31, ob = rr * 64 + cc * 2; return st * 1024 + (ob ^ (((ob >> 9) & 1) << 5)); }
__host__ __device__ __forceinline__ void stage_rc(int b, int& R, int& C) { const int st = b / 1024, sb = b % 1024, swz = sb ^ (((sb >> 9) & 1) << 5); R = (st >> 1) * 16 + swz / 64; C = (st & 1) * 32 + (swz % 64) / 2; }
__host__ __device__ __forceinline__ int perm32(int rho) { const int n = rho >> 4, i = rho & 15; return 8 * (i >> 2) + 4 * n + (i & 3); }

struct Unit { int pm, pn, half; };
struct Gemm { const bf16_t* A; const bf16_t* Bt; int M, N, K; };

struct StaticOrder {
    int nM, nN, nwg, G, c;
    __host__ __device__ void init(int M, int N, int G_, int c_) { nM = M / BM; nN = N / BM; nwg = nM * nN; G = G_; c = c_; }
    __host__ __device__ void map(long L, Unit& u) const {
        int wgid = (int)L; { const int q = nwg / NXCD, r = nwg % NXCD, xcd = wgid % NXCD, off = wgid / NXCD; wgid = (xcd < r ? xcd * (q + 1) : r * (q + 1) + (xcd - r) * q) + off; }
        const int nig = WGM * nN, gid = wgid / nig, fm = gid * WGM, gsz = (nM - fm) < WGM ? (nM - fm) : WGM;
        u.pm = fm + ((wgid % nig) % gsz); u.pn = (wgid % nig) / gsz; u.half = -1;
    }
    __host__ __device__ bool next(int i, Unit& u) const { const long L = (long)i * G + c; if (L >= nwg) return false; map(L, u); return true; }
    __device__ __forceinline__ void a_ready(const Unit&) const {}
    __device__ __forceinline__ void done(const Unit&) const {}
};
__device__ __forceinline__ unsigned cvt_pk_bf16(float lo, float hi) { unsigned r; asm volatile("v_cvt_pk_bf16_f32 %0, %1, %2" : "=v"(r) : "v"(lo), "v"(hi)); return r; }
template <class Epi, class Sched, bool ALIGN_EPI = false, bool SP2 = false>
__device__ __forceinline__ void gemm_phase(PG8_LAS unsigned char* lds, const Gemm g, const Sched& S, const Epi& E) {
    int tid_ = threadIdx.x; asm volatile("" : "+v"(tid_)); const int tid = tid_, wid = __builtin_amdgcn_readfirstlane(tid >> 6), lane = tid & 63, wr = wid >> 2, wc = wid & 3, fr = lane & 15, fq = lane >> 4;
    const int K = g.K, nt = K / BK;
    unsigned voffA[2], voffB[2];
#pragma unroll
    for (int i = 0; i < 2; ++i) { int R, C; stage_rc(tid * 16 + i * 8192, R, C); const int Rb = Epi::PERM ? ((R & ~31) + perm32(R & 31)) : R;
        voffA[i] = (unsigned)(R * K + C) * 2u; voffB[i] = (unsigned)(Rb * K + C) * 2u; }
    const size_t kstep = (size_t)(BK * 2);
    const size_t hstep = (size_t)HALF * K * 2;
    const size_t tstep = 2 * hstep;
    const unsigned ldsw = (unsigned)wid * 1024u;
    const int aoff = lds_byte(wr * 64 + fr, fq * 8), boff = lds_byte(wc * 32 + fr, fq * 8);
#define PG8_SA(b, h) (((b) * 2 + (h)) * HTB)
#define PG8_SB(b, h) ((4 + (b) * 2 + (h)) * HTB)
#define PG8_STAGE(bufoff, gbase, voff) do { _Pragma("unroll") for (int _i = 0; _i < 2; ++_i) \
        __builtin_amdgcn_global_load_lds((const unsigned*)((const char*)(gbase) + (voff)[_i]), (PG8_LAS unsigned*)(lds + (bufoff) + ldsw + _i * 8192), 16, 0, 0); } while (0)
#define PG8_LDA(dst, b, h) do { _Pragma("unroll") for (int m = 0; m < 4; ++m) _Pragma("unroll") for (int k = 0; k < 2; ++k) dst[m][k] = *(const PG8_LAS bf16x8*)(lds + PG8_SA(b, h) + aoff + m * 2048 + k * 1024); } while (0)
#define PG8_LDB(dst, b, h) do { _Pragma("unroll") for (int n = 0; n < 2; ++n) _Pragma("unroll") for (int k = 0; k < 2; ++k) dst[n][k] = *(const PG8_LAS bf16x8*)(lds + PG8_SB(b, h) + boff + n * 2048 + k * 1024); } while (0)
#define PG8_MMA(ai, bj, At, Bt) do { if (cur.half >= 0 && cur.half != (ai)) break; __builtin_amdgcn_s_setprio(1); _Pragma("unroll") for (int m = 0; m < 4; ++m) _Pragma("unroll") for (int n = 0; n < 2; ++n) _Pragma("unroll") for (int k = 0; k < 2; ++k) \
        acc[ai][bj][m][n] = __builtin_amdgcn_mfma_f32_16x16x32_bf16(Bt[n][k], At[m][k], acc[ai][bj][m][n], 0, 0, 0); __builtin_amdgcn_s_setprio(0); } while (0)
#define PG8_WAIT_V(n) asm volatile("s_waitcnt vmcnt(" #n ")" ::: "memory")
#define PG8_WAIT_L(n) asm volatile("s_waitcnt lgkmcnt(" #n ")" ::: "memory")
#define PG8_BAR __builtin_amdgcn_s_barrier()
#define PG8_SCHED __builtin_amdgcn_sched_barrier(0)
    Unit cur, nxt; int ui = 0;
    if (!S.next(0, cur)) return;
    f32x4 acc[2][2][4][2];
#pragma unroll
    for (int a = 0; a < 2; ++a)
#pragma unroll
        for (int b = 0; b < 2; ++b)
#pragma unroll
            for (int m = 0; m < 4; ++m)
#pragma unroll
                for (int n = 0; n < 2; ++n) acc[a][b][m][n] = (f32x4){0.f, 0.f, 0.f, 0.f};
    bf16x8 At[4][2], B0[2][2], B1[2][2];
    const char* cA = (const char*)g.A + (size_t)cur.pm * tstep; const char* cB = (const char*)g.Bt + (size_t)cur.pn * tstep;
    S.a_ready(cur);
    if constexpr (SP2) {
        PG8_STAGE(PG8_SB(0, 0), cB, voffB); PG8_STAGE(PG8_SB(0, 1), cB + hstep, voffB); PG8_STAGE(PG8_SA(0, 0), cA, voffA); PG8_STAGE(PG8_SA(0, 1), cA + hstep, voffA);
        if (wr == 1) PG8_BAR;
        PG8_WAIT_V(2); PG8_BAR;
        PG8_STAGE(PG8_SB(1, 0), cB + kstep, voffB); PG8_STAGE(PG8_SA(1, 0), cA + kstep, voffA); PG8_STAGE(PG8_SB(1, 1), cB + hstep + kstep, voffB);
        PG8_WAIT_V(6); PG8_BAR;
    } else {
        PG8_STAGE(PG8_SB(0, 0), cB, voffB); PG8_STAGE(PG8_SA(0, 0), cA, voffA); PG8_STAGE(PG8_SB(0, 1), cB + hstep, voffB); PG8_STAGE(PG8_SA(0, 1), cA + hstep, voffA);
        if (wr == 1) PG8_BAR;
        PG8_WAIT_V(4); PG8_BAR;
        PG8_STAGE(PG8_SB(1, 0), cB + kstep, voffB); PG8_STAGE(PG8_SA(1, 0), cA + kstep, voffA); PG8_STAGE(PG8_SB(1, 1), cB + hstep + kstep, voffB);
        PG8_WAIT_V(6); PG8_BAR;
    }
    for (;;) {
        const bool has_next = S.next(ui + 1, nxt);
        const char* nA = has_next ? (const char*)g.A + (size_t)nxt.pm * tstep : cA; const char* nB = has_next ? (const char*)g.Bt + (size_t)nxt.pn * tstep : cB;
        for (int t = 0; t < nt; t += 2) {
            const bool last = (t == nt - 2);
            const char* a1 = cA + (size_t)(t + 1) * kstep;
            const char* a2 = last ? nA : cA + (size_t)(t + 2) * kstep; const char* b2 = last ? nB : cB + (size_t)(t + 2) * kstep;
            const char* a3 = a2 + kstep; const char* b3 = b2 + kstep;
            if (last && has_next) S.a_ready(nxt);
            if constexpr (SP2) {
            PG8_LDB(B0, 0, 0); PG8_LDB(B1, 0, 1); PG8_SCHED; PG8_LDA(At, 0, 0); PG8_STAGE(PG8_SA(1, 1), a1 + hstep, voffA);
            PG8_WAIT_V(8); PG8_WAIT_L(0); PG8_BAR; PG8_MMA(0, 0, At, B0); PG8_MMA(0, 1, At, B1); PG8_BAR; PG8_SCHED;
            PG8_LDA(At, 0, 1); PG8_STAGE(PG8_SB(0, 0), b2, voffB); PG8_STAGE(PG8_SB(0, 1), b2 + hstep, voffB); PG8_STAGE(PG8_SA(0, 0), a2, voffA);
            PG8_WAIT_V(8); PG8_WAIT_L(0); PG8_BAR; PG8_MMA(1, 0, At, B0); PG8_MMA(1, 1, At, B1); PG8_BAR; PG8_SCHED;
            PG8_LDB(B0, 1, 0); PG8_LDB(B1, 1, 1); PG8_SCHED; PG8_LDA(At, 1, 0); PG8_STAGE(PG8_SA(0, 1), a2 + hstep, voffA);
            PG8_WAIT_V(8); PG8_WAIT_L(0); PG8_BAR; PG8_MMA(0, 0, At, B0); PG8_MMA(0, 1, At, B1); PG8_BAR; PG8_SCHED;
            PG8_LDA(At, 1, 1); PG8_STAGE(PG8_SB(1, 0), b3, voffB); PG8_STAGE(PG8_SB(1, 1), b3 + hstep, voffB); PG8_STAGE(PG8_SA(1, 0), a3, voffA);
            PG8_WAIT_V(8); PG8_WAIT_L(0); PG8_BAR; PG8_MMA(1, 0, At, B0); PG8_MMA(1, 1, At, B1); PG8_BAR; PG8_SCHED;
            } else {
            PG8_LDB(B0, 0, 0); PG8_SCHED; PG8_LDA(At, 0, 0); PG8_STAGE(PG8_SA(1, 1), a1 + hstep, voffA);
            PG8_WAIT_L(8); PG8_BAR; PG8_WAIT_L(0); PG8_MMA(0, 0, At, B0); PG8_BAR; PG8_SCHED;
            PG8_LDB(B1, 0, 1); PG8_STAGE(PG8_SB(0, 0), b2, voffB);
            PG8_BAR; PG8_WAIT_L(0); PG8_MMA(0, 1, At, B1); PG8_BAR;
            PG8_LDA(At, 0, 1); PG8_STAGE(PG8_SA(0, 0), a2, voffA);
            PG8_BAR; PG8_WAIT_L(0); PG8_MMA(1, 0, At, B0); PG8_BAR; PG8_SCHED;
            PG8_STAGE(PG8_SB(0, 1), b2 + hstep, voffB);
            PG8_WAIT_V(6); PG8_BAR; PG8_MMA(1, 1, At, B1); PG8_BAR;
            PG8_LDB(B0, 1, 0); PG8_SCHED; PG8_LDA(At, 1, 0); PG8_STAGE(PG8_SA(0, 1), a2 + hstep, voffA);
            PG8_WAIT_L(8); PG8_BAR; PG8_WAIT_L(0); PG8_MMA(0, 0, At, B0); PG8_BAR; PG8_SCHED;
            PG8_LDB(B1, 1, 1); PG8_STAGE(PG8_SB(1, 0), b3, voffB);
            PG8_BAR; PG8_WAIT_L(0); PG8_MMA(0, 1, At, B1); PG8_BAR;
            PG8_LDA(At, 1, 1); PG8_STAGE(PG8_SA(1, 0), a3, voffA);
            PG8_BAR; PG8_WAIT_L(0); PG8_MMA(1, 0, At, B0); PG8_BAR; PG8_SCHED;
            PG8_STAGE(PG8_SB(1, 1), b3 + hstep, voffB);
            PG8_WAIT_V(6); PG8_BAR; PG8_MMA(1, 1, At, B1); PG8_BAR;
            }
        }
        if constexpr (ALIGN_EPI) { if (wr == 0) PG8_BAR; }
#if PROBE_PH == 50
        const unsigned long long te0_ = __builtin_amdgcn_s_memrealtime();
#endif
        if constexpr (!Epi::AFTER_DRAIN) { E(acc, cur, wr, wc, fr, fq); S.done(cur); }
#if PROBE_PH == 50
        { volatile PG8_LAS unsigned long long* tp_ = (volatile PG8_LAS unsigned long long*)(lds + 155648 + 768); if (threadIdx.x == 0 && tp_[3] == PROBE_TGT) tp_[2] += __builtin_amdgcn_s_memrealtime() - te0_; }
#endif
        if (!has_next) break;
#pragma unroll
        for (int a = 0; a < 2; ++a)
#pragma unroll
            for (int b = 0; b < 2; ++b)
#pragma unroll
                for (int m = 0; m < 4; ++m)
#pragma unroll
                    for (int n = 0; n < 2; ++n) acc[a][b][m][n] = (f32x4){0.f, 0.f, 0.f, 0.f};
        cur = nxt; cA = nA; cB = nB; ++ui;
        if constexpr (ALIGN_EPI) { if (wr == 1) PG8_BAR; }
    }
    PG8_WAIT_V(0);
    if constexpr (!ALIGN_EPI) { if (wr == 0) PG8_BAR; }
    PG8_BAR;
    if constexpr (Epi::AFTER_DRAIN) { E.fused(acc, cur, wr, wc, fr, fq, lds, wid, lane); S.done(cur); }
#undef PG8_SA
#undef PG8_SB
#undef PG8_STAGE
#undef PG8_LDA
#undef PG8_LDB
#undef PG8_MMA
#undef PG8_WAIT_V
#undef PG8_WAIT_L
#undef PG8_BAR
#undef PG8_SCHED
}
}

#ifndef DIAG_SUB
#define DIAG_SUB -1
#endif
#define RUNSUB(k) (DIAG_SUB < 0 || DIAG_SUB == (k))
#ifndef DUP_SUB
#define DUP_SUB -1
#endif
#define NREP(k) ((DUP_SUB == (k)) ? 2 : 1)
#ifndef MERGE12
#define MERGE12 1
#endif
#ifndef PROBE_PH
#define PROBE_PH -1
#endif
#ifndef SKEW_TICKS
#define SKEW_TICKS 1800ull
#endif
#ifndef USE_CG_SYNC
#define USE_CG_SYNC 0
#endif
#ifndef MK_MULTI
#define MK_MULTI 0
#endif
constexpr int D = 1024, NB = 8, SEQ = 4096, NCTX = 256;
constexpr int ML = NB * SEQ;
constexpr int MC = NB * NCTX;
constexpr int MT = ML + MC;
constexpr int NPAD = 3072, ZLD = 2816;
constexpr float EPS = 1e-6f;
constexpr float LOG2E = 1.4426950408889634f;
constexpr float QSCALE = 0.125f * LOG2E;
constexpr float GQSCALE = 0.17677669529663687f;
constexpr int NCHAIN = 68;
constexpr int NPHASE = 12;
constexpr int LDS_BYTES = 159744;
constexpr int CTLW_OFF = 155648;
constexpr int WREG = 19456;

constexpr size_t MiB = 1u << 20;
constexpr size_t WS_CTL = 0, WS_WINT = 2 * MiB, WS_WOUTT = 14 * MiB, WS_MODV = 18 * MiB, WS_BIASZ = 18 * MiB + 256 * 1024, WS_ROPE = 18 * MiB + 512 * 1024;
constexpr size_t WS_PRM = 18 * MiB + 768 * 1024;
constexpr int PRM_CONVW = 0, PRM_CONVB = 15872, PRM_LNW = 16384, PRM_LNB = 16896, PRM_SINK = 17408, PRM_GNW = 17424, PRM_FNW = 17936, PRM_N = 18960;
constexpr size_t WS_RSS0 = 19 * MiB, WS_RSS1 = 19 * MiB + 256 * 1024, WS_RSS2 = 19 * MiB + 512 * 1024, WS_DEC = 20 * MiB;
constexpr size_t WS_A = 24 * MiB, WS_Y = 92 * MiB, WS_LA = 160 * MiB, WS_ST = 194 * MiB, WS_Z = 228 * MiB, WS_X1H = 416 * MiB, WS_END = 480 * MiB;

#define LAS __attribute__((address_space(3)))
typedef unsigned short bf16_t;
typedef float f32x4 __attribute__((ext_vector_type(4)));
typedef float f32x2 __attribute__((ext_vector_type(2)));
typedef float f32x16 __attribute__((ext_vector_type(16)));
typedef short bf16x8 __attribute__((ext_vector_type(8)));
typedef short s16x4 __attribute__((ext_vector_type(4)));
typedef unsigned u32x4 __attribute__((ext_vector_type(4)));
typedef unsigned u32x2 __attribute__((ext_vector_type(2)));
typedef _Float16 f16x2 __attribute__((ext_vector_type(2)));

struct Params {
    const float *x, *c, *ctx, *c_ctx, *w_mod, *b_mod, *w_in, *conv_w, *conv_b, *conv_ln_w, *conv_ln_b, *attn_sink, *gla_w_up, *gla_b_up, *gla_norm_w, *w_out, *final_norm_w;
    float* out; unsigned char* ws;
    int ph_lo, ph_hi;
};
struct WS {
    bf16_t *WinT, *WoutT, *A, *Y, *Z;
    float *modv, *biasz, *rope, *rss0, *rss1, *rss2, *dec, *LA, *ST, *prm;
};
__device__ __forceinline__ WS make_ws(unsigned char* ws) {
    WS W; W.WinT = (bf16_t*)(ws + WS_WINT); W.WoutT = (bf16_t*)(ws + WS_WOUTT); W.A = (bf16_t*)(ws + WS_A); W.Y = (bf16_t*)(ws + WS_Y); W.Z = (bf16_t*)(ws + WS_Z);
    W.modv = (float*)(ws + WS_MODV); W.biasz = (float*)(ws + WS_BIASZ); W.rope = (float*)(ws + WS_ROPE); W.rss0 = (float*)(ws + WS_RSS0); W.rss1 = (float*)(ws + WS_RSS1);
    W.rss2 = (float*)(ws + WS_RSS2); W.dec = (float*)(ws + WS_DEC); W.LA = (float*)(ws + WS_LA); W.ST = (float*)(ws + WS_ST); W.prm = (float*)(ws + WS_PRM); return W;
}

__device__ __forceinline__ unsigned pk2(float lo, float hi) { typedef __bf16 b2 __attribute__((ext_vector_type(2))); f32x2 v = {lo, hi}; b2 b = __builtin_convertvector(v, b2); return __builtin_bit_cast(unsigned, b); }
__device__ __forceinline__ unsigned pkh2(float lo, float hi) { f32x2 v = {lo, hi}; f16x2 h = __builtin_convertvector(v, f16x2); return __builtin_bit_cast(unsigned, h); }
__device__ __forceinline__ f32x2 unpkh2(unsigned w) { return __builtin_convertvector(__builtin_bit_cast(f16x2, w), f32x2); }
__device__ __forceinline__ float bflo(unsigned w) { return __uint_as_float(w << 16); }
__device__ __forceinline__ float bfhi(unsigned w) { return __uint_as_float(w & 0xffff0000u); }
__device__ __forceinline__ float silu_f(float v) { return v * __builtin_amdgcn_rcpf(1.f + __expf(-v)); }
__device__ __forceinline__ float sigmoid_f(float v) { return __builtin_amdgcn_rcpf(1.f + __expf(-v)); }
__device__ __forceinline__ float wave_sum(float v) {
#pragma unroll
    for (int o = 1; o < 64; o <<= 1) v += __shfl_xor(v, o);
    return v;
}
typedef short v4i16_t __attribute__((ext_vector_type(4)));
__device__ __forceinline__ s16x4 tr_read(const LAS unsigned char* p) { return __builtin_bit_cast(s16x4, __builtin_amdgcn_ds_read_tr16_b64_v4i16((LAS v4i16_t*)p)); }
__device__ __forceinline__ bf16x8 cat8(s16x4 a, s16x4 b) { return (bf16x8){a[0], a[1], a[2], a[3], b[0], b[1], b[2], b[3]}; }
#define MFMA32(a, b, c) __builtin_amdgcn_mfma_f32_32x32x16_bf16((a), (b), (c), 0, 0, 0)
__device__ __forceinline__ bf16x8 pack_acc8(const f32x16& v, int s) {
    u32x4 w; w.x = pk2(v[8 * s + 0], v[8 * s + 1]); w.y = pk2(v[8 * s + 2], v[8 * s + 3]); w.z = pk2(v[8 * s + 4], v[8 * s + 5]); w.w = pk2(v[8 * s + 6], v[8 * s + 7]);
    return __builtin_bit_cast(bf16x8, w);
}

#define XB_TMO      128
#define XB_XCNT(j)  (256  + 64 * (j))
#define XB_XSUB(j)  (1280 + 64 * (j))
#define XB_XGEN(j)  (2304 + 64 * (j))
#define XB_TOP      3328
#define XB_TOPGEN   3392
#define XCD_BAR_WORDS 3456
#define XB_SPIN_CAP (1u << 18)

__device__ __forceinline__ unsigned xb_ld(unsigned* p)              { return __hip_atomic_load(p, __ATOMIC_RELAXED, __HIP_MEMORY_SCOPE_AGENT); }
__device__ __forceinline__ unsigned xb_add(unsigned* p, unsigned v) { return __hip_atomic_fetch_add(p, v, __ATOMIC_RELAXED, __HIP_MEMORY_SCOPE_AGENT); }
__device__ __forceinline__ unsigned xb_xcc_id() { return (unsigned)__builtin_amdgcn_s_getreg((3 << 11) | 20) & 0xFu; }
#define XB_SPIN(cond, bar) do { unsigned _sp = 0; while (cond) { __builtin_amdgcn_s_sleep(1); \
    if ((++_sp & 255u) == 0u) { if (xb_ld(&(bar)[XB_TMO])) break; if (_sp > XB_SPIN_CAP) { atomicAdd(&(bar)[XB_TMO], 1u); break; } } } } while (0)

struct XcdBarrier {
    unsigned* bar; unsigned x;
    volatile LAS unsigned* st;
};

__device__ __forceinline__ XcdBarrier xcd_barrier_post(unsigned* bar, volatile LAS unsigned* st) {
    XcdBarrier b; b.bar = bar; b.x = xb_xcc_id(); b.st = st;
    if (threadIdx.x == 0) (void)xb_add(&bar[XB_XCNT(b.x)], 1u);
    return b;
}
__device__ __forceinline__ void xcd_barrier_complete(unsigned* bar, unsigned x, unsigned& nloc, unsigned& nx) {
    const unsigned G = gridDim.x * gridDim.y * gridDim.z;
    unsigned sum, cnt, mine, sp = 0u;
    for (;;) {
        sum = 0u; cnt = 0u; mine = 0u;
#pragma unroll
        for (unsigned j = 0; j < 16; ++j) { const unsigned c = xb_ld(&bar[XB_XCNT(j)]); sum += c; cnt += (c > 0u) ? 1u : 0u; mine = (j == x) ? c : mine; }
        if (sum == G) break;
        __builtin_amdgcn_s_sleep(1);
        if ((++sp & 255u) == 0u) { if (xb_ld(&bar[XB_TMO])) break; if (sp > XB_SPIN_CAP) { atomicAdd(&bar[XB_TMO], 1u); break; } }
    }
    nloc = mine > 0u ? mine : 1u; nx = cnt > 0u ? cnt : 1u;
}

__device__ __forceinline__ void xcd_barrier(const XcdBarrier& b) {
    asm volatile("s_waitcnt vmcnt(0)" ::: "memory");
    __syncthreads();
    if (threadIdx.x == 0) {
        unsigned* bar = b.bar;
        __builtin_amdgcn_s_waitcnt(0);
        unsigned nloc = b.st[0], nx = b.st[1];
        if (nloc == 0u) { xcd_barrier_complete(bar, b.x, nloc, nx); b.st[0] = nloc; b.st[1] = nx; }
        const unsigned old = xb_add(&bar[XB_XSUB(b.x)], 1u);
        const unsigned gen = old / nloc;
        if (old + 1u == (gen + 1u) * nloc) {
            __builtin_amdgcn_fence(__ATOMIC_RELEASE, "agent");
            asm volatile("s_waitcnt vmcnt(0)" ::: "memory");
            const unsigned og = xb_add(&bar[XB_TOP], 1u);
            const unsigned tg = og / nx;
            if (og + 1u == (tg + 1u) * nx) xb_add(&bar[XB_TOPGEN], 1u);
            else XB_SPIN(xb_ld(&bar[XB_TOPGEN]) == tg, bar);
            __builtin_amdgcn_fence(__ATOMIC_ACQUIRE, "agent");
            xb_add(&bar[XB_XGEN(b.x)], 1u);
            asm volatile("s_waitcnt vmcnt(0)" ::: "memory");
        } else {
            XB_SPIN(xb_ld(&bar[XB_XGEN(b.x)]) == gen, bar);
            __builtin_amdgcn_fence(__ATOMIC_ACQUIRE, "agent");
            asm volatile("s_waitcnt vmcnt(0)" ::: "memory");
        }
    }
    __syncthreads();
}

namespace pg8 {

template <bool DRY> struct EpiInT {
    static constexpr bool PERM = true, AFTER_DRAIN = false;
    bf16_t* Z; float* LA; const float* rss; const float* biasz; const LAS float* rope  ;
    __device__ __forceinline__ void operator()(const f32x4 (&acc)[2][2][4][2], const Unit& u, int wr, int wc, int fr_, int fq_) const {
        int fr = fr_, fq = fq_; asm volatile("" : "+v"(fr), "+v"(fq));
        const int pn = u.pn; const bool latent = u.pm < 128; const int bsel = latent ? (u.pm >> 4) : 8;
        const float* bz = biasz + bsel * NPAD + pn * 256 + wc * 32 + 8 * fq;
        f32x4 bz4[2][2]; float rinv8[2][4];
#pragma unroll
        for (int bj = 0; bj < 2; ++bj)
#pragma unroll
            for (int n = 0; n < 2; ++n) bz4[bj][n] = *(const f32x4*)(bz + bj * 128 + n * 4);
#pragma unroll
        for (int ai = 0; ai < 2; ++ai)
#pragma unroll
            for (int m = 0; m < 4; ++m) rinv8[ai][m] = rss[u.pm * 256 + ai * 128 + wr * 64 + m * 16 + fr];
#pragma unroll
        for (int ai = 0; ai < 2; ++ai)
#pragma unroll
            for (int m = 0; m < 4; ++m) rinv8[ai][m] = rsqrtf(rinv8[ai][m] * (1.f / 1024.f) + EPS);
        const bool do_rope = latent && (pn == 3 || pn == 4 || (pn == 5 && wc < 2));
        const float s0 = (pn == 3 || pn == 4) ? QSCALE : (pn == 8 ? GQSCALE : 1.f), s1 = (pn == 3 || pn == 4) ? QSCALE : 1.f;
        const int ropeoff = 8 * (fq & 1);
        if (pn == 11) {
#pragma unroll
            for (int ai = 0; ai < 2; ++ai) { if (u.half >= 0 && u.half != ai) continue;
                const int rowb = u.pm * 256 + ai * 128 + wr * 64 + fr;
#pragma unroll
                for (int bj = 0; bj < 2; ++bj)
#pragma unroll
                    for (int n = 0; n < 2; ++n) {
                        const f32x4 b4 = bz4[bj][n];
                        f32x4 x[4];
#pragma unroll
                        for (int m = 0; m < 4; ++m) { const f32x4 zz = acc[ai][bj][m][n] * rinv8[ai][m] + b4;
#pragma unroll
                            for (int e = 0; e < 4; ++e) x[m][e] = (fminf(zz[e], 0.f) - __logf(1.f + __expf(-fabsf(zz[e])))) * (1.f / 16.f); }
#pragma unroll
                        for (int m = 0; m < 4; ++m)
#pragma unroll
                            for (int e = 0; e < 4; ++e) { float xv = x[m][e];
#define DPPF(v, ctrl) __int_as_float(__builtin_amdgcn_update_dpp(0, __float_as_int(v), ctrl, 0xf, 0xf, true))
                                if (bj == 0) { xv += DPPF(xv, 0x111); xv += DPPF(xv, 0x112); xv += DPPF(xv, 0x114); xv += DPPF(xv, 0x118); }
                                else { xv += DPPF(xv, 0x101); xv += DPPF(xv, 0x102); xv += DPPF(xv, 0x104); xv += DPPF(xv, 0x108); }
                                x[m][e] = xv; }
                        f32x4 tot[4];
#pragma unroll
                        for (int m = 0; m < 4; ++m)
#pragma unroll
                            for (int e = 0; e < 4; ++e) tot[m][e] = bj == 0 ? DPPF(x[m][e], 0x15f) : DPPF(x[m][e], 0x150);
#undef DPPF
                        if (bj == 0) { x[1] = x[1] + tot[0]; x[2] = x[2] + (tot[0] + tot[1]); x[3] = x[3] + ((tot[0] + tot[1]) + tot[2]); }
                        else { x[2] = x[2] + tot[3]; x[1] = x[1] + (tot[3] + tot[2]); x[0] = x[0] + ((tot[3] + tot[2]) + tot[1]); }
#pragma unroll
                        for (int m = 0; m < 4; ++m) { u32x2 w; w.x = pkh2(x[m][0], x[m][1]); w.y = pkh2(x[m][2], x[m][3]); if (!DRY || w.x == 0x12345678u) *(u32x2*)((bf16_t*)LA + (size_t)(rowb + 16 * m) * 256 + bj * 128 + wc * 32 + 8 * fq + 4 * n) = w; }
                    }
            }
            return;
        }
#pragma unroll
        for (int ai = 0; ai < 2; ++ai) { if (u.half >= 0 && u.half != ai) continue;
#pragma unroll
            for (int m = 0; m < 4; ++m) {
                const int row = u.pm * 256 + ai * 128 + wr * 64 + m * 16 + fr;
                const float rinv = rinv8[ai][m];
                f32x4 v[2][2];
#pragma unroll
                for (int bj = 0; bj < 2; ++bj)
#pragma unroll
                    for (int n = 0; n < 2; ++n) v[bj][n] = acc[ai][bj][m][n] * rinv + bz4[bj][n];
                if (do_rope) {
                    const int t = row & 4095; const int pp = (fq < 2) ? (t >> 6) : (t & 63);
#pragma unroll
                    for (int n = 0; n < 2; ++n) {
                        const f32x4 c4 = *(const LAS f32x4*)(rope + pp * 16 + ropeoff + 4 * n), s4 = *(const LAS f32x4*)(rope + 1024 + pp * 16 + ropeoff + 4 * n);
                        const f32x4 x1 = v[0][n], x2 = v[1][n];
                        v[0][n] = x1 * c4 - x2 * s4; v[1][n] = x2 * c4 + x1 * s4;
                    }
                }
                if (pn == 11) {
                } else if (pn < 2) {
                    const f32x4 a = v[0][0], b = v[0][1], ga = v[1][0], gb = v[1][1];
                    u32x4 w; w.x = pk2(a[0] * sigmoid_f(ga[0]), a[1] * sigmoid_f(ga[1])); w.y = pk2(a[2] * sigmoid_f(ga[2]), a[3] * sigmoid_f(ga[3]));
                    w.z = pk2(b[0] * sigmoid_f(gb[0]), b[1] * sigmoid_f(gb[1])); w.w = pk2(b[2] * sigmoid_f(gb[2]), b[3] * sigmoid_f(gb[3]));
                    if (!DRY || w.x == 0x12345678u) *(u32x4*)(Z + (size_t)row * ZLD + pn * 128 + wc * 32 + 8 * fq) = w;
                } else {
                    if (pn == 2) {
#pragma unroll
                        for (int bj = 0; bj < 2; ++bj)
#pragma unroll
                            for (int n = 0; n < 2; ++n)
#pragma unroll
                                for (int e = 0; e < 4; ++e) v[bj][n][e] = silu_f(v[bj][n][e]);
                    }
                    bf16_t* zr = Z + (size_t)row * ZLD + pn * 256 + wc * 32 + 8 * fq;
#pragma unroll
                    for (int bj = 0; bj < 2; ++bj) { const float sc = bj == 0 ? s0 : s1; const f32x4 a = v[bj][0] * sc, b = v[bj][1] * sc;
                        u32x4 w; w.x = pk2(a[0], a[1]); w.y = pk2(a[2], a[3]); w.z = pk2(b[0], b[1]); w.w = pk2(b[2], b[3]);
                        if (!DRY || w.x == 0x12345678u) *(u32x4*)(zr + bj * 128) = w; }
                }
            }
        }
    }
};
typedef EpiInT<false> EpiIn;
struct EpiOut {
    static constexpr bool PERM = true, AFTER_DRAIN = false;
    const float* xl; const float* xc; bf16_t* xout  ; const float* modv_l; const float* modv_next; bf16_t* Anext; float* rss_out;
    __device__ __forceinline__ void operator()(const f32x4 (&acc)[2][2][4][2], const Unit& u, int wr, int wc, int fr_, int fq_) const {
        int fr = fr_, fq = fq_; asm volatile("" : "+v"(fr), "+v"(fq));
        const int pn = u.pn; const bool latent = u.pm < 128; const int bsel = latent ? (u.pm >> 4) : 8;
        const int colb = pn * 256 + wc * 32 + 8 * fq;
        const float* gp = modv_l + bsel * 3072 + 2048 + colb;
        const float* sp = modv_next ? modv_next + bsel * 3072 + 1024 + colb : nullptr;
#pragma unroll
        for (int ai = 0; ai < 2; ++ai)
#pragma unroll
            for (int m = 0; m < 4; ++m) {
                const int row = u.pm * 256 + ai * 128 + wr * 64 + m * 16 + fr;
                const float* xin = (latent ? xl + (size_t)row * 1024 : xc + (size_t)(row - ML) * 1024) + colb;
                float ss = 0.f;
#pragma unroll
                for (int bj = 0; bj < 2; ++bj) {
                    f32x4 o[2];
#pragma unroll
                    for (int n = 0; n < 2; ++n) { const f32x4 x4 = *(const f32x4*)(xin + bj * 128 + 4 * n); const f32x4 g4 = *(const f32x4*)(gp + bj * 128 + 4 * n);
                        o[n] = x4 + g4 * acc[ai][bj][m][n]; ss += (o[n][0] * o[n][0] + o[n][1] * o[n][1]) + (o[n][2] * o[n][2] + o[n][3] * o[n][3]); }
                    if (latent) { u32x4 w; w.x = pkh2(o[0][0], o[0][1]); w.y = pkh2(o[0][2], o[0][3]); w.z = pkh2(o[1][0], o[1][1]); w.w = pkh2(o[1][2], o[1][3]); *(u32x4*)(xout + (size_t)row * 1024 + colb + bj * 128) = w; }
                    if (sp) { const f32x4 a = o[0] * (*(const f32x4*)(sp + bj * 128) + 1.f), b = o[1] * (*(const f32x4*)(sp + bj * 128 + 4) + 1.f);
                        u32x4 w; w.x = pk2(a[0], a[1]); w.y = pk2(a[2], a[3]); w.z = pk2(b[0], b[1]); w.w = pk2(b[2], b[3]);
                        *(u32x4*)(Anext + (size_t)row * 1024 + colb + bj * 128) = w; }
                }
                ss += __shfl_xor(ss, 16); ss += __shfl_xor(ss, 32);
                if (fq == 0) atomicAdd(rss_out + row, ss);
            }
    }
};
struct EpiOutFin {
    static constexpr bool PERM = true, AFTER_DRAIN = false;
    const bf16_t* xl  ; float* out; const float* modv_l; const float* fw; float* rss; unsigned* cnt; LAS unsigned* flag;
    __device__ __forceinline__ void operator()(const f32x4 (&acc_)[2][2][4][2], const Unit& u, int wr, int wc, int fr_, int fq_) const {
        f32x4 (&acc)[2][2][4][2] = const_cast<f32x4 (&)[2][2][4][2]>(acc_);
        int fr = fr_, fq = fq_; asm volatile("" : "+v"(fr), "+v"(fq));
        const int pn = u.pn; const int bsel = u.pm >> 4;
        const int colb = pn * 256 + wc * 32 + 8 * fq;
        const float* gp = modv_l + bsel * 3072 + 2048 + colb;
#pragma unroll
        for (int ai = 0; ai < 2; ++ai)
#pragma unroll
            for (int m = 0; m < 4; ++m) {
                const int row = u.pm * 256 + ai * 128 + wr * 64 + m * 16 + fr;
                const bf16_t* xin = xl + (size_t)row * 1024 + colb;
                float ss = 0.f;
#pragma unroll
                for (int bj = 0; bj < 2; ++bj) { const u32x4 xh = *(const u32x4*)(xin + bj * 128);
#pragma unroll
                    for (int n = 0; n < 2; ++n) { const f32x2 xa = unpkh2(n == 0 ? xh.x : xh.z), xb = unpkh2(n == 0 ? xh.y : xh.w); const f32x4 x4 = {xa[0], xa[1], xb[0], xb[1]}; const f32x4 g4 = *(const f32x4*)(gp + bj * 128 + 4 * n);
                        const f32x4 o = x4 + g4 * acc[ai][bj][m][n]; acc[ai][bj][m][n] = o; ss += (o[0] * o[0] + o[1] * o[1]) + (o[2] * o[2] + o[3] * o[3]); } }
                ss += __shfl_xor(ss, 16); ss += __shfl_xor(ss, 32);
                if (fq == 0) atomicAdd(rss + row, ss);
            }
        asm volatile("s_waitcnt vmcnt(0)" ::: "memory");
        __syncthreads();
        if (threadIdx.x == 0) {
            __hip_atomic_fetch_add(cnt + 64 * u.pm, 1u, __ATOMIC_RELAXED, __HIP_MEMORY_SCOPE_AGENT);
            unsigned sp_ = 0;
            while (__hip_atomic_load(cnt + 64 * u.pm, __ATOMIC_RELAXED, __HIP_MEMORY_SCOPE_AGENT) < 4u) { __builtin_amdgcn_s_sleep(2); if (++sp_ > (1u << 22)) break; }
        }
        __syncthreads();
#pragma unroll
        for (int ai = 0; ai < 2; ++ai)
#pragma unroll
            for (int m = 0; m < 4; ++m) {
                const int row = u.pm * 256 + ai * 128 + wr * 64 + m * 16 + fr;
                const float rinv = rsqrtf(__hip_atomic_load(rss + row, __ATOMIC_RELAXED, __HIP_MEMORY_SCOPE_AGENT) * (1.f / 1024.f) + EPS);
                float* xo = out + (size_t)row * 1024 + colb;
#pragma unroll
                for (int bj = 0; bj < 2; ++bj)
#pragma unroll
                    for (int n = 0; n < 2; ++n) *(f32x4*)(xo + bj * 128 + 4 * n) = acc[ai][bj][m][n] * rinv * *(const f32x4*)(fw + colb + bj * 128 + 4 * n);
            }
    }
};
struct OneUnit {
    int pm, pn; unsigned* cnt;
    __device__ __forceinline__ bool next(int i, Unit& u) const { if (i != 0) return false; u.pm = pm; u.pn = pn; u.half = -1; return true; }
    __device__ __forceinline__ void a_ready(const Unit&) const {}
    __device__ __forceinline__ void done(const Unit&) const {
        asm volatile("s_waitcnt vmcnt(0)" ::: "memory");
        __builtin_amdgcn_fence(__ATOMIC_RELEASE, "agent");
        asm volatile("s_waitcnt vmcnt(0)" ::: "memory");
        if ((threadIdx.x & 63) == 0) __hip_atomic_fetch_add(cnt, 1u, __ATOMIC_RELAXED, __HIP_MEMORY_SCOPE_AGENT);
    }
};
struct GatedOrder : StaticOrder {
    int pm_gate; const unsigned* cnt; unsigned need;
    int nfull, nextra;
    __device__ __forceinline__ bool next(int i, Unit& u) const {
        if (i < nfull) { map((long)i * G + ((c & 7) | ((((c >> 3) + 2 * i) & 31) << 3)), u); return true; }
        int k = i - nfull;
        if (c < nextra) { if (k == 0) { map((long)nfull * G + c, u); return true; } k -= 1; }
        if (k != 0) return false;
        const int rem = nwg - nfull * G - nextra; if (c >= 2 * rem) return false;
        map((long)nfull * G + nextra + (c >> 1), u); u.half = c & 1; return true;
    }
    __device__ __forceinline__ void a_ready(const Unit& u) const {
        if (u.pm < pm_gate) return;
        if (threadIdx.x < 64) {
            unsigned sp_ = 0;
            while ((unsigned)__builtin_amdgcn_readfirstlane(__hip_atomic_load(cnt, __ATOMIC_RELAXED, __HIP_MEMORY_SCOPE_AGENT)) < need) { __builtin_amdgcn_s_sleep(2); if (++sp_ > (1u << 22)) break; }
            __builtin_amdgcn_fence(__ATOMIC_ACQUIRE, "agent");
            asm volatile("s_waitcnt vmcnt(0)" ::: "memory");
        }
        asm volatile("" ::: "memory"); __builtin_amdgcn_s_barrier(); asm volatile("" ::: "memory");
    }
};
}

__device__ __forceinline__ int win_src_col(int n0) {
    if (n0 < 512) { const int t = n0 >> 8, bj = (n0 >> 7) & 1, off = n0 & 127; return (bj ? 256 : 0) + t * 128 + off; }
    if (n0 < 768) return n0;
    if (n0 < 1280) { const int r = n0 - 768, tq = r >> 8, bj = (r >> 7) & 1, wc = (r >> 5) & 3; return 768 + (4 * tq + wc) * 64 + 32 * bj; }
    if (n0 < 1536) { const int r = n0 - 1280, bj = (r >> 7) & 1, wc = (r >> 5) & 3; return wc < 2 ? 1280 + wc * 64 + 32 * bj : 1408 + (wc - 2) * 64 + 32 * bj; }
    if (n0 < 2560) return n0;
    if (n0 < 2816) return n0 + 32;
    return -1;
}
__device__ __forceinline__ void transpose_item(const float* Wsrc, int N, int srccol, const float* wup  , int lrcol, int j0, bf16_t* WT, int n0dst, int k0, LAS float* scr, int lane) {
    const int cc = lane & 31, kh = lane >> 5;
    if (wup == nullptr) {
        float v[32];
#pragma unroll
        for (int i = 0; i < 32; ++i) v[i] = Wsrc[(size_t)(k0 + 2 * i + kh) * N + srccol + cc];
#pragma unroll
        for (int i = 0; i < 32; ++i) scr[(2 * i + kh) * 33 + cc] = v[i];
    } else {
        LAS float* wl = scr + 64 * 33;
        f32x4 w4[4]; float up[16];
#pragma unroll
        for (int q = 0; q < 4; ++q) w4[q] = *(const f32x4*)(Wsrc + (size_t)(k0 + lane) * N + lrcol + 4 * q);
#pragma unroll
        for (int r = 0; r < 16; ++r) up[r] = wup[r * 128 + j0 + cc];
#pragma unroll
        for (int q = 0; q < 4; ++q) *(LAS f32x4*)(wl + lane * 16 + 4 * q) = w4[q];
        asm volatile("s_waitcnt lgkmcnt(0)" ::: "memory");
#pragma unroll 8
        for (int i = 0; i < 32; ++i) { const int kk = 2 * i + kh; float v = 0.f;
#pragma unroll
            for (int q = 0; q < 4; ++q) { const f32x4 a = *(const LAS f32x4*)(wl + kk * 16 + 4 * q); v += a[0] * up[4 * q] + a[1] * up[4 * q + 1] + a[2] * up[4 * q + 2] + a[3] * up[4 * q + 3]; }
            scr[kk * 33 + cc] = v; }
    }
    asm volatile("s_waitcnt lgkmcnt(0)" ::: "memory");
    const int c = lane & 7;
#pragma unroll
    for (int j = 0; j < 4; ++j) { const int n = (lane >> 3) + 8 * j; const LAS float* s = scr + (8 * c) * 33 + n;
        u32x4 o; o.x = pk2(s[0 * 33], s[1 * 33]); o.y = pk2(s[2 * 33], s[3 * 33]); o.z = pk2(s[4 * 33], s[5 * 33]); o.w = pk2(s[6 * 33], s[7 * 33]);
        *(u32x4*)(WT + (size_t)(n0dst + n) * 1024 + k0 + 8 * c) = o; }
    asm volatile("s_waitcnt lgkmcnt(0)" ::: "memory");
}
__device__ __forceinline__ void phase_prep0(const Params& p, const WS& W, LAS unsigned char* lds) {
    int tid_ = threadIdx.x; asm volatile("" : "+v"(tid_)); const int tid = tid_, lane = tid & 63, wave = tid >> 6;
    {
        LAS float* sc = (LAS float*)lds; LAS float* red = sc + 9 * 1024;
        if ((int)blockIdx.x < 192) {
            const int it = blockIdx.x, l = it / 96, cb = it % 96, cc = tid & 31, kg = tid >> 5;
            const float* wp = p.w_mod + (size_t)l * 1024 * 3072 + (size_t)(kg * 64) * 3072 + cb * 32 + cc;
            float w[64];
#pragma unroll
            for (int kk = 0; kk < 64; ++kk) w[kk] = wp[(size_t)kk * 3072];
            for (int idx = tid; idx < 9216; idx += 512) { const int r = idx >> 10, k = idx & 1023; const float v = r < 8 ? p.c[r * 1024 + k] : p.c_ctx[k]; sc[idx] = silu_f(v); }
            __syncthreads();
            float a[9];
#pragma unroll
            for (int r = 0; r < 9; ++r) a[r] = 0.f;
#pragma unroll
            for (int kk = 0; kk < 64; ++kk) {
#pragma unroll
                for (int r = 0; r < 9; ++r) a[r] += sc[r * 1024 + kg * 64 + kk] * w[kk]; }
#pragma unroll
            for (int r = 0; r < 9; ++r) red[(kg * 9 + r) * 32 + cc] = a[r];
            __syncthreads();
            if (tid < 288) { const int r = tid >> 5; float s = 0.f;
#pragma unroll
                for (int g = 0; g < 16; ++g) s += red[(g * 9 + r) * 32 + cc];
                W.modv[(l * 9 + r) * 3072 + cb * 32 + cc] = s + p.b_mod[l * 3072 + cb * 32 + cc]; }
        }
    }
    if (blockIdx.x == gridDim.x - 1) {
        for (int idx = tid; idx < 1024; idx += 512) { const int pp = idx >> 4, f = idx & 15;
            const float inv = __builtin_amdgcn_exp2f(-(float)f * (13.287712379549449f / 16.f)); const float ang = (float)pp * inv;
            W.rope[idx] = __cosf(ang); W.rope[1024 + idx] = __sinf(ang); }
    }
    for (int i = blockIdx.x * 512 + tid; i < PRM_N; i += gridDim.x * 512) {
        float v;
        if (i < PRM_CONVB) v = p.conv_w[i]; else if (i < PRM_LNW) v = p.conv_b[i - PRM_CONVB]; else if (i < PRM_LNB) v = p.conv_ln_w[i - PRM_LNW]; else if (i < PRM_SINK) v = p.conv_ln_b[i - PRM_LNB];
        else if (i < PRM_GNW) v = p.attn_sink[i - PRM_SINK]; else if (i < PRM_FNW) v = p.gla_norm_w[i - PRM_GNW]; else v = p.final_norm_w[i - PRM_FNW];
        W.prm[i] = v; }
    for (int i = blockIdx.x * 512 + tid; i < MT; i += gridDim.x * 512) { W.rss0[i] = (1.f - EPS) * 1024.f; W.rss1[i] = 0.f; if (i < ML) W.rss2[i] = 0.f; }
    __syncthreads();
    {
        LAS float* scr = (LAS float*)(lds + wave * 16384);
        const int bxr = (int)blockIdx.x >= 192 ? (int)blockIdx.x - 192 : (int)blockIdx.x + 64;
        const int gw = bxr * 8 + wave, NGW = gridDim.x * 8;
        constexpr int I_IN = 96 * 16, I_OUT = 32 * 16, I_L = I_IN + I_OUT;
        for (int it = gw; it < 2 * I_L; it += NGW) {
            const int l = it / I_L; int r = it % I_L;
            if (r < I_IN) { const int nb = r % 96, kb = r / 96, n0 = nb * 32; const int src = win_src_col(n0);
                if (src >= 0) transpose_item(p.w_in + (size_t)l * 1024 * 2848, 2848, src, nullptr, 0, 0, W.WinT + (size_t)l * NPAD * 1024, n0, kb * 64, scr, lane);
                else { const int dir = (n0 - 2816) >> 7, j0 = (n0 - 2816) & 127;
                    transpose_item(p.w_in + (size_t)l * 1024 * 2848, 2848, 0, p.gla_w_up + (size_t)(l * 2 + dir) * 16 * 128, 2560 + 16 * dir, j0, W.WinT + (size_t)l * NPAD * 1024, n0, kb * 64, scr, lane); } }
            else { r -= I_IN; const int nb = r % 32, kb = r / 32;
                transpose_item(p.w_out + (size_t)l * 1024 * 1024, 1024, nb * 32, nullptr, 0, 0, W.WoutT + (size_t)l * 1024 * 1024, nb * 32, kb * 64, scr, lane); }
        }
    }
}

__device__ __forceinline__ void phase_prep1(const Params& p, const WS& W) {
    int tid_ = threadIdx.x; asm volatile("" : "+v"(tid_)); const int tid = tid_, lane = tid & 63, wave = tid >> 6;
    const int gw = blockIdx.x * 8 + wave;
    {
        const int bsel = gw >> 8, rb = bsel * 4096 + (gw & 255);
        const float* md = W.modv + bsel * 3072; const float* mc = W.modv + 8 * 3072;
        f32x4 s4[4], h4[4], sc4[4], hc4[4], vc[4];
#pragma unroll
        for (int j = 0; j < 4; ++j) { s4[j] = *(const f32x4*)(md + 1024 + j * 256 + lane * 4); h4[j] = *(const f32x4*)(md + j * 256 + lane * 4);
            sc4[j] = *(const f32x4*)(mc + 1024 + j * 256 + lane * 4); hc4[j] = *(const f32x4*)(mc + j * 256 + lane * 4);
            vc[j] = __builtin_nontemporal_load((const f32x4*)(p.ctx + (size_t)gw * 1024 + j * 256 + lane * 4)); }
#pragma unroll 1
        for (int st_ = 0; st_ < 4; ++st_) {
            f32x4 v[4][4];
#pragma unroll
            for (int q = 0; q < 4; ++q) { const float* xr = p.x + (size_t)(rb + 256 * (4 * st_ + q)) * 1024;
#pragma unroll
                for (int j = 0; j < 4; ++j) v[q][j] = __builtin_nontemporal_load((const f32x4*)(xr + j * 256 + lane * 4)); }
            float ss[4];
#pragma unroll
            for (int q = 0; q < 4; ++q) { ss[q] = 0.f;
#pragma unroll
                for (int j = 0; j < 4; ++j) { const f32x4 x4 = v[q][j]; ss[q] += (x4[0] * x4[0] + x4[1] * x4[1]) + (x4[2] * x4[2] + x4[3] * x4[3]); } }
#pragma unroll
            for (int o = 1; o < 64; o <<= 1) {
#pragma unroll
                for (int q = 0; q < 4; ++q) ss[q] += __shfl_xor(ss[q], o); }
#pragma unroll
            for (int q = 0; q < 4; ++q) { const int row = rb + 256 * (4 * st_ + q);
                const float rinv = rsqrtf(ss[q] * (1.f / 1024.f) + EPS); u32x2* ao = (u32x2*)(W.A + (size_t)row * 1024);
#pragma unroll
                for (int j = 0; j < 4; ++j) { const f32x4 a = v[q][j] * rinv * (s4[j] + 1.f) + h4[j]; u32x2 w; w.x = pk2(a[0], a[1]); w.y = pk2(a[2], a[3]); ao[j * 64 + lane] = w; } }
        }
        {
            float ss = 0.f;
#pragma unroll
            for (int j = 0; j < 4; ++j) { const f32x4 x4 = vc[j]; ss += (x4[0] * x4[0] + x4[1] * x4[1]) + (x4[2] * x4[2] + x4[3] * x4[3]); }
#pragma unroll
            for (int o = 1; o < 64; o <<= 1) ss += __shfl_xor(ss, o);
            const float rinv = rsqrtf(ss * (1.f / 1024.f) + EPS); u32x2* ao = (u32x2*)(W.A + (size_t)(ML + gw) * 1024);
#pragma unroll
            for (int j = 0; j < 4; ++j) { const f32x4 a = vc[j] * rinv * (sc4[j] + 1.f) + hc4[j]; u32x2 w; w.x = pk2(a[0], a[1]); w.y = pk2(a[2], a[3]); ao[j * 64 + lane] = w; }
        }
    }
    for (int i = blockIdx.x * 512 + tid; i < 9 * NPAD; i += gridDim.x * 512) { const int n = i % NPAD; W.biasz[i] = n >= 2816 ? p.gla_b_up[((n - 2816) >> 7) * 128 + ((n - 2816) & 127)] : 0.f; }
}
__device__ __forceinline__ void bias1_tasks(const Params& p, const WS& W, int gw, int NGW, int lane) {
    for (int it = gw; it < NPAD; it += NGW) {
        const int l = 1, n = it;
        const bf16_t* wrow = W.WinT + ((size_t)l * NPAD + n) * 1024 + lane * 16;
        const u32x4 w0 = *(const u32x4*)wrow, w1 = *(const u32x4*)(wrow + 8);
        float wf[16];
#pragma unroll
        for (int e = 0; e < 4; ++e) { wf[2 * e] = bflo(w0[e]); wf[2 * e + 1] = bfhi(w0[e]); wf[8 + 2 * e] = bflo(w1[e]); wf[8 + 2 * e + 1] = bfhi(w1[e]); }
        float extra = 0.f;
        if (n >= 2816) extra = p.gla_b_up[(l * 2 + ((n - 2816) >> 7)) * 128 + ((n - 2816) & 127)];
        float sv[9];
#pragma unroll
        for (int r = 0; r < 9; ++r) {
            const float* sh = W.modv + (l * 9 + r) * 3072 + lane * 16; float s = 0.f;
#pragma unroll
            for (int q = 0; q < 4; ++q) { const f32x4 s4 = *(const f32x4*)(sh + 4 * q); s += s4[0] * wf[4 * q] + s4[1] * wf[4 * q + 1] + s4[2] * wf[4 * q + 2] + s4[3] * wf[4 * q + 3]; }
            sv[r] = s; }
#pragma unroll
        for (int o = 1; o < 64; o <<= 1) {
#pragma unroll
            for (int r = 0; r < 9; ++r) sv[r] += __shfl_xor(sv[r], o); }
        if (lane < 9) { float s = sv[0];
#pragma unroll
            for (int r = 1; r < 9; ++r) s = lane == r ? sv[r] : s;
            W.biasz[(l * 9 + lane) * NPAD + n] = s + extra; }
    }
}

__device__ __forceinline__ void conv_unit(const Params& p, const WS& W, int layer, int sidx, int tile, LAS unsigned char* lds) {
    int tid_ = threadIdx.x; asm volatile("" : "+v"(tid_)); const int tid = tid_, lane = tid & 63, wave = tid >> 6;
    const bool isctx = sidx >= 8; const int b = sidx & 7;
    const int L = isctx ? NCTX : SEQ; const int rowbase = isctx ? ML + b * NCTX : b * SEQ; const int t0 = tile * 64;
    LAS float* U = (LAS float*)lds;
    {
        u32x4 a[6];
#pragma unroll
        for (int i = 0; i < 6; ++i) { const int idx = tid + 512 * i, tt = idx >> 5, ch = idx & 31, t = t0 - 15 + tt;
            a[i] = (u32x4){0u, 0u, 0u, 0u};
            if (tt < 94 && t >= 0 && t < L) a[i] = *(const u32x4*)(W.Z + (size_t)(rowbase + t) * ZLD + ch * 8); }
#pragma unroll
        for (int i = 0; i < 6; ++i) { const int idx = tid + 512 * i, tt = idx >> 5, ch = idx & 31;
            if (tt < 94) { const f32x4 u0 = {bflo(a[i][0]), bfhi(a[i][0]), bflo(a[i][1]), bfhi(a[i][1])}, u1 = {bflo(a[i][2]), bfhi(a[i][2]), bflo(a[i][3]), bfhi(a[i][3])};
                *(LAS f32x4*)(U + tt * 256 + ch * 8) = u0; *(LAS f32x4*)(U + tt * 256 + ch * 8 + 4) = u1; } }
    }
    __syncthreads();
    {
        const int c = tid & 255, half = tid >> 8;
        float uu[62], wgt[31];
#pragma unroll
        for (int j = 0; j < 31; ++j) wgt[j] = W.prm[PRM_CONVW + (layer * 31 + j) * 256 + c];
#pragma unroll
        for (int i = 0; i < 62; ++i) uu[i] = U[(half * 32 + i) * 256 + c];
        const float cb = W.prm[PRM_CONVB + layer * 256 + c];
        __syncthreads();
#pragma unroll
        for (int t = 0; t < 32; ++t) { float a = cb;
#pragma unroll
            for (int j = 0; j < 31; ++j) a = fmaf(wgt[j], uu[t + j], a);
            U[(half * 32 + t) * 256 + c] = a; }
    }
    __syncthreads();
    {
        const f32x4 lw = *(const f32x4*)(W.prm + PRM_LNW + layer * 256 + lane * 4), lb = *(const f32x4*)(W.prm + PRM_LNB + layer * 256 + lane * 4);
        f32x4 v[8]; u32x2 gz[8]; float sm[8];
#pragma unroll
        for (int tk = 0; tk < 8; ++tk) { const int t = wave * 8 + tk; v[tk] = *(const LAS f32x4*)(U + t * 256 + lane * 4); gz[tk] = *(const u32x2*)(W.Z + (size_t)(rowbase + t0 + t) * ZLD + 512 + lane * 4);
            sm[tk] = (v[tk][0] + v[tk][1]) + (v[tk][2] + v[tk][3]); }
#pragma unroll
        for (int o = 1; o < 64; o <<= 1) {
#pragma unroll
            for (int tk = 0; tk < 8; ++tk) sm[tk] += __shfl_xor(sm[tk], o); }
#pragma unroll
        for (int tk = 0; tk < 8; ++tk) { v[tk] = v[tk] - sm[tk] * (1.f / 256.f); sm[tk] = (v[tk][0] * v[tk][0] + v[tk][1] * v[tk][1]) + (v[tk][2] * v[tk][2] + v[tk][3] * v[tk][3]); }
#pragma unroll
        for (int o = 1; o < 64; o <<= 1) {
#pragma unroll
            for (int tk = 0; tk < 8; ++tk) sm[tk] += __shfl_xor(sm[tk], o); }
#pragma unroll
        for (int tk = 0; tk < 8; ++tk) {
            const int row = rowbase + t0 + wave * 8 + tk;
            const float rstd = rsqrtf(sm[tk] * (1.f / 256.f) + EPS);
            const f32x4 y = v[tk] * rstd * lw + lb;
            const float o0 = silu_f(y[0]) * bflo(gz[tk].x), o1 = silu_f(y[1]) * bfhi(gz[tk].x), o2 = silu_f(y[2]) * bflo(gz[tk].y), o3 = silu_f(y[3]) * bfhi(gz[tk].y);
            u32x2 w; w.x = pk2(o0, o1); w.y = pk2(o2, o3);
            *(u32x2*)(W.Y + (size_t)row * 1024 + lane * 4) = w;
        }
    }
    __syncthreads();
}

#define GLA_CUMSUM(bc, tot, larow, dir, lane)                                                               \
    do {                                                                                                    \
        _Pragma("unroll") for (int q_ = 0; q_ < 8; ++q_) { const f32x4 t4_ = *(const f32x4*)((larow) + 4 * q_); bc[4 * q_] = t4_[0]; bc[4 * q_ + 1] = t4_[1]; bc[4 * q_ + 2] = t4_[2]; bc[4 * q_ + 3] = t4_[3]; } \
        _Pragma("unroll") for (int d_ = 0; d_ < 32; ++d_) { float x_ = bc[d_];                                \
            if ((dir) == 0) { _Pragma("unroll") for (int o_ = 1; o_ < 64; o_ <<= 1) { const float y_ = __shfl_up(x_, o_); if ((lane) >= o_) x_ += y_; } tot[d_] = __shfl(x_, 63); } \
            else { _Pragma("unroll") for (int o_ = 1; o_ < 64; o_ <<= 1) { const float y_ = __shfl_down(x_, o_); if ((lane) + o_ < 64) x_ += y_; } tot[d_] = __shfl(x_, 0); } \
            bc[d_] = x_; }                                                                                  \
    } while (0)

#define GLA_LOADB(bc, tot, W_, row0_, dir_, h_, lane_) do { \
        const float* lr_ = (W_).LA + (size_t)((row0_) + (lane_)) * 256 + (dir_) * 128 + (h_) * 32; const float* lt_ = (W_).LA + (size_t)((row0_) + ((dir_) == 0 ? 63 : 0)) * 256 + (dir_) * 128 + (h_) * 32; \
        _Pragma("unroll") for (int q_ = 0; q_ < 8; ++q_) { const f32x4 a_ = *(const f32x4*)(lr_ + 4 * q_), t_ = *(const f32x4*)(lt_ + 4 * q_); \
            bc[4 * q_] = a_[0]; bc[4 * q_ + 1] = a_[1]; bc[4 * q_ + 2] = a_[2]; bc[4 * q_ + 3] = a_[3]; tot[4 * q_] = t_[0]; tot[4 * q_ + 1] = t_[1]; tot[4 * q_ + 2] = t_[2]; tot[4 * q_ + 3] = t_[3]; } } while (0)

__device__ __forceinline__ void gla_state_unit(const WS& W, int b, bool isctx, int n, LAS unsigned char* lds) {
    int tid_ = threadIdx.x; asm volatile("" : "+v"(tid_)); const int tid = tid_, lane = tid & 63, wave = __builtin_amdgcn_readfirstlane(tid >> 6);
    const int dir = wave >> 2, h = wave & 3;
    const int row0 = (isctx ? ML + b * NCTX : b * SEQ) + n * 64;
    LAS unsigned char* Vb = lds;
    LAS unsigned char* KW = lds + 49152 + wave * 5120;
#pragma unroll
    for (int i = 0; i < 4; ++i) { const int idx = tid + 512 * i, t = idx >> 5, hh = (idx >> 3) & 3, ch = idx & 7;
        *(LAS u32x4*)(Vb + hh * 12288 + t * 192 + ch * 16) = *(const u32x4*)(W.Z + (size_t)(row0 + t) * ZLD + 2304 + hh * 64 + ch * 8); }
    float bc[32], tot[32];
    GLA_LOADB(bc, tot, W, row0, dir, h, lane);
    const int c = dir == 0 ? (isctx ? n : 4 + n) : (isctx ? 3 - n : 67 - n);
    const size_t cbase = (size_t)(((b * 2 + dir) * NCHAIN + c) * 4 + h);
    {
        const bf16_t* kp = W.Z + (size_t)(row0 + lane) * ZLD + 2176 + h * 32;
#pragma unroll
        for (int q = 0; q < 4; ++q) { const u32x4 kk = *(const u32x4*)(kp + 8 * q); u32x4 o;
#pragma unroll
            for (int e = 0; e < 4; ++e) { const int d = 8 * q + 2 * e; o[e] = pk2(bflo(kk[e]) * __expf(tot[d] - bc[d]), bfhi(kk[e]) * __expf(tot[d + 1] - bc[d + 1])); }
            *(LAS u32x4*)(KW + lane * 80 + q * 16) = o; }
        if (lane == 0) { float* dp = W.dec + cbase * 32;
#pragma unroll
            for (int q = 0; q < 8; ++q) { f32x4 o = {__expf(tot[4 * q]), __expf(tot[4 * q + 1]), __expf(tot[4 * q + 2]), __expf(tot[4 * q + 3])}; *(f32x4*)(dp + 4 * q) = o; } }
    }
    __syncthreads();
    {
        const int i16 = lane & 15, gi = (lane >> 4) & 1, hi = lane >> 5, l31 = lane & 31;
        const LAS unsigned char* kwb = KW + (i16 >> 2) * 80 + (16 * gi + 4 * (i16 & 3)) * 2 + (8 * hi) * 80;
        const LAS unsigned char* vb = Vb + h * 12288 + (i16 >> 2) * 192 + (16 * gi + 4 * (i16 & 3)) * 2 + (8 * hi) * 192;
        float* stp = W.ST + cbase * 2048;
#pragma unroll
        for (int vt = 0; vt < 2; ++vt) {
            f32x16 acc = {};
#pragma unroll
            for (int s = 0; s < 4; ++s) {
                const bf16x8 a = cat8(tr_read(kwb + (16 * s) * 80), tr_read(kwb + (16 * s + 4) * 80));
                const bf16x8 bb = cat8(tr_read(vb + (16 * s) * 192 + vt * 64), tr_read(vb + (16 * s + 4) * 192 + vt * 64));
                acc = MFMA32(a, bb, acc);
            }
#pragma unroll
            for (int r = 0; r < 16; ++r) { const int d = (r & 3) + 8 * (r >> 2) + 4 * hi; stp[d * 64 + 32 * vt + l31] = acc[r]; }
        }
    }
    __syncthreads();
}

__device__ __forceinline__ void gla_scan(const WS& W, int unit) {
    int tid_ = threadIdx.x; asm volatile("" : "+v"(tid_));
    { const int e = unit * 512 + tid_;
        const int pp = e & 1023, h = (e >> 10) & 3, bd = e >> 12, d = 2 * (pp & 15);
        unsigned* sp = (unsigned*)W.ST + ((size_t)(bd * NCHAIN) * 4 + h) * 1024 + pp;
        const float* dp = W.dec + ((size_t)(bd * NCHAIN) * 4 + h) * 32 + d;
        float S0 = 0.f, S1 = 0.f;
#pragma unroll
        for (int c0 = 0; c0 < NCHAIN; c0 += 34) {
            unsigned st[34]; f32x2 dc[34];
#pragma unroll
            for (int j = 0; j < 34; ++j) { st[j] = sp[(size_t)(c0 + j) * 4096]; dc[j] = *(const f32x2*)(dp + (size_t)(c0 + j) * 128); }
#pragma unroll
            for (int j = 0; j < 34; ++j) { sp[(size_t)(c0 + j) * 4096] = pk2(S0, S1); const f32x2 x = unpkh2(st[j]); S0 = dc[j][0] * S0 + x[0]; S1 = dc[j][1] * S1 + x[1]; }
        }
    }
}

__device__ __forceinline__ void gla_out_unit(const Params& p, const WS& W, int layer, int b, bool isctx, int n, int hp, LAS unsigned char* lds) {
    int tid_ = threadIdx.x; asm volatile("" : "+v"(tid_)); const int tid = tid_, lane = tid & 63, wave = __builtin_amdgcn_readfirstlane(tid >> 6);
    const int dh = wave >> 1, dir = dh >> 1, hl = dh & 1, h = hp * 2 + hl, th = wave & 1;
    const int row0 = (isctx ? ML + b * NCTX : b * SEQ) + n * 64;
    LAS unsigned char* Vb = lds;
    LAS unsigned char* QK = lds + 24576;
    LAS unsigned char* SI = lds + 65536;
    LAS float* OB = (LAS float*)(lds + 90112);
#pragma unroll
    for (int i = 0; i < 2; ++i) { const int idx = tid + 512 * i, t = idx >> 4, hh = (idx >> 3) & 1, ch = idx & 7;
        *(LAS u32x4*)(Vb + hh * 12288 + t * 192 + ch * 16) = *(const u32x4*)(W.Z + (size_t)(row0 + t) * ZLD + 2304 + (hp * 2 + hh) * 64 + ch * 8); }
#pragma unroll
    for (int i = 0; i < 2; ++i) { const int idx = tid + 512 * i, q = idx >> 8, d = (idx >> 3) & 31, ch = idx & 7;
        const int qdir = q >> 1, qh = hp * 2 + (q & 1);
        const int c = qdir == 0 ? (isctx ? n : 4 + n) : (isctx ? 3 - n : 67 - n);
        const float* sp = W.ST + ((size_t)(((b * 2 + qdir) * NCHAIN + c) * 4 + qh)) * 2048 + d * 64 + ch * 8;
        const f32x4 s0 = *(const f32x4*)sp, s1 = *(const f32x4*)(sp + 4);
        u32x4 o; o.x = pk2(s0[0], s0[1]); o.y = pk2(s0[2], s0[3]); o.z = pk2(s1[0], s1[1]); o.w = pk2(s1[2], s1[3]);
        *(LAS u32x4*)(SI + q * 6144 + d * 192 + ch * 16) = o; }
    if (th == 0) {
        float bc[32], tot[32];
        GLA_LOADB(bc, tot, W, row0, dir, h, lane);
        const bf16_t* qp = W.Z + (size_t)(row0 + lane) * ZLD + 2048 + h * 32;
        LAS unsigned char* qi = QK + dh * 10240 + lane * 80; LAS unsigned char* ki = qi + 5120;
#pragma unroll
        for (int q = 0; q < 4; ++q) { const u32x4 qq = *(const u32x4*)(qp + 8 * q), kk = *(const u32x4*)(qp + 128 + 8 * q); u32x4 oq, ok;
#pragma unroll
            for (int e = 0; e < 4; ++e) { const int d = 8 * q + 2 * e; const float e0 = __expf(bc[d]), e1 = __expf(bc[d + 1]);
                oq[e] = pk2(bflo(qq[e]) * e0, bfhi(qq[e]) * e1); ok[e] = pk2(bflo(kk[e]) / e0, bfhi(kk[e]) / e1); }
            *(LAS u32x4*)(qi + q * 16) = oq; *(LAS u32x4*)(ki + q * 16) = ok; }
    }
    __syncthreads();
    const int i16 = lane & 15, gi = (lane >> 4) & 1, hi = lane >> 5, l31 = lane & 31;
    f32x16 o[2];
    {
        const LAS unsigned char* qib = QK + dh * 10240; const LAS unsigned char* kib = qib + 5120;
        bf16x8 qf[2];
#pragma unroll
        for (int s = 0; s < 2; ++s) qf[s] = *(const LAS bf16x8*)(qib + (32 * th + l31) * 80 + (2 * s + hi) * 16);
        f32x16 at[2];
#pragma unroll
        for (int st = 0; st < 2; ++st) { f32x16 a = {};
#pragma unroll
            for (int s = 0; s < 2; ++s) { const bf16x8 kf = *(const LAS bf16x8*)(kib + (32 * st + l31) * 80 + (2 * s + hi) * 16); a = MFMA32(kf, qf[s], a); }
            const int tq = 32 * th + l31;
#pragma unroll
            for (int r = 0; r < 16; ++r) { const int sk = 32 * st + (r & 3) + 8 * (r >> 2) + 4 * hi; const bool keep = dir == 0 ? (sk <= tq) : (sk >= tq); a[r] = keep ? a[r] : 0.f; }
            at[st] = a; }
        const LAS unsigned char* vb = Vb + hl * 12288 + (i16 >> 2) * 192 + (16 * gi + 4 * (i16 & 3)) * 2;
        const LAS unsigned char* sb = SI + dh * 6144 + (i16 >> 2) * 192 + (16 * gi + 4 * (i16 & 3)) * 2 + (8 * hi) * 192;
#pragma unroll
        for (int vt = 0; vt < 2; ++vt) {
            f32x16 acc = {};
#pragma unroll
            for (int st = 0; st < 2; ++st)
#pragma unroll
                for (int sk = 0; sk < 2; ++sk) { const int r0 = 32 * st + 16 * sk + 4 * hi;
                    const bf16x8 a = cat8(tr_read(vb + r0 * 192 + vt * 64), tr_read(vb + (r0 + 8) * 192 + vt * 64));
                    acc = MFMA32(a, pack_acc8(at[st], sk), acc); }
#pragma unroll
            for (int s = 0; s < 2; ++s) { const bf16x8 a = cat8(tr_read(sb + (16 * s) * 192 + vt * 64), tr_read(sb + (16 * s + 4) * 192 + vt * 64)); acc = MFMA32(a, qf[s], acc); }
            o[vt] = acc;
        }
    }
    if (dir == 1) {
#pragma unroll
        for (int vt = 0; vt < 2; ++vt)
#pragma unroll
            for (int r = 0; r < 16; ++r) { const int v = 32 * vt + (r & 3) + 8 * (r >> 2) + 4 * hi; OB[hl * 4096 + v * 64 + 32 * th + l31] = o[vt][r]; }
    }
    __syncthreads();
    if (dir == 0) {
        float ss = 0.f;
#pragma unroll
        for (int vt = 0; vt < 2; ++vt)
#pragma unroll
            for (int r = 0; r < 16; ++r) { const int v = 32 * vt + (r & 3) + 8 * (r >> 2) + 4 * hi; const float x = o[vt][r] + OB[hl * 4096 + v * 64 + 32 * th + l31]; o[vt][r] = x; ss += x * x; }
        ss += __shfl_xor(ss, 32);
        const float rinv = rsqrtf(ss * (1.f / 64.f) + EPS);
        const int row = row0 + 32 * th + l31;
#pragma unroll
        for (int vt = 0; vt < 2; ++vt)
#pragma unroll
            for (int r4 = 0; r4 < 4; ++r4) { const int v = 32 * vt + 8 * r4 + 4 * hi;
                const u32x2 gz = *(const u32x2*)(W.Z + (size_t)row * ZLD + 2560 + h * 64 + v);
                const f32x4 nw = *(const f32x4*)(W.prm + PRM_GNW + layer * 256 + h * 64 + v);
                const float a0 = o[vt][4 * r4] * rinv * nw[0] * silu_f(bflo(gz.x)), a1 = o[vt][4 * r4 + 1] * rinv * nw[1] * silu_f(bfhi(gz.x));
                const float a2 = o[vt][4 * r4 + 2] * rinv * nw[2] * silu_f(bflo(gz.y)), a3 = o[vt][4 * r4 + 3] * rinv * nw[3] * silu_f(bfhi(gz.y));
                u32x2 w; w.x = pk2(a0, a1); w.y = pk2(a2, a3);
                *(u32x2*)(W.Y + (size_t)row * 1024 + 768 + h * 64 + v) = w; }
    }
    __syncthreads();
}


__device__ __forceinline__ int wq_next(unsigned* ctr, int lane) { unsigned v = 0; if (lane == 0) v = __hip_atomic_fetch_add(ctr, 1u, __ATOMIC_RELAXED, __HIP_MEMORY_SCOPE_AGENT); return (int)__builtin_amdgcn_readfirstlane(v); }
#define LDSW_WAIT() asm volatile("s_waitcnt lgkmcnt(0)" ::: "memory")
__device__ __forceinline__ void gla_stage_v(const bf16_t* z0, int h, LAS unsigned char* Vw, int lane) {
    u32x4 vv[8]; const bf16_t* zp = z0 + (size_t)(lane >> 3) * ZLD + 2304 + h * 64 + 8 * (lane & 7);
#pragma unroll
    for (int i = 0; i < 8; ++i) vv[i] = *(const u32x4*)(zp + (size_t)(8 * i) * ZLD);
#pragma unroll
    for (int i = 0; i < 8; ++i) *(LAS u32x4*)(Vw + ((lane >> 3) + 8 * i) * 144 + (lane & 7) * 16) = vv[i];
}
__device__ __forceinline__ void gla_state_wave(const WS& W, int b, bool isctx, int n, int h, LAS unsigned char* ldsw, int) {
    int lane = (int)__builtin_amdgcn_mbcnt_hi(~0u, __builtin_amdgcn_mbcnt_lo(~0u, 0u)); asm volatile("" : "+v"(lane));
    const int row0 = (isctx ? ML + b * NCTX : b * SEQ) + n * 64;
    const bf16_t* z0 = W.Z + (size_t)row0 * ZLD;
    LAS unsigned char* Vw = ldsw; LAS unsigned char* KW = ldsw + 9216;
    LDSW_WAIT();
    const int pr = lane >> 3, pc = lane & 7;
    u32x4 vv[8]; u32x2 kk[8], la0[8], la1[8], tt0, tt1;
    { const bf16_t* zp = z0 + (size_t)(lane >> 3) * ZLD + 2304 + h * 64 + 8 * (lane & 7);
#pragma unroll
      for (int i = 0; i < 8; ++i) vv[i] = *(const u32x4*)(zp + (size_t)(8 * i) * ZLD); }
    const bf16_t* lb = (const bf16_t*)W.LA + (size_t)row0 * 256 + h * 32 + 4 * pc;
    tt0 = *(const u32x2*)(lb + (size_t)63 * 256); tt1 = *(const u32x2*)(lb + 128);
#pragma unroll
    for (int i = 0; i < 8; ++i) { kk[i] = *(const u32x2*)(z0 + (size_t)(pr + 8 * i) * ZLD + 2176 + h * 32 + 4 * pc);
        la0[i] = *(const u32x2*)(lb + (size_t)(pr + 8 * i) * 256); la1[i] = *(const u32x2*)(lb + (size_t)(pr + 8 * i) * 256 + 128); }
#pragma unroll
    for (int i = 0; i < 8; ++i) *(LAS u32x4*)(Vw + ((lane >> 3) + 8 * i) * 144 + (lane & 7) * 16) = vv[i];
    const int i16 = lane & 15, gi = (lane >> 4) & 1, hi = lane >> 5, l31 = lane & 31;
    const LAS unsigned char* kwb = KW + (8 * hi + (i16 >> 2)) * 80 + (16 * gi + 4 * (i16 & 3)) * 2;
    const LAS unsigned char* vb = Vw + (8 * hi + (i16 >> 2)) * 144 + (16 * gi + 4 * (i16 & 3)) * 2;
    LAS unsigned char* Tb = ldsw + 14336;
#define GS_DIR(DIR, LAX, TT) do { \
        const int c = (DIR) == 0 ? (isctx ? n : 4 + n) : (isctx ? 3 - n : 67 - n); \
        const size_t cbase = (size_t)(((b * 2 + (DIR)) * NCHAIN + c) * 4 + h); \
        f32x4 tot; { const f32x2 a_ = unpkh2(TT.x), b_ = unpkh2(TT.y); tot = (f32x4){a_[0], a_[1], b_[0], b_[1]}; } \
        _Pragma("unroll") for (int i = 0; i < 8; ++i) { f32x4 bb; { const f32x2 a_ = unpkh2(LAX[i].x), b_ = unpkh2(LAX[i].y); bb = (f32x4){a_[0], a_[1], b_[0], b_[1]}; } u32x2 o; \
            o.x = pk2(bflo(kk[i].x) * __expf(tot[0] - bb[0]), bfhi(kk[i].x) * __expf(tot[1] - bb[1])); o.y = pk2(bflo(kk[i].y) * __expf(tot[2] - bb[2]), bfhi(kk[i].y) * __expf(tot[3] - bb[3])); \
            *(LAS u32x2*)(KW + (pr + 8 * i) * 80 + pc * 8) = o; } \
        if (pr == 0) { const f32x4 o = {__expf(tot[0]), __expf(tot[1]), __expf(tot[2]), __expf(tot[3])}; *(f32x4*)(W.dec + cbase * 32 + 4 * pc) = o; } \
        LDSW_WAIT(); \
          \
        _Pragma("unroll") for (int vt = 0; vt < 2; ++vt) { f32x16 acc = {}; \
            _Pragma("unroll") for (int s = 0; s < 4; ++s) { \
                const bf16x8 a = cat8(tr_read(kwb + (16 * s) * 80), tr_read(kwb + (16 * s + 4) * 80)); \
                const bf16x8 bb = cat8(tr_read(vb + (16 * s) * 144 + vt * 64), tr_read(vb + (16 * s + 4) * 144 + vt * 64)); \
                acc = MFMA32(a, bb, acc); } \
            _Pragma("unroll") for (int g4 = 0; g4 < 4; ++g4) { u32x2 w; w.x = pkh2(acc[4 * g4], acc[4 * g4 + 1]); w.y = pkh2(acc[4 * g4 + 2], acc[4 * g4 + 3]); \
                *(LAS u32x2*)(Tb + (32 * vt + l31) * 64 + (8 * g4 + 4 * hi) * 2) = w; } } \
        LDSW_WAIT(); \
        { bf16_t* stp = (bf16_t*)W.ST + cbase * 2048; \
          _Pragma("unroll") for (int i = 0; i < 4; ++i) *(u32x4*)(stp + (lane + 64 * i) * 8) = *(const LAS u32x4*)(Tb + (lane + 64 * i) * 16); } \
    } while (0)
    GS_DIR(0, la0, tt0);
    LDSW_WAIT();
    GS_DIR(1, la1, tt1);
#undef GS_DIR
}
__device__ __forceinline__ void gla_out_wave(const Params& p, const WS& W, int layer, int b, bool isctx, int n, int h, LAS unsigned char* ldsw, int) {
    int lane = (int)__builtin_amdgcn_mbcnt_hi(~0u, __builtin_amdgcn_mbcnt_lo(~0u, 0u)); asm volatile("" : "+v"(lane));
    const int row0 = (isctx ? ML + b * NCTX : b * SEQ) + n * 64;
    const bf16_t* z0 = W.Z + (size_t)row0 * ZLD;
    LAS unsigned char* Vw = ldsw; LAS unsigned char* QI = ldsw + 9216; LAS unsigned char* KI = ldsw + 14336;
    const int cf = isctx ? n : 4 + n, cb_ = isctx ? 3 - n : 67 - n;
    const bf16_t* sp0 = (const bf16_t*)W.ST + ((size_t)(((b * 2 + 0) * NCHAIN + cf) * 4 + h)) * 2048;
    const bf16_t* sp1 = (const bf16_t*)W.ST + ((size_t)(((b * 2 + 1) * NCHAIN + cb_) * 4 + h)) * 2048;
    float pf0 = 0.f, pf1 = 0.f;
    if (PROBE_PH < 0) { pf0 = *(const float*)(sp0 + lane * 32); pf1 = *(const float*)(sp1 + lane * 32); }
    LDSW_WAIT();
    const int pr = lane >> 3, pc = lane & 7;
    const int i16 = lane & 15, gi = (lane >> 4) & 1, hi = lane >> 5, l31 = lane & 31;
    u32x4 vv[8]; u32x2 qr[8], kr[8], la0[8], la1[8];
    { const bf16_t* zp = z0 + (size_t)(lane >> 3) * ZLD + 2304 + h * 64 + 8 * (lane & 7);
#pragma unroll
      for (int i = 0; i < 8; ++i) vv[i] = *(const u32x4*)(zp + (size_t)(8 * i) * ZLD); }
#pragma unroll
    for (int i = 0; i < 8; ++i) { const bf16_t* zp = z0 + (size_t)(pr + 8 * i) * ZLD + 2048 + h * 32 + 4 * pc; qr[i] = *(const u32x2*)zp; kr[i] = *(const u32x2*)(zp + 128);
        const bf16_t* lb = (const bf16_t*)W.LA + (size_t)(row0 + pr + 8 * i) * 256 + h * 32 + 4 * pc; la0[i] = *(const u32x2*)lb; la1[i] = *(const u32x2*)(lb + 128); }
#pragma unroll
    for (int i = 0; i < 8; ++i) *(LAS u32x4*)(Vw + ((lane >> 3) + 8 * i) * 144 + (lane & 7) * 16) = vv[i];
    const LAS unsigned char* vb = Vw + (i16 >> 2) * 144 + (16 * gi + 4 * (i16 & 3)) * 2;
    f32x16 o[2][2];
#pragma unroll
    for (int vt = 0; vt < 2; ++vt) { o[vt][0] = (f32x16){}; o[vt][1] = (f32x16){}; }
    bf16x8 sf[2][2];
#define GO_PREP(LAX, OQ, OK) _Pragma("unroll") for (int i = 0; i < 8; ++i) { const f32x2 a_ = unpkh2(LAX[i].x), b_ = unpkh2(LAX[i].y); \
            const float e0 = __expf(a_[0]), e1 = __expf(a_[1]), e2 = __expf(b_[0]), e3 = __expf(b_[1]); const u32x2 qv = qr[i], kv = kr[i]; \
            OQ[i].x = pk2(bflo(qv.x) * e0, bfhi(qv.x) * e1); OQ[i].y = pk2(bflo(qv.y) * e2, bfhi(qv.y) * e3); \
            OK[i].x = pk2(bflo(kv.x) * __builtin_amdgcn_rcpf(e0), bfhi(kv.x) * __builtin_amdgcn_rcpf(e1)); OK[i].y = pk2(bflo(kv.y) * __builtin_amdgcn_rcpf(e2), bfhi(kv.y) * __builtin_amdgcn_rcpf(e3)); }
#define GO_PUT(OQ, OK) _Pragma("unroll") for (int i = 0; i < 8; ++i) { *(LAS u32x2*)(QI + (pr + 8 * i) * 80 + pc * 8) = OQ[i]; *(LAS u32x2*)(KI + (pr + 8 * i) * 80 + pc * 8) = OK[i]; }
#define GO_SF(SP) _Pragma("unroll") for (int vt = 0; vt < 2; ++vt) _Pragma("unroll") for (int s = 0; s < 2; ++s) sf[vt][s] = *(const bf16x8*)((SP) + (32 * vt + l31) * 32 + 16 * s + 8 * hi)
#define GO_MMA(DIR) _Pragma("unroll") for (int tt = 0; tt < 2; ++tt) { bf16x8 qf[2]; \
            _Pragma("unroll") for (int s = 0; s < 2; ++s) qf[s] = *(const LAS bf16x8*)(QI + (32 * tt + l31) * 80 + (2 * s + hi) * 16); \
            _Pragma("unroll") for (int st = 0; st < 2; ++st) { f32x16 at = (f32x16){}; \
                _Pragma("unroll") for (int s = 0; s < 2; ++s) { const bf16x8 kf = *(const LAS bf16x8*)(KI + (32 * st + l31) * 80 + (2 * s + hi) * 16); at = MFMA32(kf, qf[s], at); } \
                _Pragma("unroll") for (int r = 0; r < 16; ++r) { const int sk = 32 * st + (r & 3) + 8 * (r >> 2) + 4 * hi, tq = 32 * tt + l31; const bool keep = (DIR) == 0 ? (sk <= tq) : (sk >= tq); at[r] = keep ? at[r] : 0.f; } \
                _Pragma("unroll") for (int sk = 0; sk < 2; ++sk) { const int r0 = 32 * st + 16 * sk + 4 * hi; const bf16x8 pp = pack_acc8(at, sk); \
                    _Pragma("unroll") for (int vt = 0; vt < 2; ++vt) { const bf16x8 a = cat8(tr_read(vb + r0 * 144 + vt * 64), tr_read(vb + (r0 + 8) * 144 + vt * 64)); o[vt][tt] = MFMA32(a, pp, o[vt][tt]); } } } \
            _Pragma("unroll") for (int vt = 0; vt < 2; ++vt) _Pragma("unroll") for (int s = 0; s < 2; ++s) o[vt][tt] = MFMA32(sf[vt][s], qf[s], o[vt][tt]); }
    u32x2 oq0[8], ok0[8], oq1[8], ok1[8];
    GO_PREP(la0, oq0, ok0);
    GO_PUT(oq0, ok0);
    GO_PREP(la1, oq1, ok1);
    GO_SF(sp0);
    LDSW_WAIT();
    GO_MMA(0);
    LDSW_WAIT();
    GO_PUT(oq1, ok1);
    GO_SF(sp1);
    int le = lane; asm volatile("" : "+v"(le));
    u32x4 gq[8];
#pragma unroll
    for (int i = 0; i < 8; ++i) gq[i] = *(const u32x4*)(z0 + (size_t)((le >> 3) + 8 * i) * ZLD + 2560 + h * 64 + 8 * (le & 7));
    LDSW_WAIT();
    GO_MMA(1);
#undef GO_PREP
#undef GO_PUT
#undef GO_SF
#undef GO_MMA
    LDSW_WAIT();
    {
#pragma unroll
        for (int i = 0; i < 8; ++i) *(LAS u32x4*)(Vw + ((le >> 3) + 8 * i) * 144 + (le & 7) * 16) = gq[i];
        LDSW_WAIT();
        float rinv[2];
#pragma unroll
        for (int tt = 0; tt < 2; ++tt) {
            float ss = 0.f;
#pragma unroll
            for (int vt = 0; vt < 2; ++vt)
#pragma unroll
                for (int r = 0; r < 16; ++r) ss += o[vt][tt][r] * o[vt][tt][r];
            ss += __shfl_xor(ss, 32);
            rinv[tt] = rsqrtf(ss * (1.f / 64.f) + EPS);
        }
#pragma unroll
        for (int vt = 0; vt < 2; ++vt)
#pragma unroll
            for (int r4 = 0; r4 < 4; ++r4) { const int v = 32 * vt + 8 * r4 + 4 * hi;
                const f32x4 nw = *(const f32x4*)(W.prm + PRM_GNW + layer * 256 + h * 64 + v);
#pragma unroll
                for (int tt = 0; tt < 2; ++tt) { LAS unsigned char* rowp = Vw + (32 * tt + l31) * 144;
                    const u32x2 gz = *(const LAS u32x2*)(rowp + v * 2);
                    const float a0 = o[vt][tt][4 * r4] * rinv[tt] * nw[0] * silu_f(bflo(gz.x)), a1 = o[vt][tt][4 * r4 + 1] * rinv[tt] * nw[1] * silu_f(bfhi(gz.x));
                    const float a2 = o[vt][tt][4 * r4 + 2] * rinv[tt] * nw[2] * silu_f(bflo(gz.y)), a3 = o[vt][tt][4 * r4 + 3] * rinv[tt] * nw[3] * silu_f(bfhi(gz.y));
                    u32x2 w; w.x = pk2(a0, a1); w.y = pk2(a2, a3);
                    *(LAS u32x2*)(rowp + v * 2) = w; }
                __builtin_amdgcn_sched_barrier(0); }
        LDSW_WAIT();
#pragma unroll
        for (int i = 0; i < 8; ++i) { const int tr = (le >> 3) + 8 * i;
            *(u32x4*)(W.Y + (size_t)(row0 + tr) * 1024 + 768 + h * 64 + 8 * (le & 7)) = *(const LAS u32x4*)(Vw + tr * 144 + (le & 7) * 16); }
    }
    asm volatile("" :: "v"(pf0), "v"(pf1));
}

#if (PROBE_PH >= 21 && PROBE_PH <= 23) || PROBE_PH == 41 || PROBE_PH == 42
#define ATT_PROBE_ARG , unsigned long long& g_probe_acc
#define ATT_PROBE_PASS , g_probe_acc
#else
#define ATT_PROBE_ARG
#define ATT_PROBE_PASS
#endif
constexpr float ATT_PMAX = 65536.f;
struct AttPre { u32x4 q[8]; u32x4 k0, v0, k1, v1; };
__device__ __forceinline__ void att_prefetch(const WS& W, int b, int g, int qb, bool isctx, int tid, AttPre& pre) {
    const int lane = tid & 63, wave = tid >> 6, head = g * 4 + (wave >> 1);
    const int seqbase = isctx ? ML + b * NCTX : b * SEQ, tq0 = qb * 128 + (wave & 1) * 64;
#pragma unroll
    for (int i = 0; i < 8; ++i) { const int qr = (lane >> 3) + 8 * i, cq = lane & 7;
        pre.q[i] = *(const u32x4*)(W.Z + (size_t)(seqbase + tq0 + qr) * ZLD + 768 + 256 * (head >> 2) + 128 * (cq >> 2) + 32 * (head & 3) + 8 * (cq & 3)); }
    const int kvr = tid >> 3, ch = tid & 7;
    const bf16_t* src = W.Z + (size_t)(ML + b * NCTX + kvr) * ZLD + 1280 + 128 * (ch >> 2) + 32 * g + 8 * (ch & 3);
    pre.k0 = *(const u32x4*)src; pre.v0 = *(const u32x4*)(src + 64); pre.k1 = *(const u32x4*)(src + (size_t)64 * ZLD); pre.v1 = *(const u32x4*)(src + (size_t)64 * ZLD + 64);
}
__device__ __forceinline__ void attn_unit(const Params& p, const WS& W, int layer, int b, int g, int qb, bool isctx, LAS unsigned char* lds, AttPre& pre, bool has_next, int nb, int ng, int nqb ATT_PROBE_ARG) {
    int tid_ = threadIdx.x; asm volatile("" : "+v"(tid_)); const int tid = tid_, lane = tid & 63, wave = __builtin_amdgcn_readfirstlane(tid >> 6);
#if PROBE_PH == 41 || PROBE_PH == 42
    const unsigned long long tu0 = __builtin_amdgcn_s_memrealtime();
#endif
    const int l31 = lane & 31, hi = lane >> 5, i16 = lane & 15, gi = (lane >> 4) & 1;
    const int head = g * 4 + (wave >> 1);
    const int seqbase = isctx ? ML + b * NCTX : b * SEQ;
    const int q0 = qb * 128, tq0 = q0 + (wave & 1) * 64;
    constexpr int KB = 64 * 144, VB = 64 * 192, STG = KB + VB;
    LAS unsigned char* Qw = lds + 3 * STG + wave * 9216;
#pragma unroll
    for (int i = 0; i < 8; ++i) { const int qr = (lane >> 3) + 8 * i, cq = lane & 7; *(LAS u32x4*)(Qw + qr * 144 + cq * 16) = pre.q[i]; }
    const float pfg = PROBE_PH >= 0 ? 0.f : __uint_as_float(*(const unsigned*)(W.Z + (size_t)(seqbase + tq0 + lane) * ZLD + 1536 + head * 64));
    const int jlo = isctx ? 0 : (qb == 0 ? 2 : 0), jhi = isctx ? -1 : (qb == 31 ? 3 : 5);
    const int NT = 4 + (jhi - jlo + 1);
    const int kvr = tid >> 3, ch = tid & 7;
    const int gcolK = 1280 + 128 * (ch >> 2) + 32 * g + 8 * (ch & 3);
    const int ctxbase = ML + b * NCTX;
    const float sink2 = W.prm[PRM_SINK + layer * 8 + head] * LOG2E;
    float mref[2] = {sink2, sink2}, lsum[2] = {hi == 0 ? 1.f : 0.f, hi == 0 ? 1.f : 0.f};
    f32x16 negm[2];
#pragma unroll
    for (int r = 0; r < 16; ++r) { negm[0][r] = -sink2; negm[1][r] = -sink2; }
    asm volatile("" : "+v"(negm[0]), "+v"(negm[1]));
    f32x16 O[2][2];
#pragma unroll
    for (int dt = 0; dt < 2; ++dt)
#pragma unroll
        for (int ct = 0; ct < 2; ++ct) O[dt][ct] = (f32x16){};
    u32x4 kregA, vregA;
#define ATT_KROW(ti) ((ti) < 4 ? ctxbase + 64 * (ti) : b * SEQ + q0 - 128 + 64 * (jlo + (ti) - 4))
#define ATT_LOADR(ti, R) do { const bf16_t* src_ = W.Z + (size_t)(ATT_KROW(ti) + kvr) * ZLD + gcolK; kreg##R = *(const u32x4*)src_; vreg##R = *(const u32x4*)(src_ + 64); } while (0)
#define ATT_STORER(st, R) do { *(LAS u32x4*)(lds + (st) * STG + kvr * 144 + ch * 16) = kreg##R; *(LAS u32x4*)(lds + (st) * STG + KB + kvr * 192 + ch * 16) = vreg##R; } while (0)
    const int wh = wave & 1;
    const int sA = isctx ? 0 : jlo, eA = isctx ? -1 : (jhi < 4 ? jhi : 4), sB = isctx ? 0 : (jlo > 1 ? jlo : 1), eB = jhi;
    const int NLS = isctx ? 0 : ((eA - sA > eB - sB ? eA - sA : eB - sB) + 1);
    const int NS = 4 + NLS;
    const int s_h = wh ? sB : sA, e_h = wh ? eB : eA;
    kregA = pre.k0; vregA = pre.v0; ATT_STORER(0, A);
    kregA = pre.k1; vregA = pre.v1; ATT_STORER(1, A);
    ATT_LOADR(2, A);
    __syncthreads();
#if PROBE_PH == 41
    if (layer == 1) g_probe_acc += __builtin_amdgcn_s_memrealtime() - tu0;
#endif
    for (int t2 = 0; t2 < NS; ++t2) {
        { const int TI_ = t2 < 4 ? t2 : 4 + (s_h + (t2 - 4) - jlo);
          const int st = TI_ % 3;
#if PROBE_PH >= 21 && PROBE_PH <= 23
        const unsigned long long ts0 = __builtin_amdgcn_s_memrealtime();
#endif
        bool active = true, need_mask = false; int k0 = 0;
        if (t2 >= 4) { const int j_ = s_h + (t2 - 4); k0 = q0 - 128 + 64 * j_; active = j_ <= e_h; need_mask = !((k0 >= tq0 - 65) && (k0 <= tq0 + 65)); }
        if (active) {
            const LAS unsigned char* Kb = lds + st * STG; const LAS unsigned char* Vbp = Kb + KB;
            f32x16 s[2][2];
#pragma unroll
            for (int ds = 0; ds < 4; ++ds) {
                const bf16x8 q0f = *(const LAS bf16x8*)(Qw + l31 * 144 + (2 * ds + hi) * 16), q1f = *(const LAS bf16x8*)(Qw + (32 + l31) * 144 + (2 * ds + hi) * 16);
#pragma unroll
                for (int rt = 0; rt < 2; ++rt) { const bf16x8 kf = *(const LAS bf16x8*)(Kb + (32 * rt + l31) * 144 + (2 * ds + hi) * 16);
                    s[rt][0] = MFMA32(kf, q0f, ds == 0 ? negm[0] : s[rt][0]); s[rt][1] = MFMA32(kf, q1f, ds == 0 ? negm[1] : s[rt][1]); }
            }
            if (need_mask) {
#pragma unroll
                for (int rt = 0; rt < 2; ++rt)
#pragma unroll
                    for (int ct = 0; ct < 2; ++ct)
#pragma unroll
                        for (int r = 0; r < 16; ++r) { const int kp = k0 + 32 * rt + (r & 3) + 8 * (r >> 2) + 4 * hi, qp = tq0 + 32 * ct + l31; const int dd = qp - kp;
                            if (dd > 128 || dd < -128) s[rt][ct][r] = -1e30f; }
            }
            float ls[2];
#pragma unroll
            for (int ct = 0; ct < 2; ++ct) {
#pragma unroll
                for (int rt = 0; rt < 2; ++rt)
#pragma unroll
                    for (int r = 0; r < 16; ++r) s[rt][ct][r] = __builtin_amdgcn_exp2f(s[rt][ct][r]);
                float a_ = s[0][ct][0] + s[0][ct][1], b_ = s[1][ct][0] + s[1][ct][1];
                asm("" : "+v"(a_)); asm("" : "+v"(b_));
#pragma unroll
                for (int r = 2; r < 16; ++r) { a_ += s[0][ct][r]; asm("" : "+v"(a_)); b_ += s[1][ct][r]; asm("" : "+v"(b_)); }
                ls[ct] = a_ + b_;
            }
            if (__builtin_expect(__any((ls[0] > ATT_PMAX) || (ls[1] > ATT_PMAX)), 0)) {
#pragma unroll
                for (int ct = 0; ct < 2; ++ct) {
                    float m_ = s[0][ct][0];
#pragma unroll
                    for (int r = 1; r < 16; ++r) m_ = fmaxf(m_, s[0][ct][r]);
#pragma unroll
                    for (int r = 0; r < 16; ++r) m_ = fmaxf(m_, s[1][ct][r]);
                    m_ = fmaxf(m_, __shfl_xor(m_, 32));
                    const float d_ = fmaxf(__builtin_amdgcn_logf(m_), 0.f); mref[ct] += d_; const float al = __builtin_amdgcn_exp2f(-d_);
#pragma unroll
                    for (int rt = 0; rt < 2; ++rt) s[rt][ct] = s[rt][ct] * al;
                    ls[ct] *= al; lsum[ct] *= al;
#pragma unroll
                    for (int dt = 0; dt < 2; ++dt) O[dt][ct] = O[dt][ct] * al;
#pragma unroll
                    for (int r = 0; r < 16; ++r) negm[ct][r] = -mref[ct];
                }
            }
            lsum[0] += ls[0]; lsum[1] += ls[1];
            const LAS unsigned char* vb = Vbp + (i16 >> 2) * 192 + (16 * gi + 4 * (i16 & 3)) * 2;
#pragma unroll
            for (int rt = 0; rt < 2; ++rt)
#pragma unroll
                for (int sk = 0; sk < 2; ++sk) {
                    const bf16x8 p0 = pack_acc8(s[rt][0], sk), p1 = pack_acc8(s[rt][1], sk);
                    const int r0 = 32 * rt + 16 * sk + 4 * hi;
#pragma unroll
                    for (int dt = 0; dt < 2; ++dt) { const bf16x8 vf = cat8(tr_read(vb + r0 * 192 + dt * 64), tr_read(vb + (r0 + 8) * 192 + dt * 64));
                        O[dt][0] = MFMA32(vf, p0, O[dt][0]); O[dt][1] = MFMA32(vf, p1, O[dt][1]); }
                }
        }
#if PROBE_PH >= 21 && PROBE_PH <= 23
        __builtin_amdgcn_sched_barrier(0); const unsigned long long ts1 = __builtin_amdgcn_s_memrealtime(); __builtin_amdgcn_sched_barrier(0);
#endif
        if (t2 + 2 < NT) ATT_STORER((t2 + 2) % 3, A);
        if (t2 + 3 < NT) ATT_LOADR(t2 + 3, A);
#if PROBE_PH >= 21 && PROBE_PH <= 23
        asm volatile("s_waitcnt lgkmcnt(0)" ::: "memory"); __builtin_amdgcn_sched_barrier(0); const unsigned long long ts2 = __builtin_amdgcn_s_memrealtime(); __builtin_amdgcn_sched_barrier(0);
#endif
        __syncthreads();
#if PROBE_PH >= 21 && PROBE_PH <= 23
        { const unsigned long long ts3 = __builtin_amdgcn_s_memrealtime(); if (layer == 1) g_probe_acc += (PROBE_PH == 21 ? ts1 - ts0 : PROBE_PH == 22 ? ts2 - ts1 : ts3 - ts2); }
#endif
        }
    }
#undef ATT_KROW
#undef ATT_LOADR
#undef ATT_STORER
#if PROBE_PH == 42
    const unsigned long long tu1 = __builtin_amdgcn_s_memrealtime();
#endif
    if (has_next) att_prefetch(W, nb, ng, nqb, false, tid, pre);
    {
        int le = lane; asm volatile("" : "+v"(le));
        u32x4 gq[8];
#pragma unroll
        for (int i = 0; i < 8; ++i) gq[i] = *(const u32x4*)(W.Z + (size_t)(seqbase + tq0 + (le >> 3) + 8 * i) * ZLD + 1536 + head * 64 + 8 * (le & 7));
#pragma unroll
        for (int i = 0; i < 8; ++i) *(LAS u32x4*)(Qw + ((le >> 3) + 8 * i) * 144 + (le & 7) * 16) = gq[i];
        asm volatile("s_waitcnt lgkmcnt(0)" ::: "memory");
#pragma unroll
        for (int ct = 0; ct < 2; ++ct) {
            const float lt = lsum[ct] + __shfl_xor(lsum[ct], 32); const float inv = __builtin_amdgcn_rcpf(lt);
            LAS unsigned char* rowp = Qw + (32 * ct + l31) * 144;
#pragma unroll
            for (int dt = 0; dt < 2; ++dt)
#pragma unroll
                for (int r4 = 0; r4 < 4; ++r4) { const int d = 32 * dt + 8 * r4 + 4 * hi;
                    const u32x2 gz = *(const LAS u32x2*)(rowp + d * 2);
                    const float a0 = O[dt][ct][4 * r4] * inv * silu_f(bflo(gz.x)), a1 = O[dt][ct][4 * r4 + 1] * inv * silu_f(bfhi(gz.x));
                    const float a2 = O[dt][ct][4 * r4 + 2] * inv * silu_f(bflo(gz.y)), a3 = O[dt][ct][4 * r4 + 3] * inv * silu_f(bfhi(gz.y));
                    u32x2 w; w.x = pk2(a0, a1); w.y = pk2(a2, a3);
                    *(LAS u32x2*)(rowp + d * 2) = w; }
        }
        asm volatile("s_waitcnt lgkmcnt(0)" ::: "memory");
#pragma unroll
        for (int i = 0; i < 8; ++i) { const int qr = (le >> 3) + 8 * i;
            *(u32x4*)(W.Y + (size_t)(seqbase + tq0 + qr) * 1024 + 256 + head * 64 + 8 * (le & 7)) = *(const LAS u32x4*)(Qw + qr * 144 + (le & 7) * 16); }
    }
    asm volatile("" :: "v"(pfg));
#if PROBE_PH == 42
    asm volatile("s_waitcnt vmcnt(0)" ::: "memory"); if (layer == 1) g_probe_acc += __builtin_amdgcn_s_memrealtime() - tu1;
#endif
}

__device__ __forceinline__ void phase_final(const Params& p, const WS& W) {
    int tid_ = threadIdx.x; asm volatile("" : "+v"(tid_)); const int tid = tid_, lane = tid & 63, wave = tid >> 6;
    const int gw = blockIdx.x * 8 + wave, NGW = gridDim.x * 8;
    f32x4 fw[4];
#pragma unroll
    for (int j = 0; j < 4; ++j) fw[j] = *(const f32x4*)(p.final_norm_w + j * 256 + lane * 4);
    for (int row = gw; row < ML; row += NGW) {
        const float rinv = rsqrtf(W.rss2[row] * (1.f / 1024.f) + EPS);
        float* xr = p.out + (size_t)row * 1024;
#pragma unroll
        for (int j = 0; j < 4; ++j) { const f32x4 v = *(const f32x4*)(xr + j * 256 + lane * 4); *(f32x4*)(xr + j * 256 + lane * 4) = v * rinv * fw[j]; }
    }
}

__device__ __forceinline__ int q_next(unsigned* ctr, volatile LAS unsigned* slot) {
    __syncthreads();
    if (threadIdx.x == 0) *slot = __hip_atomic_fetch_add(ctr, 1u, __ATOMIC_RELAXED, __HIP_MEMORY_SCOPE_AGENT);
    __syncthreads();
    return (int)*slot;
}
#define QCTR(k) ((unsigned*)(wsb + WS_CTL) + 4096 + 64 * (k))

__global__ void __launch_bounds__(512, 2) fwd_kernel(Params p) {
    extern __shared__ __attribute__((aligned(16))) unsigned char lds_raw[];
    LAS unsigned char* lds = (LAS unsigned char*)lds_raw;
    const int G = gridDim.x;
    volatile LAS unsigned* bst = (volatile LAS unsigned*)(lds + CTLW_OFF + 512);
    if (threadIdx.x < 2) bst[threadIdx.x] = 0u;
    __syncthreads();
    XcdBarrier xbar = xcd_barrier_post((unsigned*)(p.ws + WS_CTL), bst);
    volatile LAS unsigned* qslot = (volatile LAS unsigned*)(lds + CTLW_OFF + 640);
#if PROBE_PH >= 0
    volatile LAS unsigned long long* tps = (volatile LAS unsigned long long*)(lds + CTLW_OFF + 768); if (threadIdx.x < 4) tps[threadIdx.x] = 0ull;
    unsigned long long g_probe_acc = 0;
#endif
    for (int ph = p.ph_lo; ph < p.ph_hi; ++ph) {
        if (ph > p.ph_lo && !(MERGE12 && ph >= 2 && (ph - 2) % 5 == 2)) {
#if USE_CG_SYNC
            cg::this_grid().sync();
#else
            xcd_barrier(xbar);
#if DUP_SUB == 30
            xcd_barrier(xbar); xcd_barrier(xbar); xcd_barrier(xbar); xcd_barrier(xbar);
#endif
#endif
        }
#if PROBE_PH >= 0
        if (threadIdx.x == 0) { if (ph == (PROBE_PH == 34 ? 9 : PROBE_PH)) tps[0] = __builtin_amdgcn_s_memrealtime(); if (ph == PROBE_PH + 1) tps[1] = __builtin_amdgcn_s_memrealtime(); }
#if PROBE_PH == 50
        if (threadIdx.x == 0) tps[3] = (unsigned long long)ph;
        __syncthreads();
#endif
#endif
        size_t zoff = 0; asm volatile("" : "+s"(zoff)); unsigned char* wsb = p.ws + zoff;
        int bx = blockIdx.x; asm volatile("" : "+s"(bx));
        const WS W = make_ws(wsb);
        if (RUNSUB(10) && ph == 0) { for (int rep = 0; rep < NREP(10); ++rep) { phase_prep0(p, W, lds); __syncthreads(); } }
        else if (RUNSUB(11) && ph == 1) { for (int rep = 0; rep < NREP(11); ++rep) phase_prep1(p, W); }
        else if (ph >= 2 && ph < 12) {
            const int layer = (ph - 2) / 5, sub = (ph - 2) % 5;
            if (RUNSUB(0) && sub == 0) {
                unsigned* gate_cnt = (unsigned*)(wsb + WS_CTL) + 4096 + 64 * 40;
                { int tr_ = threadIdx.x; asm volatile("" : "+v"(tr_)); *(LAS f32x4*)(lds + 131072 + 16 * tr_) = *(const f32x4*)(W.rope + 4 * tr_); }
                if (layer == 1 && bx >= G - 32) {
                    const int ci = bx - (G - 32);
                    pg8::Gemm gmo{W.Y, W.WoutT, MT, 1024, 1024}; pg8::OneUnit S1{128 + (ci >> 2), ci & 3, gate_cnt};
                    pg8::EpiOut Eo{p.x, p.ctx, (bf16_t*)(wsb + WS_X1H), W.modv, W.modv + 9 * 3072, W.A, W.rss1};
                    pg8::gemm_phase<pg8::EpiOut, pg8::OneUnit, true, true>(lds, gmo, S1, Eo);
                }
                pg8::Gemm gm{W.A, W.WinT + (size_t)layer * NPAD * 1024, MT, NPAD, 1024}; pg8::GatedOrder S; S.init(MT, NPAD, G, bx); S.pm_gate = layer == 1 ? 128 : (1 << 30); S.cnt = gate_cnt; S.need = 256u;
                pg8::EpiIn E{W.Z, W.LA, layer == 0 ? W.rss0 : W.rss1, W.biasz + layer * 9 * NPAD, (const LAS float*)(lds + 131072)};
                S.nfull = layer == 0 ? 6 : 5; S.nextra = layer == 0 ? 0 : G - 32;
                if (layer == 0 && bx >= 192) {
                    int tw_ = threadIdx.x; asm volatile("" : "+v"(tw_)); bias1_tasks(p, W, (bx - 192) * 8 + (tw_ >> 6), (G - 192) * 8, tw_ & 63); }
                pg8::gemm_phase<pg8::EpiIn, pg8::GatedOrder, true, true>(lds, gm, S, E);
            } else if (sub == 1) {
                { int tw_ = threadIdx.x; asm volatile("" : "+v"(tw_)); const int lane = tw_ & 63, wv = __builtin_amdgcn_readfirstlane(tw_ >> 6);
                  if (RUNSUB(5)) for (int rep = 0; rep < NREP(5); ++rep) _Pragma("unroll 1") for (int it = 0, u; it < 2 && (u = it == 0 ? bx * 8 + wv : (wv == 0 && bx < 128 ? 2048 + bx : 1 << 30)) < 2176; ++it) { if (u < 2048) gla_state_wave(W, u >> 8, false, (u >> 2) & 63, u & 3, lds + wv * WREG, lane); else { const int v = u - 2048; gla_state_wave(W, v >> 4, true, (v >> 2) & 3, v & 3, lds + wv * WREG, lane); } }
                }
                if (MERGE12) {
                    asm volatile("s_waitcnt vmcnt(0)" ::: "memory"); __syncthreads();
                    if (threadIdx.x == 0) { __builtin_amdgcn_fence(__ATOMIC_RELEASE, "agent"); __hip_atomic_fetch_add(QCTR(44 + layer), 1u, __ATOMIC_RELAXED, __HIP_MEMORY_SCOPE_AGENT); }
                } else __syncthreads();
                if (RUNSUB(1)) for (int rep = 0; rep < NREP(1); ++rep) for (int u = bx; u < 512; u += G) conv_unit(p, W, layer, u >> 6, u & 63, lds);
            } else if (sub == 2) {
                const int natt = layer == 0 ? 576 : 512;
                if (RUNSUB(2)) {
                    int ta_ = threadIdx.x; asm volatile("" : "+v"(ta_));
                    AttPre pre;
                    for (int u = 2 * bx; u < 512; u += 2 * G) {
                        att_prefetch(W, u >> 6, (u >> 5) & 1, u & 31, false, ta_, pre);
#if PROBE_PH >= 31 && PROBE_PH <= 34
                        const unsigned long long tq0_ = __builtin_amdgcn_s_memrealtime();
#endif
                        attn_unit(p, W, layer, u >> 6, (u >> 5) & 1, u & 31, false, lds, pre, true, (u + 1) >> 6, ((u + 1) >> 5) & 1, (u + 1) & 31 ATT_PROBE_PASS);
#if PROBE_PH == 31
                        if (layer == 1) g_probe_acc = __builtin_amdgcn_s_memrealtime() - tq0_;
#endif
                        attn_unit(p, W, layer, (u + 1) >> 6, ((u + 1) >> 5) & 1, (u + 1) & 31, false, lds, pre, false, 0, 0, 0 ATT_PROBE_PASS);
#if PROBE_PH == 32
                        if (layer == 1) g_probe_acc = __builtin_amdgcn_s_memrealtime() - tq0_;
#endif
#if PROBE_PH >= 33 && PROBE_PH <= 34
                        if (layer == 1) g_probe_acc = tq0_;
#endif
                    }
                    for (int u; (u = q_next(QCTR(layer * 4 + 2), qslot)) < natt - 512 + 128;) {
                        if (u >= natt - 512) {
                            if (MERGE12) {
                                if (threadIdx.x < 64) { unsigned sp_ = 0;
                                    while ((unsigned)__builtin_amdgcn_readfirstlane(__hip_atomic_load(QCTR(44 + layer), __ATOMIC_RELAXED, __HIP_MEMORY_SCOPE_AGENT)) < (unsigned)G) { __builtin_amdgcn_s_sleep(2); if (++sp_ > (1u << 22)) break; }
                                    __builtin_amdgcn_fence(__ATOMIC_ACQUIRE, "agent"); asm volatile("s_waitcnt vmcnt(0)" ::: "memory"); }
                                __syncthreads();
                            }
                            gla_scan(W, u - (natt - 512)); }
                        else if (u < 32) { att_prefetch(W, u >> 2, (u >> 1) & 1, u & 1, true, ta_, pre); attn_unit(p, W, layer, u >> 2, (u >> 1) & 1, u & 1, true, lds, pre, false, 0, 0, 0 ATT_PROBE_PASS); }
                        else { const int v = u - 32; conv_unit(p, W, layer, 8 + (v >> 2), v & 3, lds); } }
#if PROBE_PH == 33
                    if (layer == 1) g_probe_acc = __builtin_amdgcn_s_memrealtime() - g_probe_acc;
#endif
                }
            } else if (sub == 3) {
                const int nu = layer == 0 ? 2176 : 2048;
                { int tw_ = threadIdx.x; asm volatile("" : "+v"(tw_)); const int lane = tw_ & 63, wv = __builtin_amdgcn_readfirstlane(tw_ >> 6);
                  if (RUNSUB(3)) for (int rep = 0; rep < NREP(3); ++rep) _Pragma("unroll 1") for (int it = 0, u; it < 2 && (u = it == 0 ? bx * 8 + wv : (wv == 0 && bx < 128 ? 2048 + bx : 1 << 30)) < nu; ++it) { if (u < 2048) gla_out_wave(p, W, layer, u >> 8, false, (u >> 2) & 63, u & 3, lds + wv * WREG, lane); else { const int v = u - 2048; gla_out_wave(p, W, layer, v >> 4, true, (v >> 2) & 3, v & 3, lds + wv * WREG, lane); } } }
            } else {
                if (!RUNSUB(4) && !RUNSUB(6)) {} else if (layer == 0) {
                    if (RUNSUB(4)) {
                    pg8::Gemm gm{W.Y, W.WoutT, ML, 1024, 1024}; pg8::StaticOrder S; S.init(ML, 1024, G, bx);
                    pg8::EpiOut E{p.x, p.ctx, (bf16_t*)(wsb + WS_X1H), W.modv, W.modv + 9 * 3072, W.A, W.rss1};
                    pg8::gemm_phase<pg8::EpiOut, pg8::StaticOrder, true, true>(lds, gm, S, E); }
                } else if (RUNSUB(6)) {
                    pg8::Gemm gm{W.Y, W.WoutT + (size_t)1024 * 1024, ML, 1024, 1024}; pg8::StaticOrder S; S.init(ML, 1024, G, bx);
                    pg8::EpiOutFin E{(const bf16_t*)(wsb + WS_X1H), p.out, W.modv + 9 * 3072, W.prm + PRM_FNW, W.rss2, (unsigned*)(wsb + WS_CTL) + 8192, (LAS unsigned*)(lds + CTLW_OFF + 576)};
                    pg8::gemm_phase<pg8::EpiOutFin, pg8::StaticOrder, true, true>(lds, gm, S, E);
                }
            }
        }
    }
#if PROBE_PH >= 0
    xcd_barrier(xbar);
    { if (threadIdx.x == 0 && tps[1] == 0ull) tps[1] = __builtin_amdgcn_s_memrealtime();
      __syncthreads();
      const float dlt = PROBE_PH == 50 ? (float)tps[2] * 1e-6f : (PROBE_PH >= 21 && PROBE_PH <= 42) ? (float)g_probe_acc * 1e-6f : (float)(tps[1] - tps[0]) * 1e-6f;
      for (size_t i = (size_t)blockIdx.x * 512 + threadIdx.x; i < (size_t)ML * 1024 / 4; i += (size_t)gridDim.x * 512) { f32x4 v = ((f32x4*)p.out)[i]; v = v + dlt; ((f32x4*)p.out)[i] = v; } }
#endif
}

extern "C" void kernel_launch(void* const* d_in, const int* in_sizes, int n_in, void* d_out, int out_size, void* d_ws, size_t ws_size, hipStream_t stream) {
    static int grid = 0;
    if (grid == 0) {
        if (n_in != 17 || out_size != ML * D || ws_size < WS_END) { fprintf(stderr, "kernel_launch: unexpected shapes (n_in %d, out %d, ws %zu)\n", n_in, out_size, ws_size); grid = -1; return; }
        int dev = 0, cus = 0, per_cu = 0;
        hipGetDevice(&dev); hipDeviceGetAttribute(&cus, hipDeviceAttributeMultiprocessorCount, dev);
        hipFuncSetAttribute((const void*)fwd_kernel, hipFuncAttributeMaxDynamicSharedMemorySize, LDS_BYTES);
        hipOccupancyMaxActiveBlocksPerMultiprocessor(&per_cu, (const void*)fwd_kernel, 512, LDS_BYTES);
        if (per_cu < 1) { fprintf(stderr, "kernel_launch: occupancy query says %d blocks/CU\n", per_cu); per_cu = 1; }
        (void)hipGetLastError();
        grid = cus;
    }
    if (grid < 0) return;
    Params p{};
    p.x = (const float*)d_in[0]; p.c = (const float*)d_in[1]; p.ctx = (const float*)d_in[2]; p.c_ctx = (const float*)d_in[3]; p.w_mod = (const float*)d_in[4]; p.b_mod = (const float*)d_in[5];
    p.w_in = (const float*)d_in[6]; p.conv_w = (const float*)d_in[7]; p.conv_b = (const float*)d_in[8]; p.conv_ln_w = (const float*)d_in[9]; p.conv_ln_b = (const float*)d_in[10];
    p.attn_sink = (const float*)d_in[11]; p.gla_w_up = (const float*)d_in[12]; p.gla_b_up = (const float*)d_in[13]; p.gla_norm_w = (const float*)d_in[14]; p.w_out = (const float*)d_in[15];
    p.final_norm_w = (const float*)d_in[16]; p.out = (float*)d_out; p.ws = (unsigned char*)d_ws;
    if (hipMemsetAsync((char*)d_ws + WS_CTL, 0, 65536, stream) != hipSuccess) { fprintf(stderr, "kernel_launch: memset failed\n"); return; }
#if MK_MULTI
    for (int ph = 0; ph < NPHASE; ++ph) { p.ph_lo = ph; p.ph_hi = ph + 1; hipLaunchKernelGGL(fwd_kernel, dim3(grid), dim3(512), LDS_BYTES, stream, p); }
#else
    p.ph_lo = 0; p.ph_hi = NPHASE;
    void* args[] = {&p};
    hipError_t e = hipLaunchCooperativeKernel((void*)fwd_kernel, dim3(grid), dim3(512), args, LDS_BYTES, stream);
    if (e != hipSuccess) fprintf(stderr, "cooperative launch failed: %s (grid %d)\n", hipGetErrorString(e), grid);
#endif
}
```
